# Optimizing an MI355X kernel written in HIP

```python
import math
import jax, jax.numpy as jnp
from jax import lax
import numpy as np

D_MODEL = 4096
BATCH = 2
SEQ = 4096
DEPTH = 2

CHUNK = 64
Q_BLOCK = 128
EPS = 1e-6
A_HEADS = 8
A_DH = 128
A_WIDTH = A_HEADS * 2 * A_DH
B_HEADS = 4
B_DK = 128
B_DV = 256
B_WIDTH = B_HEADS * B_DV
GATE_RANK = 16
GATE_TAU = 16.0
POOL_WINDOWS = (2, 4, 8, 16)
N_POOL = len(POOL_WINDOWS)
POOL_CH = 256
C_WIDTH = N_POOL * POOL_CH
MIX_WIDTH = A_WIDTH + B_WIDTH + C_WIDTH
IN_SIZES = (A_WIDTH, A_WIDTH, A_WIDTH,
            B_HEADS * B_DK, B_HEADS * B_DK,
            B_WIDTH, B_WIDTH,
            GATE_RANK,
            C_WIDTH)
IN_COLS = int(sum(IN_SIZES))
IN_SPLITS = [int(s) for s in np.cumsum(IN_SIZES)[:-1]]
D_FF = 11008
CONV_K = 3

kernel_name = "hybrid_diffattn_gla_pool_convffn"


def rmsnorm(x, g):
    xf = x.astype(jnp.float32)
    y = xf * lax.rsqrt(jnp.mean(xf * xf, axis=-1, keepdims=True) + EPS)
    return (y * g.astype(jnp.float32)).astype(x.dtype)


def alibi_slopes(n_heads):
    return 2.0 ** (-8.0 * jnp.arange(1, n_heads + 1, dtype=jnp.float32) / n_heads)


def diff_attention(q, k, v, lam):
    B, S, H = q.shape[0], q.shape[1], q.shape[2]
    E = v.shape[-1]
    scale = 1.0 / math.sqrt(A_DH)
    slopes = alibi_slopes(H)
    kpos = jnp.arange(S)
    kchunk = kpos // CHUNK
    k1, k2 = k[..., 0, :], k[..., 1, :]

    def block(i):
        start = i * Q_BLOCK
        qb = lax.dynamic_slice_in_dim(q, start, Q_BLOCK, axis=1)
        qpos = start + jnp.arange(Q_BLOCK)
        allowed = kchunk[None, :] <= (qpos // CHUNK)[:, None]
        dist = jnp.abs(qpos[:, None] - kpos[None, :]).astype(jnp.float32)
        bias = jnp.where(allowed[None], -slopes[:, None, None] * dist[None], -jnp.inf)

        def probs(qh, kh):
            s = jnp.einsum('bqhd,bkhd->bhqk', qh, kh).astype(jnp.float32) * scale + bias
            return jax.nn.softmax(s, axis=-1)

        attn = probs(qb[..., 0, :], k1) - lam * probs(qb[..., 1, :], k2)
        return jnp.einsum('bhqk,bkhe->bqhe', attn.astype(v.dtype), v)

    out = lax.map(block, jnp.arange(S // Q_BLOCK))
    return out.transpose(1, 0, 2, 3, 4).reshape(B, S, H, E)


def gla(q, k, v, log_a):
    dtype = v.dtype
    B, S, H, DK = q.shape
    DV = v.shape[-1]
    nc = S // CHUNK

    def to_chunks(t):
        return t.astype(jnp.float32).reshape(B, nc, CHUNK, H, t.shape[-1]).transpose(1, 0, 3, 2, 4)

    causal = jnp.tril(jnp.ones((CHUNK, CHUNK), dtype=bool))

    def step(state, inp):
        qc, kc, vc, gc = inp
        b = jnp.cumsum(gc, axis=2)
        diff = b[:, :, :, None, :] - b[:, :, None, :, :]
        decay = jnp.exp(jnp.where(causal[None, None, :, :, None], diff, -jnp.inf))
        a = jnp.einsum('bhtd,bhsd,bhtsd->bhts', qc, kc, decay)
        o = jnp.einsum('bhts,bhse->bhte', a, vc) + jnp.einsum('bhtd,bhde->bhte', qc * jnp.exp(b), state)
        b_last = b[:, :, -1:, :]
        new_state = jnp.exp(b_last[:, :, 0, :])[..., None] * state + \
            jnp.einsum('bhsd,bhse->bhde', kc * jnp.exp(b_last - b), vc)
        return new_state, o

    init = jnp.zeros((B, H, DK, DV), jnp.float32)
    _, o = lax.scan(step, init, (to_chunks(q), to_chunks(k), to_chunks(v), to_chunks(log_a)))
    return o.transpose(1, 0, 3, 2, 4).reshape(B, S, H, DV).astype(dtype)


def pool_mixer(u, w_pool, scale):
    B, S, _ = u.shape
    uf = u.astype(jnp.float32).reshape(B, S, N_POOL, POOL_CH)
    cs = jnp.concatenate([jnp.zeros((B, 1, N_POOL, POOL_CH), jnp.float32),
                          jnp.cumsum(uf, axis=1)], axis=1)
    hi = jnp.arange(1, S + 1)
    outs = []
    for g, w in enumerate(POOL_WINDOWS):
        lo = jnp.maximum(hi - w, 0)
        cnt = (hi - lo).astype(jnp.float32)
        win_sum = cs[:, 1:, g, :] - jnp.take(cs[:, :, g, :], lo, axis=1)
        outs.append(win_sum / cnt[None, :, None] - uf[:, :, g, :])
    d = jnp.stack(outs, axis=2).astype(u.dtype)
    y = jnp.einsum('bsgc,gcd->bsgd', d, w_pool).reshape(B, S, C_WIDTH)
    return y * scale


def causal_dwconv(z, w, b):
    S = z.shape[1]
    zp = jnp.pad(z, ((0, 0), (CONV_K - 1, 0), (0, 0)))
    y = b
    for t in range(CONV_K):
        y = y + zp[:, t:t + S] * w[t]
    return y


def setup_inputs(seed: int = 0) -> dict:
    key = jax.random.key(seed)
    ks = jax.random.split(key, 24)
    f32 = jnp.float32
    nrm = lambda k, shape, s: jax.random.normal(k, shape, f32) * s
    gain = lambda k, shape: 1.0 + 0.02 * jax.random.normal(k, shape, f32)
    L = DEPTH
    return {
        "x": nrm(ks[0], (BATCH, SEQ, D_MODEL), 1.0),
        "w_in": nrm(ks[1], (L, D_MODEL, IN_COLS), D_MODEL ** -0.5),
        "w_gate_lr2": nrm(ks[2], (L, GATE_RANK, B_HEADS * B_DK), GATE_RANK ** -0.5),
        "b_gate": nrm(ks[3], (L, B_HEADS * B_DK), 0.1),
        "lam_q1": nrm(ks[4], (L, A_DH), 0.1),
        "lam_k1": nrm(ks[5], (L, A_DH), 0.1),
        "lam_q2": nrm(ks[6], (L, A_DH), 0.1),
        "lam_k2": nrm(ks[7], (L, A_DH), 0.1),
        "g_subln": gain(ks[8], (L, 2 * A_DH)),
        "g_gla": gain(ks[9], (L, B_WIDTH)),
        "w_pool": nrm(ks[10], (L, N_POOL, POOL_CH, POOL_CH), POOL_CH ** -0.5),
        "pool_scale": gain(ks[11], (L, C_WIDTH)),
        "w_o": nrm(ks[12], (L, MIX_WIDTH, D_MODEL), MIX_WIDTH ** -0.5),
        "w_up": nrm(ks[13], (L, D_MODEL, 2 * D_FF), D_MODEL ** -0.5),
        "w_conv": nrm(ks[14], (L, CONV_K, 2 * D_FF), CONV_K ** -0.5),
        "b_conv": nrm(ks[15], (L, 2 * D_FF), 0.01),
        "w_down": nrm(ks[16], (L, D_FF, D_MODEL), D_FF ** -0.5),
        "g_pre_mix": gain(ks[17], (L, D_MODEL)),
        "g_post_mix": gain(ks[18], (L, D_MODEL)),
        "g_pre_ffn": gain(ks[19], (L, D_MODEL)),
        "g_post_ffn": gain(ks[20], (L, D_MODEL)),
    }


def reference(x, w_in, w_gate_lr2, b_gate, lam_q1, lam_k1, lam_q2, lam_k2, g_subln, g_gla,
              w_pool, pool_scale, w_o, w_up, w_conv, b_conv, w_down,
              g_pre_mix, g_post_mix, g_pre_ffn, g_post_ffn):
    B, S, _ = x.shape
    h = x
    for l in range(DEPTH):
        hn = rmsnorm(h, g_pre_mix[l])
        u = hn @ w_in[l]
        qa, ka, va, qb, kb, vb, gb, zlr, uc = jnp.split(u, IN_SPLITS, axis=-1)

        lam_init = 0.8 - 0.6 * math.exp(-0.3 * l)
        lam = (jnp.exp(jnp.sum(lam_q1[l].astype(jnp.float32) * lam_k1[l].astype(jnp.float32)))
               - jnp.exp(jnp.sum(lam_q2[l].astype(jnp.float32) * lam_k2[l].astype(jnp.float32)))
               + lam_init)
        oa = diff_attention(qa.reshape(B, S, A_HEADS, 2, A_DH),
                            ka.reshape(B, S, A_HEADS, 2, A_DH),
                            va.reshape(B, S, A_HEADS, 2 * A_DH), lam)
        oa = (rmsnorm(oa, g_subln[l]) * (1.0 - lam_init)).reshape(B, S, A_WIDTH)

        log_a = jax.nn.log_sigmoid(
            (zlr @ w_gate_lr2[l] + b_gate[l]).astype(jnp.float32)) / GATE_TAU
        ob = gla(qb.reshape(B, S, B_HEADS, B_DK) * (B_DK ** -0.5),
                 kb.reshape(B, S, B_HEADS, B_DK),
                 vb.reshape(B, S, B_HEADS, B_DV),
                 log_a.reshape(B, S, B_HEADS, B_DK))
        ob = rmsnorm(ob, g_gla[l].reshape(B_HEADS, B_DV)).reshape(B, S, B_WIDTH) * jax.nn.silu(gb)

        oc = pool_mixer(uc, w_pool[l], pool_scale[l])

        mix = jnp.concatenate([oa, ob, oc], axis=-1) @ w_o[l]
        h = h + rmsnorm(mix, g_post_mix[l])

        hn = rmsnorm(h, g_pre_ffn[l])
        z = causal_dwconv(hn @ w_up[l], w_conv[l], b_conv[l])
        gate, val = jnp.split(z, 2, axis=-1)
        f = (jax.nn.gelu(gate, approximate=True) * val) @ w_down[l]
        h = h + rmsnorm(f, g_post_ffn[l])
    return h
```

```cpp
#ifndef MK_ONE_LAUNCH
#define MK_ONE_LAUNCH 1
#endif
#include <hip/hip_runtime.h>
#include <stdint.h>
#include <stdio.h>

typedef unsigned short bf16_t;
typedef short bf16x8 __attribute__((ext_vector_type(8)));
typedef float f32x4 __attribute__((ext_vector_type(4)));
typedef float f32x16 __attribute__((ext_vector_type(16)));

constexpr int D = 4096, SEQ = 4096, M = 8192, DEPTH = 2;
constexpr int NIN = 10256, DFF = 11008, NUP = 22016;
constexpr int UNW = 7168, UTW = 3072;
constexpr float EPS = 1e-6f;
constexpr int UN_QA = 0, UN_KA = 2048, UN_QB = 4096, UN_KB = 4608, UN_GB = 5120, UN_UC = 6144;
constexpr int SRC_QA = 0, SRC_KA = 2048, SRC_VA = 4096, SRC_QB = 6144, SRC_KB = 6656, SRC_VB = 7168, SRC_GB = 8192, SRC_ZLR = 9216, SRC_UC = 9232;

constexpr size_t MiB = 1u << 20;
constexpr size_t WS_CTL = 0;
constexpr size_t WS_W0 = 1 * MiB;
constexpr size_t OFF_WN = 0, OFF_WT = 56 * MiB, OFF_WO = 80 * MiB, OFF_WUP = 112 * MiB, OFF_WDN = 284 * MiB, OFF_WP = 370 * MiB, W_LAYER = 371 * MiB;
constexpr size_t WS_HN = WS_W0 + 2 * W_LAYER;
constexpr size_t WS_UN = WS_HN + 64 * MiB;
constexpr size_t WS_UT = WS_UN + 112 * MiB;
constexpr size_t WS_ZLR = WS_UT + 48 * MiB;
constexpr size_t WS_MIX = WS_ZLR + 1 * MiB;
constexpr size_t WS_Y = WS_MIX + 64 * MiB;
constexpr size_t WS_Z = WS_Y + 128 * MiB;
constexpr size_t WS_F = WS_Z + 344 * MiB;
constexpr size_t WS_DP = WS_F + 172 * MiB;
constexpr size_t WS_END = WS_DP + 16 * MiB;

__device__ __forceinline__ bf16_t f2bf(float f) { unsigned u = __float_as_uint(f); u += 0x7fffu + ((u >> 16) & 1u); return (bf16_t)(u >> 16); }
__device__ __forceinline__ float bf2f(bf16_t b) { return __uint_as_float(((unsigned)b) << 16); }
__device__ __forceinline__ float wave_sum(float v) {
#pragma unroll
    for (int o = 1; o < 64; o <<= 1) v += __shfl_xor(v, o);
    return v;
}
__device__ __forceinline__ float wave_max(float v) {
#pragma unroll
    for (int o = 1; o < 64; o <<= 1) v = fmaxf(v, __shfl_xor(v, o));
    return v;
}

__global__ void k_cvt_t(const float* __restrict__ W, int ldw, int c0, bf16_t* __restrict__ Wt, int K, int r0) {
    __shared__ float t[64][65];
    const int nb = blockIdx.x, kb = blockIdx.y, tx = threadIdx.x & 63, ty = threadIdx.x >> 6;
    for (int i = ty; i < 64; i += 4) t[i][tx] = W[(size_t)(kb * 64 + i) * ldw + c0 + nb * 64 + tx];
    __syncthreads();
    for (int i = ty; i < 64; i += 4) Wt[(size_t)(r0 + nb * 64 + i) * K + kb * 64 + tx] = f2bf(t[tx][i]);
}

template <int OUTF32>
__global__ __launch_bounds__(256) void k_gemm(const bf16_t* __restrict__ A, int lda, const bf16_t* __restrict__ Bt, int ldb, void* C, int ldc, int K, const float* cscale) {
    const int wid = threadIdx.x >> 6, lane = threadIdx.x & 63, r = lane & 31, h = lane >> 5;
    const int m0 = blockIdx.y * 128 + (wid >> 1) * 64, n0 = blockIdx.x * 128 + (wid & 1) * 64;
    f32x16 acc[2][2];
#pragma unroll
    for (int i = 0; i < 2; ++i)
#pragma unroll
        for (int j = 0; j < 2; ++j)
#pragma unroll
            for (int e = 0; e < 16; ++e) acc[i][j][e] = 0.f;
    const bf16_t* a0 = A + (size_t)(m0 + r) * lda + 8 * h;
    const bf16_t* a1 = a0 + (size_t)32 * lda;
    const bf16_t* b0 = Bt + (size_t)(n0 + r) * ldb + 8 * h;
    const bf16_t* b1 = b0 + (size_t)32 * ldb;
    for (int k = 0; k < K; k += 16) {
        const bf16x8 fa0 = *(const bf16x8*)(a0 + k), fa1 = *(const bf16x8*)(a1 + k), fb0 = *(const bf16x8*)(b0 + k), fb1 = *(const bf16x8*)(b1 + k);
        acc[0][0] = __builtin_amdgcn_mfma_f32_32x32x16_bf16(fa0, fb0, acc[0][0], 0, 0, 0);
        acc[0][1] = __builtin_amdgcn_mfma_f32_32x32x16_bf16(fa0, fb1, acc[0][1], 0, 0, 0);
        acc[1][0] = __builtin_amdgcn_mfma_f32_32x32x16_bf16(fa1, fb0, acc[1][0], 0, 0, 0);
        acc[1][1] = __builtin_amdgcn_mfma_f32_32x32x16_bf16(fa1, fb1, acc[1][1], 0, 0, 0);
    }
#pragma unroll
    for (int i = 0; i < 2; ++i)
#pragma unroll
        for (int j = 0; j < 2; ++j)
#pragma unroll
            for (int e = 0; e < 16; ++e) {
                const int row = m0 + 32 * i + (e & 3) + 8 * (e >> 2) + 4 * h, col = n0 + 32 * j + r;
                float v = acc[i][j][e];
                if (OUTF32) ((float*)C)[(size_t)row * ldc + col] = v;
                else { if (cscale) v *= cscale[col]; ((bf16_t*)C)[(size_t)row * ldc + col] = f2bf(v); }
            }
}

__global__ __launch_bounds__(256) void k_norm(const float* X, float* H, const float* Y, const float* gpost, const float* gnext, bf16_t* HN) {
    const int row = blockIdx.x * 4 + (threadIdx.x >> 6), lane = threadIdx.x & 63;
    f32x4 hv[16];
    const f32x4* src = (const f32x4*)((X ? X : H) + (size_t)row * D) + lane;
#pragma unroll
    for (int j = 0; j < 16; ++j) hv[j] = src[64 * j];
    if (Y) {
        const f32x4* yp = (const f32x4*)(Y + (size_t)row * D) + lane;
        f32x4 yv[16]; float s = 0.f;
#pragma unroll
        for (int j = 0; j < 16; ++j) { yv[j] = yp[64 * j]; s += yv[j].x * yv[j].x + yv[j].y * yv[j].y + yv[j].z * yv[j].z + yv[j].w * yv[j].w; }
        const float rs = rsqrtf(wave_sum(s) * (1.f / D) + EPS);
#pragma unroll
        for (int j = 0; j < 16; ++j) { const f32x4 g = ((const f32x4*)gpost)[lane + 64 * j]; hv[j] += yv[j] * rs * g; }
    }
    if (X || Y) {
        f32x4* hp = (f32x4*)(H + (size_t)row * D) + lane;
#pragma unroll
        for (int j = 0; j < 16; ++j) hp[64 * j] = hv[j];
    }
    if (gnext) {
        float s = 0.f;
#pragma unroll
        for (int j = 0; j < 16; ++j) s += hv[j].x * hv[j].x + hv[j].y * hv[j].y + hv[j].z * hv[j].z + hv[j].w * hv[j].w;
        const float rs = rsqrtf(wave_sum(s) * (1.f / D) + EPS);
        uint2* op = (uint2*)(HN + (size_t)row * D) + lane;
#pragma unroll
        for (int j = 0; j < 16; ++j) { const f32x4 g = ((const f32x4*)gnext)[lane + 64 * j]; const f32x4 v = hv[j] * rs * g;
            uint2 o; o.x = (unsigned)f2bf(v.x) | ((unsigned)f2bf(v.y) << 16); o.y = (unsigned)f2bf(v.z) | ((unsigned)f2bf(v.w) << 16); op[64 * j] = o; }
    }
}

__global__ __launch_bounds__(256) void k_zlr(const bf16_t* HN, const float* w_in, float* ZLR) {
    const int row = blockIdx.x * 4 + (threadIdx.x >> 6), lane = threadIdx.x & 63;
    float acc[16];
#pragma unroll
    for (int j = 0; j < 16; ++j) acc[j] = 0.f;
    for (int k = lane; k < D; k += 64) {
        const float a = bf2f(HN[(size_t)row * D + k]);
        const f32x4* w = (const f32x4*)(w_in + (size_t)k * NIN + SRC_ZLR);
#pragma unroll
        for (int q = 0; q < 4; ++q) { const f32x4 wv = w[q]; acc[4 * q] += a * wv.x; acc[4 * q + 1] += a * wv.y; acc[4 * q + 2] += a * wv.z; acc[4 * q + 3] += a * wv.w; }
    }
#pragma unroll
    for (int j = 0; j < 16; ++j) acc[j] = wave_sum(acc[j]);
    if (lane == 0) {
#pragma unroll
        for (int j = 0; j < 16; ++j) ZLR[(size_t)row * 16 + j] = acc[j];
    }
}

__device__ __forceinline__ float lam_of(const float* q1, const float* k1, const float* q2, const float* k2, int lane, float lam_init) {
    float s1 = q1[lane] * k1[lane] + q1[lane + 64] * k1[lane + 64], s2 = q2[lane] * k2[lane] + q2[lane + 64] * k2[lane + 64];
    s1 = wave_sum(s1); s2 = wave_sum(s2);
    return expf(s1) - expf(s2) + lam_init;
}

__global__ __launch_bounds__(64) void k_attn_naive(const bf16_t* UN, const bf16_t* UT, bf16_t* MIX, const float* lq1, const float* lk1, const float* lq2, const float* lk2, const float* gsub, float lam_init) {
    __shared__ float sc[2][SEQ];
    __shared__ float qv[2][128];
    const int lane = threadIdx.x, q = blockIdx.x % SEQ, h = (blockIdx.x / SEQ) % 8, b = blockIdx.x / (SEQ * 8);
    const float lam = lam_of(lq1, lk1, lq2, lk2, lane, lam_init);
    const size_t tok = (size_t)b * SEQ + q;
    for (int i = lane; i < 256; i += 64) qv[i >> 7][i & 127] = bf2f(UN[tok * UNW + UN_QA + h * 256 + i]);
    __syncthreads();
    const int nk = (q / 64 + 1) * 64;
    const float slope = exp2f(-(float)(h + 1)), scale = 0.08838834764831845f;
    float mx[2] = {-INFINITY, -INFINITY};
    for (int j = lane; j < nk; j += 64) {
        const bf16_t* kp = UN + ((size_t)b * SEQ + j) * UNW + UN_KA + h * 256;
#pragma unroll
        for (int mp = 0; mp < 2; ++mp) {
            float d = 0.f;
            for (int c = 0; c < 128; c += 8) { const bf16x8 kv = *(const bf16x8*)(kp + mp * 128 + c);
#pragma unroll
                for (int e = 0; e < 8; ++e) d += qv[mp][c + e] * bf2f((bf16_t)kv[e]); }
            const float s = d * scale - slope * fabsf((float)(q - j));
            sc[mp][j] = s; mx[mp] = fmaxf(mx[mp], s);
        }
    }
    float l[2] = {0.f, 0.f};
#pragma unroll
    for (int mp = 0; mp < 2; ++mp) { mx[mp] = wave_max(mx[mp]); }
    for (int j = lane; j < nk; j += 64) {
#pragma unroll
        for (int mp = 0; mp < 2; ++mp) { const float p = expf(sc[mp][j] - mx[mp]); sc[mp][j] = p; l[mp] += p; }
    }
#pragma unroll
    for (int mp = 0; mp < 2; ++mp) l[mp] = wave_sum(l[mp]);
    const float i1 = 1.f / l[0], i2 = lam / l[1];
    for (int j = lane; j < nk; j += 64) sc[0][j] = sc[0][j] * i1 - sc[1][j] * i2;
    __syncthreads();
    float o[4] = {0.f, 0.f, 0.f, 0.f};
    for (int j = 0; j < nk; j += 8) {
#pragma unroll
        for (int i = 0; i < 4; ++i) {
            const bf16x8 vv = *(const bf16x8*)(UT + (size_t)(h * 256 + lane * 4 + i) * M + (size_t)b * SEQ + j);
#pragma unroll
            for (int e = 0; e < 8; ++e) o[i] += sc[0][j + e] * bf2f((bf16_t)vv[e]);
        }
    }
    float ss = o[0] * o[0] + o[1] * o[1] + o[2] * o[2] + o[3] * o[3];
    const float rs = rsqrtf(wave_sum(ss) * (1.f / 256.f) + EPS) * (1.f - lam_init);
#pragma unroll
    for (int i = 0; i < 4; ++i) MIX[tok * D + h * 256 + lane * 4 + i] = f2bf(o[i] * rs * gsub[lane * 4 + i]);
}

__global__ __launch_bounds__(256) void k_gla_naive(const bf16_t* UN, const bf16_t* UT, const float* ZLR, const float* w2, const float* bg, const float* ggla, bf16_t* MIX) {
    __shared__ float sa[128], sk[128], sq[128], red[4];
    const int e = threadIdx.x, h = blockIdx.x & 3, b = blockIdx.x >> 2;
    float S[128];
#pragma unroll
    for (int d = 0; d < 128; ++d) S[d] = 0.f;
    for (int t = 0; t < SEQ; ++t) {
        const size_t tok = (size_t)b * SEQ + t;
        if (e < 128) {
            float x = bg[h * 128 + e];
#pragma unroll
            for (int r = 0; r < 16; ++r) x += ZLR[tok * 16 + r] * w2[r * 512 + h * 128 + e];
            const float ls = fminf(x, 0.f) - log1pf(expf(-fabsf(x)));
            sa[e] = expf(ls * (1.f / 16.f));
            sk[e] = bf2f(UN[tok * UNW + UN_KB + h * 128 + e]);
            sq[e] = bf2f(UN[tok * UNW + UN_QB + h * 128 + e]) * 0.08838834764831845f;
        }
        __syncthreads();
        const float v = bf2f(UT[(size_t)(2048 + h * 256 + e) * M + tok]);
        float o = 0.f;
#pragma unroll
        for (int d = 0; d < 128; ++d) { S[d] = sa[d] * S[d] + sk[d] * v; o += sq[d] * S[d]; }
        const float ws = wave_sum(o * o);
        if ((e & 63) == 0) red[e >> 6] = ws;
        __syncthreads();
        const float ms = (red[0] + red[1] + red[2] + red[3]) * (1.f / 256.f);
        const float g = bf2f(UN[tok * UNW + UN_GB + h * 256 + e]);
        const float out = o * rsqrtf(ms + EPS) * ggla[h * 256 + e] * (g / (1.f + expf(-g)));
        MIX[tok * D + 2048 + h * 256 + e] = f2bf(out);
    }
}

__global__ void k_pool_d(const bf16_t* UN, bf16_t* DP) {
    const int idx = blockIdx.x * 256 + threadIdx.x, c = idx & 1023, tok = idx >> 10, t = tok & (SEQ - 1), g = c >> 8, w = 2 << g;
    const int lo = (t + 1 - w) > 0 ? (t + 1 - w) : 0;
    float s = 0.f;
    for (int j = lo; j <= t; ++j) s += bf2f(UN[(size_t)(tok - t + j) * UNW + UN_UC + c]);
    DP[(size_t)tok * 1024 + c] = f2bf(s / (float)(t + 1 - lo) - bf2f(UN[(size_t)tok * UNW + UN_UC + c]));
}

__device__ __forceinline__ float gelu_tanh(float x) { const float u = 0.7978845608028654f * (x + 0.044715f * x * x * x); return 0.5f * x * (1.f + tanhf(u)); }
__global__ void k_convglu(const bf16_t* Z, const float* wc, const float* bc, bf16_t* F) {
    const size_t idx = (size_t)blockIdx.x * 256 + threadIdx.x; const int c = (int)(idx % DFF); const size_t tok = idx / DFF; const int t = (int)(tok & (SEQ - 1));
    float gte = bc[c], val = bc[c + DFF];
#pragma unroll
    for (int j = 0; j < 3; ++j) { const int tt = t - 2 + j; if (tt >= 0) { const size_t r = (tok - 2 + j) * (size_t)NUP;
        gte += wc[j * NUP + c] * bf2f(Z[r + c]); val += wc[j * NUP + c + DFF] * bf2f(Z[r + c + DFF]); } }
    F[tok * DFF + c] = f2bf(gelu_tanh(gte) * val);
}


#define LAS __attribute__((address_space(3)))
#define GAS __attribute__((address_space(1)))
typedef unsigned u32x4 __attribute__((ext_vector_type(4)));
typedef unsigned u32x2 __attribute__((ext_vector_type(2)));
typedef float f32x2 __attribute__((ext_vector_type(2)));
typedef GAS unsigned gu32;
#define RLX_AGENT __ATOMIC_RELAXED, __HIP_MEMORY_SCOPE_AGENT
constexpr size_t OFF_WZ = 370 * MiB + 512 * 1024;
constexpr int RING_BYTES = 141312, LDSCTL_OFF = RING_BYTES, MISC_OFF = LDSCTL_OFF + 320, LDS_BYTES = 147456;
constexpr int CW_BAR = 4096;
constexpr size_t CTL_ZERO_BYTES = 64 * 1024;

__device__ __forceinline__ unsigned cvt_pk_bf16(float lo, float hi) { unsigned r; asm volatile("v_cvt_pk_bf16_f32 %0, %1, %2" : "=v"(r) : "v"(lo), "v"(hi)); return r; }

#define XB_TMO      128
#define XB_XCNT(j)  (256  + 64 * (j))
#define XB_XSUB(j)  (1280 + 64 * (j))
#define XB_XGEN(j)  (2304 + 64 * (j))
#define XB_TOP      3328
#define XB_TOPGEN   3392
#define XCD_BAR_WORDS 3456
#define XB_SPIN_CAP (1u << 18)
__device__ __forceinline__ unsigned xb_ld(unsigned* p)              { return __hip_atomic_load(p, __ATOMIC_RELAXED, __HIP_MEMORY_SCOPE_AGENT); }
__device__ __forceinline__ unsigned xb_add(unsigned* p, unsigned v) { return __hip_atomic_fetch_add(p, v, __ATOMIC_RELAXED, __HIP_MEMORY_SCOPE_AGENT); }
__device__ __forceinline__ unsigned xb_xcc_id() { return (unsigned)__builtin_amdgcn_s_getreg((3 << 11) | 20) & 0xFu; }
#define XB_SPIN(cond, bar) do { unsigned _sp = 0; while (cond) { __builtin_amdgcn_s_sleep(1); \
    if ((++_sp & 255u) == 0u) { if (xb_ld(&(bar)[XB_TMO])) break; if (_sp > XB_SPIN_CAP) { atomicAdd(&(bar)[XB_TMO], 1u); break; } } } } while (0)
struct XcdBarrier { unsigned* bar; unsigned x; volatile LAS unsigned* st; };
__device__ __forceinline__ XcdBarrier xcd_barrier_post(unsigned* bar, volatile LAS unsigned* st) {
    XcdBarrier b; b.bar = bar; b.x = xb_xcc_id(); b.st = st;
    if (threadIdx.x == 0) (void)xb_add(&bar[XB_XCNT(b.x)], 1u);
    return b;
}
__device__ __forceinline__ void xcd_barrier_complete(unsigned* bar, unsigned x, unsigned& nloc, unsigned& nx) {
    const unsigned G = gridDim.x * gridDim.y * gridDim.z;
    unsigned sum, cnt, mine, sp = 0u;
    for (;;) {
        sum = 0u; cnt = 0u; mine = 0u;
#pragma unroll
        for (unsigned j = 0; j < 16; ++j) { const unsigned c = xb_ld(&bar[XB_XCNT(j)]); sum += c; cnt += (c > 0u) ? 1u : 0u; mine = (j == x) ? c : mine; }
        if (sum == G) break;
        __builtin_amdgcn_s_sleep(1);
        if ((++sp & 255u) == 0u) { if (xb_ld(&bar[XB_TMO])) break; if (sp > XB_SPIN_CAP) { atomicAdd(&bar[XB_TMO], 1u); break; } }
    }
    nloc = mine > 0u ? mine : 1u; nx = cnt > 0u ? cnt : 1u;
}
__device__ __forceinline__ void xcd_barrier(const XcdBarrier& b) {
    asm volatile("s_waitcnt vmcnt(0)" ::: "memory");
    __syncthreads();
    if (threadIdx.x == 0) {
        unsigned* bar = b.bar;
        __builtin_amdgcn_s_waitcnt(0);
        unsigned nloc = b.st[0], nx = b.st[1];
        if (nloc == 0u) { xcd_barrier_complete(bar, b.x, nloc, nx); b.st[0] = nloc; b.st[1] = nx; }
        const unsigned old = xb_add(&bar[XB_XSUB(b.x)], 1u);
        const unsigned gen = old / nloc;
        if (old + 1u == (gen + 1u) * nloc) {
            __builtin_amdgcn_fence(__ATOMIC_RELEASE, "agent");
            asm volatile("s_waitcnt vmcnt(0)" ::: "memory");
            const unsigned og = xb_add(&bar[XB_TOP], 1u);
            const unsigned tg = og / nx;
            if (og + 1u == (tg + 1u) * nx) xb_add(&bar[XB_TOPGEN], 1u);
            else XB_SPIN(xb_ld(&bar[XB_TOPGEN]) == tg, bar);
            __builtin_amdgcn_fence(__ATOMIC_ACQUIRE, "agent");
            xb_add(&bar[XB_XGEN(b.x)], 1u);
            asm volatile("s_waitcnt vmcnt(0)" ::: "memory");
        } else {
            XB_SPIN(xb_ld(&bar[XB_XGEN(b.x)]) == gen, bar);
            __builtin_amdgcn_fence(__ATOMIC_ACQUIRE, "agent");
            asm volatile("s_waitcnt vmcnt(0)" ::: "memory");
        }
    }
    __syncthreads();
}

namespace pg8 {
constexpr int BM = 256, BK = 64, HALF = 128, HTB = HALF * BK * 2, STAGE_BYTES = 8 * HTB, NXCD = 8, WGM = 8;
__host__ __device__ __forceinline__ int lds_byte(int r, int c) { const int st = (r >> 4) * 2 + (c >> 5), rr = r & 15, cc = c & 31, ob = rr * 64 + cc * 2; return st * 1024 + (ob ^ (((ob >> 9) & 1) << 5)); }
__host__ __device__ __forceinline__ void stage_rc(int b, int& R, int& C) { const int st = b / 1024, sb = b % 1024, swz = sb ^ (((sb >> 9) & 1) << 5); R = (st >> 1) * 16 + swz / 64; C = (st & 1) * 32 + (swz % 64) / 2; }
__host__ __device__ __forceinline__ int perm32(int rho) { const int n = rho >> 4, i = rho & 15; return 8 * (i >> 2) + 4 * n + (i & 3); }

struct Unit { int pm, pn, kind; };
struct Gemm { const bf16_t* A[2]; const bf16_t* Bt[2]; int lda, ldb, K; };

__device__ __forceinline__ void tile_of(int wgid, int nM, int nN, int& pm, int& pn) {
    const int nwg = nM * nN; { const int q = nwg / NXCD, r = nwg % NXCD, xcd = wgid % NXCD, off = wgid / NXCD; wgid = (xcd < r ? xcd * (q + 1) : r * (q + 1) + (xcd - r) * q) + off; }
    const int nig = WGM * nN, gid = wgid / nig, fm = gid * WGM, gsz = (nM - fm) < WGM ? (nM - fm) : WGM;
    pm = fm + ((wgid % nig) % gsz); pn = (wgid % nig) / gsz;
}
struct Order2 {
    int nM0, nN0, nM1, nN1, G, c;
    __device__ __forceinline__ bool next(int i, Unit& u) const {
        const int L = i * G + c, n0 = nM0 * nN0;
        if (L < n0) { u.kind = 0; tile_of(L, nM0, nN0, u.pm, u.pn); return true; }
        if (L < n0 + nM1 * nN1) { u.kind = 1; tile_of(L - n0, nM1, nN1, u.pm, u.pn); return true; }
        return false;
    }
    __device__ __forceinline__ void a_ready(const Unit&) const {}
    __device__ __forceinline__ void done(const Unit&) const {}
};

struct EpiBf16 {
    static constexpr bool PERM = true;
    bf16_t* O[2]; int ldc[2];
    __device__ __forceinline__ void operator()(const f32x4 (&acc)[2][2][4][2], const Unit& u, int wr, int wc, int fr, int fq) const {
        const int row0 = u.pm * BM + wr * 64 + fr, col0 = u.pn * BM + wc * 32 + 8 * fq;
        bf16_t* base = u.kind ? O[1] : O[0]; const int ld = u.kind ? ldc[1] : ldc[0];
#pragma unroll
        for (int ai = 0; ai < 2; ++ai)
#pragma unroll
            for (int m = 0; m < 4; ++m) { bf16_t* rowp = base + (size_t)(row0 + ai * HALF + m * 16) * ld + col0;
#pragma unroll
                for (int bj = 0; bj < 2; ++bj) { const f32x4 v0 = acc[ai][bj][m][0], v1 = acc[ai][bj][m][1];
                    u32x4 w; w.x = cvt_pk_bf16(v0[0], v0[1]); w.y = cvt_pk_bf16(v0[2], v0[3]); w.z = cvt_pk_bf16(v1[0], v1[1]); w.w = cvt_pk_bf16(v1[2], v1[3]);
                    *(u32x4*)(rowp + bj * HALF) = w; } }
    }
};
struct EpiF32 {
    static constexpr bool PERM = false;
    float* C; int ldc;
    __device__ __forceinline__ void operator()(const f32x4 (&acc)[2][2][4][2], const Unit& u, int wr, int wc, int fr, int fq) const {
        const int row0 = u.pm * BM + wr * 64 + fr, col0 = u.pn * BM + wc * 32 + 4 * fq;
#pragma unroll
        for (int ai = 0; ai < 2; ++ai)
#pragma unroll
            for (int m = 0; m < 4; ++m) { float* rowp = C + (size_t)(row0 + ai * HALF + m * 16) * ldc + col0;
#pragma unroll
                for (int bj = 0; bj < 2; ++bj)
#pragma unroll
                    for (int n = 0; n < 2; ++n) *(f32x4*)(rowp + bj * HALF + n * 16) = acc[ai][bj][m][n]; }
    }
};

template <class Epi, class Sched, bool ALIGN_EPI, bool SP2>
__device__ __forceinline__ void gemm_phase(LAS unsigned char* lds, const Gemm g, const Sched& S, const Epi& E) {
    int tid = threadIdx.x; asm volatile("" : "+v"(tid));
    const int wid = __builtin_amdgcn_readfirstlane(tid >> 6), lane = tid & 63, wr = wid >> 2, wc = wid & 3, fr = lane & 15, fq = lane >> 4;
    const int K = g.K, nt = K / BK;
    unsigned voffA[2], voffB[2];
#pragma unroll
    for (int i = 0; i < 2; ++i) { int R, C; stage_rc(tid * 16 + i * 8192, R, C); const int Rb = Epi::PERM ? ((R & ~31) + perm32(R & 31)) : R;
        voffA[i] = (unsigned)(R * g.lda + C) * 2u; voffB[i] = (unsigned)(Rb * g.ldb + C) * 2u; }
    const size_t kstep = (size_t)(BK * 2);
    const size_t hstepA = (size_t)HALF * g.lda * 2, hstepB = (size_t)HALF * g.ldb * 2;
    const size_t tstepA = 2 * hstepA, tstepB = 2 * hstepB;
    const unsigned ldsw = (unsigned)wid * 1024u;
    const int aoff = lds_byte(wr * 64 + fr, fq * 8), boff = lds_byte(wc * 32 + fr, fq * 8);
#define PG8_SA(b, h) (((b) * 2 + (h)) * HTB)
#define PG8_SB(b, h) ((4 + (b) * 2 + (h)) * HTB)
#define PG8_STAGE(bufoff, gbase, voff) do { _Pragma("unroll") for (int _i = 0; _i < 2; ++_i) \
        __builtin_amdgcn_global_load_lds((const unsigned*)((const char*)(gbase) + (voff)[_i]), (LAS unsigned*)(lds + (bufoff) + ldsw + _i * 8192), 16, 0, 0); } while (0)
#define PG8_LDA(dst, b, h) do { _Pragma("unroll") for (int m = 0; m < 4; ++m) _Pragma("unroll") for (int k = 0; k < 2; ++k) dst[m][k] = *(const LAS bf16x8*)(lds + PG8_SA(b, h) + aoff + m * 2048 + k * 1024); } while (0)
#define PG8_LDB(dst, b, h) do { _Pragma("unroll") for (int n = 0; n < 2; ++n) _Pragma("unroll") for (int k = 0; k < 2; ++k) dst[n][k] = *(const LAS bf16x8*)(lds + PG8_SB(b, h) + boff + n * 2048 + k * 1024); } while (0)
#define PG8_MMA(ai, bj, At, Bt) do { __builtin_amdgcn_s_setprio(1); _Pragma("unroll") for (int m = 0; m < 4; ++m) _Pragma("unroll") for (int n = 0; n < 2; ++n) _Pragma("unroll") for (int k = 0; k < 2; ++k) \
        acc[ai][bj][m][n] = __builtin_amdgcn_mfma_f32_16x16x32_bf16(Bt[n][k], At[m][k], acc[ai][bj][m][n], 0, 0, 0); __builtin_amdgcn_s_setprio(0); } while (0)
#define PG8_WAIT_V(n) asm volatile("s_waitcnt vmcnt(" #n ")" ::: "memory")
#define PG8_WAIT_L(n) asm volatile("s_waitcnt lgkmcnt(" #n ")" ::: "memory")
#define PG8_BAR __builtin_amdgcn_s_barrier()
#define PG8_SCHED __builtin_amdgcn_sched_barrier(0)
    Unit cur, nxt; int ui = 0;
    if (!S.next(0, cur)) return;
    f32x4 acc[2][2][4][2];
#pragma unroll
    for (int a = 0; a < 2; ++a)
#pragma unroll
        for (int b = 0; b < 2; ++b)
#pragma unroll
            for (int m = 0; m < 4; ++m)
#pragma unroll
                for (int n = 0; n < 2; ++n) acc[a][b][m][n] = (f32x4){0.f, 0.f, 0.f, 0.f};
    bf16x8 At[4][2], B0[2][2], B1[2][2];
    const char* cA = (const char*)(cur.kind ? g.A[1] : g.A[0]) + (size_t)cur.pm * tstepA; const char* cB = (const char*)(cur.kind ? g.Bt[1] : g.Bt[0]) + (size_t)cur.pn * tstepB;
    S.a_ready(cur);
    if constexpr (SP2) {
        PG8_STAGE(PG8_SB(0, 0), cB, voffB); PG8_STAGE(PG8_SB(0, 1), cB + hstepB, voffB); PG8_STAGE(PG8_SA(0, 0), cA, voffA); PG8_STAGE(PG8_SA(0, 1), cA + hstepA, voffA);
        if (wr == 1) PG8_BAR;
        PG8_WAIT_V(2); PG8_BAR;
        PG8_STAGE(PG8_SB(1, 0), cB + kstep, voffB); PG8_STAGE(PG8_SA(1, 0), cA + kstep, voffA); PG8_STAGE(PG8_SB(1, 1), cB + hstepB + kstep, voffB);
        PG8_WAIT_V(6); PG8_BAR;
    } else {
        PG8_STAGE(PG8_SB(0, 0), cB, voffB); PG8_STAGE(PG8_SA(0, 0), cA, voffA); PG8_STAGE(PG8_SB(0, 1), cB + hstepB, voffB); PG8_STAGE(PG8_SA(0, 1), cA + hstepA, voffA);
        if (wr == 1) PG8_BAR;
        PG8_WAIT_V(4); PG8_BAR;
        PG8_STAGE(PG8_SB(1, 0), cB + kstep, voffB); PG8_STAGE(PG8_SA(1, 0), cA + kstep, voffA); PG8_STAGE(PG8_SB(1, 1), cB + hstepB + kstep, voffB);
        PG8_WAIT_V(6); PG8_BAR;
    }
    for (;;) {
        const bool has_next = S.next(ui + 1, nxt);
        const char* nA = has_next ? (const char*)(nxt.kind ? g.A[1] : g.A[0]) + (size_t)nxt.pm * tstepA : cA; const char* nB = has_next ? (const char*)(nxt.kind ? g.Bt[1] : g.Bt[0]) + (size_t)nxt.pn * tstepB : cB;
        for (int t = 0; t < nt; t += 2) {
            const bool last = (t == nt - 2);
            const char* a1 = cA + (size_t)(t + 1) * kstep;
            const char* a2 = last ? nA : cA + (size_t)(t + 2) * kstep; const char* b2 = last ? nB : cB + (size_t)(t + 2) * kstep;
            const char* a3 = a2 + kstep; const char* b3 = b2 + kstep;
            if (last && has_next) S.a_ready(nxt);
            if constexpr (SP2) {
            PG8_LDB(B0, 0, 0); PG8_LDB(B1, 0, 1); PG8_SCHED; PG8_LDA(At, 0, 0); PG8_STAGE(PG8_SA(1, 1), a1 + hstepA, voffA);
            PG8_WAIT_V(8); PG8_WAIT_L(0); PG8_BAR; PG8_MMA(0, 0, At, B0); PG8_MMA(0, 1, At, B1); PG8_BAR; PG8_SCHED;
            PG8_LDA(At, 0, 1); PG8_STAGE(PG8_SB(0, 0), b2, voffB); PG8_STAGE(PG8_SB(0, 1), b2 + hstepB, voffB); PG8_STAGE(PG8_SA(0, 0), a2, voffA);
            PG8_WAIT_V(8); PG8_WAIT_L(0); PG8_BAR; PG8_MMA(1, 0, At, B0); PG8_MMA(1, 1, At, B1); PG8_BAR; PG8_SCHED;
            PG8_LDB(B0, 1, 0); PG8_LDB(B1, 1, 1); PG8_SCHED; PG8_LDA(At, 1, 0); PG8_STAGE(PG8_SA(0, 1), a2 + hstepA, voffA);
            PG8_WAIT_V(8); PG8_WAIT_L(0); PG8_BAR; PG8_MMA(0, 0, At, B0); PG8_MMA(0, 1, At, B1); PG8_BAR; PG8_SCHED;
            PG8_LDA(At, 1, 1); PG8_STAGE(PG8_SB(1, 0), b3, voffB); PG8_STAGE(PG8_SB(1, 1), b3 + hstepB, voffB); PG8_STAGE(PG8_SA(1, 0), a3, voffA);
            PG8_WAIT_V(8); PG8_WAIT_L(0); PG8_BAR; PG8_MMA(1, 0, At, B0); PG8_MMA(1, 1, At, B1); PG8_BAR; PG8_SCHED;
            } else {
            PG8_LDB(B0, 0, 0); PG8_SCHED; PG8_LDA(At, 0, 0); PG8_STAGE(PG8_SA(1, 1), a1 + hstepA, voffA);
            PG8_WAIT_L(8); PG8_BAR; PG8_WAIT_L(0); PG8_MMA(0, 0, At, B0); PG8_BAR; PG8_SCHED;
            PG8_LDB(B1, 0, 1); PG8_STAGE(PG8_SB(0, 0), b2, voffB);
            PG8_BAR; PG8_WAIT_L(0); PG8_MMA(0, 1, At, B1); PG8_BAR;
            PG8_LDA(At, 0, 1); PG8_STAGE(PG8_SA(0, 0), a2, voffA);
            PG8_BAR; PG8_WAIT_L(0); PG8_MMA(1, 0, At, B0); PG8_BAR; PG8_SCHED;
            PG8_STAGE(PG8_SB(0, 1), b2 + hstepB, voffB);
            PG8_WAIT_V(6); PG8_BAR; PG8_MMA(1, 1, At, B1); PG8_BAR;
            PG8_LDB(B0, 1, 0); PG8_SCHED; PG8_LDA(At, 1, 0); PG8_STAGE(PG8_SA(0, 1), a2 + hstepA, voffA);
            PG8_WAIT_L(8); PG8_BAR; PG8_WAIT_L(0); PG8_MMA(0, 0, At, B0); PG8_BAR; PG8_SCHED;
            PG8_LDB(B1, 1, 1); PG8_STAGE(PG8_SB(1, 0), b3, voffB);
            PG8_BAR; PG8_WAIT_L(0); PG8_MMA(0, 1, At, B1); PG8_BAR;
            PG8_LDA(At, 1, 1); PG8_STAGE(PG8_SA(1, 0), a3, voffA);
            PG8_BAR; PG8_WAIT_L(0); PG8_MMA(1, 0, At, B0); PG8_BAR; PG8_SCHED;
            PG8_STAGE(PG8_SB(1, 1), b3 + hstepB, voffB);
            PG8_WAIT_V(6); PG8_BAR; PG8_MMA(1, 1, At, B1); PG8_BAR;
            }
        }
        if constexpr (ALIGN_EPI) { if (wr == 0) PG8_BAR; }
        E(acc, cur, wr, wc, fr, fq); S.done(cur);
        if (!has_next) break;
#pragma unroll
        for (int a = 0; a < 2; ++a)
#pragma unroll
            for (int b = 0; b < 2; ++b)
#pragma unroll
                for (int m = 0; m < 4; ++m)
#pragma unroll
                    for (int n = 0; n < 2; ++n) acc[a][b][m][n] = (f32x4){0.f, 0.f, 0.f, 0.f};
        cur = nxt; cA = nA; cB = nB; ++ui;
        if constexpr (ALIGN_EPI) { if (wr == 1) PG8_BAR; }
    }
    PG8_WAIT_V(0);
    if constexpr (!ALIGN_EPI) { if (wr == 0) PG8_BAR; }
    PG8_BAR;
#undef PG8_SA
#undef PG8_SB
#undef PG8_STAGE
#undef PG8_LDA
#undef PG8_LDB
#undef PG8_MMA
#undef PG8_WAIT_V
#undef PG8_WAIT_L
#undef PG8_BAR
#undef PG8_SCHED
}
}
#ifndef PG8_SP2
#define PG8_SP2 true
#endif
#ifndef PG8_ALIGN
#define PG8_ALIGN true
#endif

constexpr size_t WS_GLA = WS_Z;
constexpr size_t GLA_LT = 0, GLA_OI = 64 * MiB, GLA_ST = 96 * MiB, GLA_QT = 128 * MiB, GLA_DEC = 136 * MiB;
__device__ __forceinline__ int crow(int i, int hh) { return (i & 3) + 8 * (i >> 2) + 4 * hh; }
#define MFMA32(a, b, c) __builtin_amdgcn_mfma_f32_32x32x16_bf16((a), (b), (c), 0, 0, 0)
#define WG_BAR() do { asm volatile("s_waitcnt vmcnt(0) lgkmcnt(0)" ::: "memory"); __builtin_amdgcn_s_barrier(); asm volatile("" ::: "memory"); } while (0)

__device__ __forceinline__ f32x16 mma_lds(const LAS bf16_t* A, int pa, const LAS bf16_t* B, int pb, int K, f32x16 acc, int r, int hh) {
    const LAS bf16_t* ap = A + r * pa + 8 * hh; const LAS bf16_t* bp = B + r * pb + 8 * hh;
    for (int k = 0; k < K; k += 16) acc = MFMA32(*(const LAS bf16x8*)(ap + k), *(const LAS bf16x8*)(bp + k), acc);
    return acc;
}

namespace att {
constexpr float LOG2E = 1.4426950408889634f, C1 = 0.08838834764831845f * LOG2E, THRL = 8.f;
constexpr int KP = 528, VP = 144, VBYTES = 256 * VP, KBYTES = 64 * KP, ABUF = VBYTES + KBYTES, XP = 1040;
__device__ __forceinline__ void stage_tile(LAS unsigned char* buf, const char* kt, const char* vt, int wave, int lane) {
    asm volatile("" : "+v"(lane));
#pragma unroll
    for (int i = 0; i < 5; ++i) { const int iv = wave + 8 * i; if (iv < 36) { const unsigned q = iv * 64 + lane, row = q / 9u, cp = q - 9u * row, cc = cp < 8u ? cp : 7u;
        __builtin_amdgcn_global_load_lds((const GAS unsigned*)(vt + (row * (unsigned)(M * 2) + cc * 16u)), (LAS unsigned*)(buf + iv * 1024), 16, 0, 0); } }
#pragma unroll
    for (int i = 0; i < 5; ++i) { const int ik = wave + 8 * i; if (ik < 33) { const unsigned q = ik * 64 + lane, row = q / 33u, cp = q - 33u * row, cc = cp < 32u ? cp : 31u;
        __builtin_amdgcn_global_load_lds((const GAS unsigned*)(kt + (row * (unsigned)(UNW * 2) + cc * 16u)), (LAS unsigned*)(buf + VBYTES + ik * 1024), 16, 0, 0); } }
}
__device__ __forceinline__ void unit(LAS unsigned char* lds, const bf16_t* UN, const bf16_t* UT, bf16_t* MIX, int b, int h, int qb, float lam, const float* gsub, float post_scale, int wave, int lane) {
    const int mp = wave >> 2, wq = wave & 3, r = lane & 31, hh = lane >> 5;
    const int qpos = qb * 128 + wq * 32 + r, cw = (qb * 128 + wq * 32) >> 6, ntile = 2 * qb + 2;
    const float C2 = __uint_as_float((unsigned)(127 - (h + 1)) << 23) * LOG2E;
    const char* kt = (const char*)(UN + (size_t)(b * SEQ) * UNW + UN_KA + h * 256);
    const char* vt = (const char*)(UT + (size_t)(h * 256) * M + (size_t)b * SEQ);
    bf16x8 qf[8];
    { const bf16_t* qp = UN + (size_t)(b * SEQ + qpos) * UNW + UN_QA + h * 256 + mp * 128 + 8 * hh;
#pragma unroll
      for (int kk = 0; kk < 8; ++kk) qf[kk] = *(const bf16x8*)(qp + 16 * kk); }
    f32x16 O[8];
#pragma unroll
    for (int eb = 0; eb < 8; ++eb)
#pragma unroll
        for (int i = 0; i < 16; ++i) O[eb][i] = 0.f;
    float m_ref = -INFINITY, l_acc = 0.f;
    stage_tile(lds, kt, vt, wave, lane);
    const int kbase = VBYTES + r * KP + mp * 256 + hh * 16, vbase = r * VP + hh * 16;
    for (int j = 0; j < ntile; ++j) {
        WG_BAR();
        LAS unsigned char* buf = lds + (j & 1) * ABUF;
        if (j + 1 < ntile) stage_tile(lds + ((j + 1) & 1) * ABUF, kt + (size_t)(j + 1) * 64 * UNW * 2, vt + (size_t)(j + 1) * 128, wave, lane);
        if (j <= cw) {
            const LAS unsigned char* kp = buf + kbase; const LAS unsigned char* vp = buf + vbase;
#pragma unroll
            for (int hf = 0; hf < 2; ++hf) {
                f32x16 p0;
#pragma unroll
                for (int i = 0; i < 16; ++i) p0[i] = 0.f;
#pragma unroll
                for (int kk = 0; kk < 8; ++kk) p0 = MFMA32(*(const LAS bf16x8*)(kp + hf * 32 * KP + kk * 32), qf[kk], p0);
                const float base0 = (float)(qpos - 64 * j - 32 * hf - 4 * hh);
                float pmax = -INFINITY;
#pragma unroll
                for (int i = 0; i < 16; ++i) { const float off = (float)((i & 3) + 8 * (i >> 2));
                    p0[i] = fmaf(p0[i], C1, -C2 * fabsf(base0 - off)); pmax = fmaxf(pmax, p0[i]); }
                { auto rr = __builtin_amdgcn_permlane32_swap(__float_as_uint(pmax), __float_as_uint(pmax), false, false); pmax = fmaxf(__uint_as_float(rr[0]), __uint_as_float(rr[1])); }
                if (!__all(pmax - m_ref <= THRL)) {
                    const float mn = fmaxf(m_ref, pmax), alpha = __builtin_amdgcn_exp2f(m_ref - mn); m_ref = mn; l_acc *= alpha;
#pragma unroll
                    for (int eb = 0; eb < 8; ++eb)
#pragma unroll
                        for (int i = 0; i < 16; ++i) O[eb][i] *= alpha;
                }
                float ps = 0.f;
#pragma unroll
                for (int i = 0; i < 16; ++i) { p0[i] = __builtin_amdgcn_exp2f(p0[i] - m_ref); ps += p0[i]; }
                l_acc += ps;
                bf16x8 pf[2];
#define PK4(P, BASE, OUT) do { const unsigned a0 = cvt_pk_bf16(P[BASE + 0], P[BASE + 1]), a1 = cvt_pk_bf16(P[BASE + 2], P[BASE + 3]); \
    const unsigned b0 = cvt_pk_bf16(P[BASE + 4], P[BASE + 5]), b1 = cvt_pk_bf16(P[BASE + 6], P[BASE + 7]); \
    auto r0 = __builtin_amdgcn_permlane32_swap(a0, b0, false, false); auto r1 = __builtin_amdgcn_permlane32_swap(a1, b1, false, false); \
    u32x4 w = {r0[0], r1[0], r0[1], r1[1]}; OUT = *reinterpret_cast<bf16x8*>(&w); } while (0)
                PK4(p0, 0, pf[0]); PK4(p0, 8, pf[1]);
#undef PK4
#define LDV(EB, S2) (*(const LAS bf16x8*)(vp + (EB) * 32 * VP + (4 * hf + 2 * (S2)) * 16))
                { bf16x8 va[4] = {LDV(0, 0), LDV(0, 1), LDV(1, 0), LDV(1, 1)};
#pragma unroll
                  for (int eb = 0; eb < 8; eb += 2) { bf16x8 vn[4];
                      if (eb < 6) { vn[0] = LDV(eb + 2, 0); vn[1] = LDV(eb + 2, 1); vn[2] = LDV(eb + 3, 0); vn[3] = LDV(eb + 3, 1); }
                      O[eb] = MFMA32(va[0], pf[0], O[eb]); O[eb + 1] = MFMA32(va[2], pf[0], O[eb + 1]); O[eb] = MFMA32(va[1], pf[1], O[eb]); O[eb + 1] = MFMA32(va[3], pf[1], O[eb + 1]);
                      __builtin_amdgcn_sched_barrier(0);
                      if (eb < 6) { va[0] = vn[0]; va[1] = vn[1]; va[2] = vn[2]; va[3] = vn[3]; } } }
#undef LDV
            }
        }
    }
    { auto rr = __builtin_amdgcn_permlane32_swap(__float_as_uint(l_acc), __float_as_uint(l_acc), false, false); l_acc = __uint_as_float(rr[0]) + __uint_as_float(rr[1]); }
    WG_BAR();
    LAS unsigned char* xp = lds + (wq * 32 + r) * XP + hh * 16;
    if (mp == 1) {
        const float inv = lam / l_acc;
#pragma unroll
        for (int eb = 0; eb < 8; ++eb)
#pragma unroll
            for (int g4 = 0; g4 < 4; ++g4) { const f32x4 v = {O[eb][4 * g4] * inv, O[eb][4 * g4 + 1] * inv, O[eb][4 * g4 + 2] * inv, O[eb][4 * g4 + 3] * inv};
                *(LAS f32x4*)(xp + (8 * eb + 2 * g4) * 16) = v; }
    }
    WG_BAR();
    if (mp == 0) {
        const float inv = 1.f / l_acc; float ss = 0.f;
#pragma unroll
        for (int eb = 0; eb < 8; ++eb) {
#pragma unroll
            for (int g4 = 0; g4 < 4; ++g4) { const f32x4 x = *(const LAS f32x4*)(xp + (8 * eb + 2 * g4) * 16);
#pragma unroll
                for (int e = 0; e < 4; ++e) { const float v = O[eb][4 * g4 + e] * inv - x[e]; O[eb][4 * g4 + e] = v; ss += v * v; } }
            asm volatile("" ::: "memory"); }
        { auto rr = __builtin_amdgcn_permlane32_swap(__float_as_uint(ss), __float_as_uint(ss), false, false); ss = __uint_as_float(rr[0]) + __uint_as_float(rr[1]); }
        const float rs = rsqrtf(ss * (1.f / 256.f) + EPS) * post_scale;
        bf16_t* op = MIX + (size_t)(b * SEQ + qpos) * D + h * 256 + 4 * hh; const float* gp = gsub + 4 * hh;
#pragma unroll
        for (int eb = 0; eb < 8; ++eb) {
#pragma unroll
            for (int g4 = 0; g4 < 4; ++g4) { const int e0 = 32 * eb + 8 * g4; const f32x4 g = *(const f32x4*)(gp + e0);
                u32x2 w; w.x = cvt_pk_bf16(O[eb][4 * g4] * rs * g[0], O[eb][4 * g4 + 1] * rs * g[1]); w.y = cvt_pk_bf16(O[eb][4 * g4 + 2] * rs * g[2], O[eb][4 * g4 + 3] * rs * g[3]);
                *(u32x2*)(op + e0) = w; }
            asm volatile("" ::: "memory"); }
    }
    WG_BAR();
}
}

namespace gla {
constexpr int O_LA = 0, O_ZL = 32768, O_QT = 36864, O_KT = 54272, O_KHT = 71680, O_VT = 90112, O_AM = 0;
constexpr int PQ = 136, PS = 72;
__device__ __forceinline__ void g1_unit(LAS unsigned char* lds, const bf16_t* UN, const bf16_t* UT, const float* ZLR, const float* w2, const float* bgate, unsigned char* gs, int u, int tid, int wave, int lane) {
    const int c = u & 63, h = (u >> 6) & 3, b = u >> 8; const size_t tok0 = (size_t)b * SEQ + c * 64;
    LAS float* LA = (LAS float*)(lds + O_LA); LAS float* ZL = (LAS float*)(lds + O_ZL);
    LAS bf16_t* QT = (LAS bf16_t*)(lds + O_QT); LAS bf16_t* KT = (LAS bf16_t*)(lds + O_KT); LAS bf16_t* KHT = (LAS bf16_t*)(lds + O_KHT); LAS bf16_t* VT = (LAS bf16_t*)(lds + O_VT); LAS bf16_t* AM = (LAS bf16_t*)(lds + O_AM);
    if (tid < 256) *(LAS f32x4*)(ZL + tid * 4) = *(const f32x4*)(ZLR + tok0 * 16 + tid * 4);
#pragma unroll
    for (int i = 0; i < 4; ++i) { const int id = tid + 512 * i, row = id >> 3, ch = id & 7;
        *(LAS u32x4*)(VT + row * PS + ch * 8) = *(const u32x4*)(UT + (size_t)(2048 + h * 256 + row) * M + tok0 + ch * 8); }
    WG_BAR();
    const int d = tid & 127, qd = tid >> 7;
    float bt[16];
    { float w[16];
#pragma unroll
      for (int rr = 0; rr < 16; ++rr) w[rr] = w2[rr * 512 + h * 128 + d];
      const float bias = bgate[h * 128 + d]; float run = 0.f;
#pragma unroll
      for (int i = 0; i < 16; ++i) { const int t = qd * 16 + i; float x = bias;
#pragma unroll
          for (int rr = 0; rr < 16; ++rr) x += ZL[t * 16 + rr] * w[rr];
          const float ls = fminf(x, 0.f) - log1pf(__expf(-fabsf(x)));
          run += ls * (1.f / 16.f); bt[i] = run; }
      WG_BAR();
      ZL[qd * 128 + d] = run; }
    WG_BAR();
    float off = 0.f, btot = 0.f;
#pragma unroll
    for (int q = 0; q < 4; ++q) { const float p = ZL[q * 128 + d]; btot += p; if (q < qd) off += p; }
    bf16_t* QTg = (bf16_t*)(gs + GLA_QT) + (size_t)u * 64 * 128;
#pragma unroll
    for (int i = 0; i < 16; ++i) { const int t = qd * 16 + i; const float bb = bt[i] + off;
        const float qv = bf2f(UN[(tok0 + t) * UNW + UN_QB + h * 128 + d]) * 0.08838834764831845f, kv = bf2f(UN[(tok0 + t) * UNW + UN_KB + h * 128 + d]);
        const bf16_t qt = f2bf(qv * __expf(bb));
        QT[t * PQ + d] = qt; QTg[t * 128 + d] = qt; KT[t * PQ + d] = f2bf(kv * __expf(-bb)); KHT[d * PS + t] = f2bf(kv * __expf(btot - bb)); }
    if (qd == 0) ((float*)(gs + GLA_DEC))[(size_t)u * 128 + d] = __expf(btot);
    WG_BAR();
    const int r = lane & 31, hh = lane >> 5;
    f32x16 zero;
#pragma unroll
    for (int i = 0; i < 16; ++i) zero[i] = 0.f;
    if (wave < 4) {
        const int mi = wave >> 1, ni = wave & 1;
        const f32x16 a = mma_lds(QT + 32 * mi * PQ, PQ, KT + 32 * ni * PQ, PQ, 128, zero, r, hh);
#pragma unroll
        for (int i = 0; i < 16; ++i) { const int t = 32 * mi + crow(i, hh), s = 32 * ni + r; AM[t * PS + s] = f2bf(s <= t ? a[i] : 0.f); }
    }
    { float* LT = (float*)(gs + GLA_LT) + (size_t)u * 256 * 128;
#pragma unroll
      for (int db = 0; db < 4; ++db) { const f32x16 a = mma_lds(VT + 32 * wave * PS, PS, KHT + 32 * db * PS, PS, 64, zero, r, hh);
#pragma unroll
          for (int i = 0; i < 16; ++i) LT[(size_t)(32 * wave + crow(i, hh)) * 128 + 32 * db + r] = a[i]; } }
    WG_BAR();
    { float* OI = (float*)(gs + GLA_OI) + (size_t)u * 64 * 256;
#pragma unroll
      for (int tb = 0; tb < 2; ++tb) { const f32x16 a = mma_lds(AM + 32 * tb * PS, PS, VT + 32 * wave * PS, PS, 64, zero, r, hh);
#pragma unroll
          for (int i = 0; i < 16; ++i) OI[(size_t)(32 * tb + crow(i, hh)) * 256 + 32 * wave + r] = a[i]; } }
    WG_BAR();
}
__device__ __forceinline__ void g2_scan(unsigned char* gs, int p) {
    const int bh = p >> 14, rem = p & 16383, e = rem >> 6, d2 = (rem & 63) * 2;
    const float* LT = (const float*)(gs + GLA_LT); const float* DEC = (const float*)(gs + GLA_DEC); bf16_t* ST = (bf16_t*)(gs + GLA_ST);
    float s0 = 0.f, s1 = 0.f;
#pragma unroll 8
    for (int c = 0; c < 64; ++c) { const size_t u = (size_t)bh * 64 + c;
        *(unsigned*)(ST + (u * 256 + e) * 128 + d2) = cvt_pk_bf16(s0, s1);
        const f32x2 dc = *(const f32x2*)(DEC + u * 128 + d2), lv = *(const f32x2*)(LT + (u * 256 + e) * 128 + d2);
        s0 = dc.x * s0 + lv.x; s1 = dc.y * s1 + lv.y; }
}
__device__ __forceinline__ void g3_unit(LAS unsigned char* lds, const bf16_t* UN, unsigned char* gs, const float* ggla, bf16_t* MIX, int u, int tid, int wave, int lane) {
    const int c = u & 63, h = (u >> 6) & 3, b = u >> 8; const size_t tok0 = (size_t)b * SEQ + c * 64;
    LAS bf16_t* QT = (LAS bf16_t*)lds; LAS bf16_t* STs = (LAS bf16_t*)(lds + 17408); LAS float* OT = (LAS float*)lds;
    const bf16_t* QTg = (const bf16_t*)(gs + GLA_QT) + (size_t)u * 64 * 128; const bf16_t* ST = (const bf16_t*)(gs + GLA_ST) + (size_t)u * 256 * 128;
#pragma unroll
    for (int i = 0; i < 2; ++i) { const int id = tid + 512 * i, row = id >> 4, ch = id & 15; *(LAS u32x4*)(QT + row * PQ + ch * 8) = *(const u32x4*)(QTg + row * 128 + ch * 8); }
#pragma unroll
    for (int i = 0; i < 8; ++i) { const int id = tid + 512 * i, row = id >> 4, ch = id & 15; *(LAS u32x4*)(STs + row * PQ + ch * 8) = *(const u32x4*)(ST + row * 128 + ch * 8); }
    const int r = lane & 31, hh = lane >> 5;
    const float* OI = (const float*)(gs + GLA_OI) + (size_t)u * 64 * 256;
    f32x16 acc[2];
#pragma unroll
    for (int tb = 0; tb < 2; ++tb)
#pragma unroll
        for (int i = 0; i < 16; ++i) acc[tb][i] = OI[(size_t)(32 * tb + crow(i, hh)) * 256 + 32 * wave + r];
    WG_BAR();
#pragma unroll
    for (int tb = 0; tb < 2; ++tb) acc[tb] = mma_lds(QT + 32 * tb * PQ, PQ, STs + 32 * wave * PQ, PQ, 128, acc[tb], r, hh);
    WG_BAR();
#pragma unroll
    for (int tb = 0; tb < 2; ++tb)
#pragma unroll
        for (int i = 0; i < 16; ++i) OT[(32 * tb + crow(i, hh)) * 260 + 32 * wave + r] = acc[tb][i];
    WG_BAR();
    { const int t = tid >> 3, part = tid & 7; const LAS float* op = OT + t * 260 + part * 32; float v[32]; float ss = 0.f;
#pragma unroll
      for (int q = 0; q < 8; ++q) { const f32x4 x = *(const LAS f32x4*)(op + 4 * q); v[4 * q] = x[0]; v[4 * q + 1] = x[1]; v[4 * q + 2] = x[2]; v[4 * q + 3] = x[3]; ss += x[0] * x[0] + x[1] * x[1] + x[2] * x[2] + x[3] * x[3]; }
      ss += __shfl_xor(ss, 1); ss += __shfl_xor(ss, 2); ss += __shfl_xor(ss, 4);
      const float rs = rsqrtf(ss * (1.f / 256.f) + EPS);
      const bf16_t* gbp = UN + (tok0 + t) * UNW + UN_GB + h * 256 + part * 32; const float* gg = ggla + h * 256 + part * 32;
      bf16_t* mp = MIX + (tok0 + t) * D + 2048 + h * 256 + part * 32;
#pragma unroll
      for (int q = 0; q < 4; ++q) { const bf16x8 gv = *(const bf16x8*)(gbp + 8 * q); float o[8];
#pragma unroll
          for (int e = 0; e < 8; ++e) { const float g = bf2f((bf16_t)gv[e]); o[e] = v[8 * q + e] * rs * gg[8 * q + e] * (g / (1.f + __expf(-g))); }
          u32x4 w; w.x = cvt_pk_bf16(o[0], o[1]); w.y = cvt_pk_bf16(o[2], o[3]); w.z = cvt_pk_bf16(o[4], o[5]); w.w = cvt_pk_bf16(o[6], o[7]);
          *(u32x4*)(mp + 8 * q) = w; } }
    WG_BAR();
}
}

__device__ __forceinline__ void pool_unit(LAS unsigned char* lds, const bf16_t* UN, const bf16_t* WP, const float* pscale, bf16_t* MIX, int pu, int tid, int wave, int lane) {
    const int g = pu & 3, rb = pu >> 2, w = 2 << g; const size_t tok0 = (size_t)rb * 128;
    LAS bf16_t* DT = (LAS bf16_t*)lds; constexpr int PD = 264;
    { const int c = tid & 255, half = tid >> 8, tf = (int)(tok0 & (SEQ - 1)) + 64 * half;
      const bf16_t* up = UN + (tok0 + 64 * half) * UNW + UN_UC + g * 256 + c;
      float s = 0.f;
      for (int j = 1; j < w; ++j) if (tf - j >= 0) s += bf2f(up[-(ptrdiff_t)j * UNW]);
      for (int i = 0; i < 64; ++i) { const int t = tf + i; const float ut = bf2f(up[(size_t)i * UNW]);
          s += ut; const int cnt = (t + 1 < w) ? t + 1 : w;
          DT[(64 * half + i) * PD + c] = f2bf(s / (float)cnt - ut);
          if (t + 1 - w >= 0) s -= bf2f(up[(ptrdiff_t)(i + 1 - w) * UNW]); } }
    WG_BAR();
    const int r = lane & 31, hh = lane >> 5;
    f32x16 acc[4];
#pragma unroll
    for (int mb = 0; mb < 4; ++mb)
#pragma unroll
        for (int i = 0; i < 16; ++i) acc[mb][i] = 0.f;
    const bf16_t* bp = WP + (size_t)g * 65536 + (size_t)(32 * wave + r) * 256 + 8 * hh;
#pragma unroll 4
    for (int ks = 0; ks < 16; ++ks) { const bf16x8 bf = *(const bf16x8*)(bp + 16 * ks);
#pragma unroll
        for (int mb = 0; mb < 4; ++mb) acc[mb] = MFMA32(*(const LAS bf16x8*)(DT + (32 * mb + r) * PD + 16 * ks + 8 * hh), bf, acc[mb]); }
    const int n = 32 * wave + r; const float sc = pscale[g * 256 + n];
#pragma unroll
    for (int mb = 0; mb < 4; ++mb)
#pragma unroll
        for (int i = 0; i < 16; ++i) MIX[(tok0 + 32 * mb + crow(i, hh)) * D + 3072 + g * 256 + n] = f2bf(acc[mb][i] * sc);
    WG_BAR();
}

#define LDS_WAIT() asm volatile("s_waitcnt lgkmcnt(0)" ::: "memory")
#define VM_WAIT() asm volatile("s_waitcnt vmcnt(0)" ::: "memory")
__device__ __forceinline__ unsigned pk2(float lo, float hi) { return (unsigned)f2bf(lo) | ((unsigned)f2bf(hi) << 16); }

__device__ __forceinline__ void cvt_item(const float* __restrict__ W, int ldw, int srccol, int nvalid, bf16_t* __restrict__ Wt, int K, int dstrow, int k0, LAS float* scr, int lane) {
    const int c = lane & 31;
#pragma unroll 8
    for (int i = 0; i < 32; ++i) { const int kk = 2 * i + (lane >> 5); scr[kk * 33 + c] = (c < nvalid) ? W[(size_t)(k0 + kk) * ldw + srccol + c] : 0.f; }
    LDS_WAIT(); asm volatile("" ::: "memory");
    const int c8 = lane & 7;
#pragma unroll
    for (int j = 0; j < 4; ++j) { const int n = (lane >> 3) + 8 * j; const LAS float* s = scr + (8 * c8) * 33 + n;
        u32x4 o; o.x = pk2(s[0 * 33], s[1 * 33]); o.y = pk2(s[2 * 33], s[3 * 33]); o.z = pk2(s[4 * 33], s[5 * 33]); o.w = pk2(s[6 * 33], s[7 * 33]);
        *(u32x4*)(Wt + (size_t)(dstrow + n) * K + k0 + 8 * c8) = o; }
    LDS_WAIT(); asm volatile("" ::: "memory");
}
__device__ __forceinline__ int win_src_col(int d) {
    if (d < 2048) return d + (SRC_QA - 0);
    if (d < 4096) return d + (SRC_KA - 2048);
    if (d < 4608) return d + (SRC_QB - 4096);
    if (d < 5120) return d + (SRC_KB - 4608);
    if (d < 6144) return d + (SRC_GB - 5120);
    if (d < 7168) return d + (SRC_UC - 6144);
    if (d < 9216) return d + (SRC_VA - 7168);
    return d + (SRC_VB - 9216);
}
constexpr int I_IN = 64 * 320, I_Z = 64, I_O = 64 * 128, I_UP = 64 * 688, I_DN = 172 * 128, I_P = 128, I_LAYER = I_IN + I_Z + I_O + I_UP + I_DN + I_P;

__device__ __forceinline__ void norm_row(const float* X, float* H, const float* Y, const float* gpost, const float* gnext, bf16_t* HN, int row, int lane) {
    f32x4 hv[16];
    const f32x4* src = (const f32x4*)((X ? X : H) + (size_t)row * D) + lane;
#pragma unroll
    for (int j = 0; j < 16; ++j) hv[j] = src[64 * j];
    if (Y) {
        const f32x4* yp = (const f32x4*)(Y + (size_t)row * D) + lane;
        f32x4 yv[16]; float s = 0.f;
#pragma unroll
        for (int j = 0; j < 16; ++j) { yv[j] = yp[64 * j]; s += yv[j].x * yv[j].x + yv[j].y * yv[j].y + yv[j].z * yv[j].z + yv[j].w * yv[j].w; }
        const float rs = rsqrtf(wave_sum(s) * (1.f / D) + EPS);
#pragma unroll
        for (int j = 0; j < 16; ++j) { const f32x4 g = ((const f32x4*)gpost)[lane + 64 * j]; hv[j] += yv[j] * rs * g; }
    }
    if (X || Y) {
        f32x4* hp = (f32x4*)(H + (size_t)row * D) + lane;
#pragma unroll
        for (int j = 0; j < 16; ++j) hp[64 * j] = hv[j];
    }
    if (gnext) {
        float s = 0.f;
#pragma unroll
        for (int j = 0; j < 16; ++j) s += hv[j].x * hv[j].x + hv[j].y * hv[j].y + hv[j].z * hv[j].z + hv[j].w * hv[j].w;
        const float rs = rsqrtf(wave_sum(s) * (1.f / D) + EPS);
        u32x2* op = (u32x2*)(HN + (size_t)row * D) + lane;
#pragma unroll
        for (int j = 0; j < 16; ++j) { const f32x4 g = ((const f32x4*)gnext)[lane + 64 * j]; const f32x4 v = hv[j] * rs * g;
            u32x2 o; o.x = cvt_pk_bf16(v.x, v.y); o.y = cvt_pk_bf16(v.z, v.w); op[64 * j] = o; }
    }
}

__device__ __forceinline__ void zlr_rows(const bf16_t* HN, const bf16_t* WZ, float* ZLR, int rb, LAS unsigned char* lds, int tid, int wave, int lane) {
    const int r = lane & 31, h = lane >> 5;
    f32x16 acc;
#pragma unroll
    for (int e = 0; e < 16; ++e) acc[e] = 0.f;
    const bf16_t* ap = HN + (size_t)(rb * 32 + r) * D + wave * 512 + 8 * h;
    const bf16_t* bp = WZ + (size_t)r * D + wave * 512 + 8 * h;
#pragma unroll 8
    for (int k = 0; k < 512; k += 16) acc = __builtin_amdgcn_mfma_f32_32x32x16_bf16(*(const bf16x8*)(ap + k), *(const bf16x8*)(bp + k), acc, 0, 0, 0);
    LAS float* red = (LAS float*)lds;
    if (r < 16) {
#pragma unroll
        for (int e = 0; e < 16; ++e) red[(wave * 32 + (e & 3) + 8 * (e >> 2) + 4 * h) * 16 + r] = acc[e];
    }
    __syncthreads();
    { const int row = tid >> 4, n = tid & 15; float s = 0.f;
#pragma unroll
      for (int w = 0; w < 8; ++w) s += red[(w * 32 + row) * 16 + n];
      ZLR[(size_t)(rb * 32 + row) * 16 + n] = s; }
    __syncthreads();
}

__device__ __forceinline__ float gelu_tanh_fast(float x) { const float u = 1.5957691216057308f * (x + 0.044715f * x * x * x); return x / (1.f + __expf(-u)); }
__device__ __forceinline__ void conv_run(const bf16_t* Z, const float* wc, const float* bc, bf16_t* F, int run, int tid) {
    const size_t t0 = (size_t)run * 32; const bool first = ((run * 32) & (SEQ - 1)) == 0;
    for (int oc = tid; oc < DFF / 8; oc += 512) {
        const int c0 = oc * 8;
        float wg[3][8], wv[3][8], bg[8], bv[8];
#pragma unroll
        for (int j = 0; j < 3; ++j)
#pragma unroll
            for (int q = 0; q < 2; ++q) { const f32x4 a = *(const f32x4*)(wc + (size_t)j * NUP + c0 + 4 * q), b = *(const f32x4*)(wc + (size_t)j * NUP + DFF + c0 + 4 * q);
#pragma unroll
                for (int e = 0; e < 4; ++e) { wg[j][4 * q + e] = a[e]; wv[j][4 * q + e] = b[e]; } }
#pragma unroll
        for (int q = 0; q < 2; ++q) { const f32x4 a = *(const f32x4*)(bc + c0 + 4 * q), b = *(const f32x4*)(bc + DFF + c0 + 4 * q);
#pragma unroll
            for (int e = 0; e < 4; ++e) { bg[4 * q + e] = a[e]; bv[4 * q + e] = b[e]; } }
        float g2[8], g1[8], v2[8], v1[8];
        if (first) {
#pragma unroll
            for (int e = 0; e < 8; ++e) { g2[e] = 0.f; g1[e] = 0.f; v2[e] = 0.f; v1[e] = 0.f; }
        } else {
            const bf16x8 a2 = *(const bf16x8*)(Z + (t0 - 2) * NUP + c0), a1 = *(const bf16x8*)(Z + (t0 - 1) * NUP + c0), b2 = *(const bf16x8*)(Z + (t0 - 2) * NUP + DFF + c0), b1 = *(const bf16x8*)(Z + (t0 - 1) * NUP + DFF + c0);
#pragma unroll
            for (int e = 0; e < 8; ++e) { g2[e] = bf2f((bf16_t)a2[e]); g1[e] = bf2f((bf16_t)a1[e]); v2[e] = bf2f((bf16_t)b2[e]); v1[e] = bf2f((bf16_t)b1[e]); }
        }
#pragma unroll 4
        for (int r = 0; r < 32; ++r) {
            const bf16x8 a0 = *(const bf16x8*)(Z + (t0 + r) * NUP + c0), b0 = *(const bf16x8*)(Z + (t0 + r) * NUP + DFF + c0);
            float o[8];
#pragma unroll
            for (int e = 0; e < 8; ++e) { const float g0 = bf2f((bf16_t)a0[e]), v0 = bf2f((bf16_t)b0[e]);
                const float gt = bg[e] + wg[0][e] * g2[e] + wg[1][e] * g1[e] + wg[2][e] * g0, vl = bv[e] + wv[0][e] * v2[e] + wv[1][e] * v1[e] + wv[2][e] * v0;
                o[e] = gelu_tanh_fast(gt) * vl; g2[e] = g1[e]; g1[e] = g0; v2[e] = v1[e]; v1[e] = v0; }
            u32x4 w; w.x = cvt_pk_bf16(o[0], o[1]); w.y = cvt_pk_bf16(o[2], o[3]); w.z = cvt_pk_bf16(o[4], o[5]); w.w = cvt_pk_bf16(o[6], o[7]);
            *(u32x4*)(F + (t0 + r) * DFF + c0) = w;
        }
    }
}

constexpr int NPH = 21;
struct Args { const float* in[21]; float* out; unsigned char* ws; int ph_lo, ph_hi; };

__device__ __forceinline__ const void* lds_ptr(volatile LAS unsigned* A, int i) {
    const unsigned lo = __builtin_amdgcn_readfirstlane(A[2 * i]), hi = __builtin_amdgcn_readfirstlane(A[2 * i + 1]);
    return (const void*)(const GAS void*)(((unsigned long long)hi << 32) | (unsigned long long)lo);
}
constexpr int ARGS_OFF = RING_BYTES + 1024;
template <int LO, int HI> __global__ void __launch_bounds__(512, 2) fwd(Args args) {
    extern __shared__ __attribute__((aligned(16))) unsigned char lds_raw[];
    LAS unsigned char* lds = (LAS unsigned char*)lds_raw;
    volatile LAS unsigned* MISC = (volatile LAS unsigned*)(lds + MISC_OFF);
    volatile LAS unsigned* AP = (volatile LAS unsigned*)(lds + ARGS_OFF);
    const int wave = __builtin_amdgcn_readfirstlane((int)threadIdx.x >> 6);
#define FRESH_TID() int tid = threadIdx.x; asm volatile("" : "+v"(tid)); const int lane = tid & 63
#define P(i) ((const float*)lds_ptr(AP, (i)))
#define WSP() ((unsigned char*)lds_ptr(AP, 22))
    const int G = gridDim.x; const int bx = blockIdx.x; const int vcu = (G % 8 == 0) ? (bx % 8) * (G / 8) + bx / 8 : bx;
    constexpr int lo = LO, hi = HI;
    for (int u = threadIdx.x; u < (LDS_BYTES - LDSCTL_OFF) / 4; u += 512) ((LAS unsigned*)(lds + LDSCTL_OFF))[u] = 0u;
    __syncthreads();
    if (threadIdx.x == 0) {
        volatile LAS unsigned long long* A8 = (volatile LAS unsigned long long*)(lds + ARGS_OFF);
#pragma unroll
        for (int i = 0; i < 21; ++i) A8[i] = (unsigned long long)args.in[i];
        A8[21] = (unsigned long long)args.out; A8[22] = (unsigned long long)args.ws;
    }
    __syncthreads();
    XcdBarrier bar; bar.bar = (unsigned*)(WSP() + WS_CTL) + CW_BAR; bar.x = 0; bar.st = nullptr;
    if (hi - lo > 1) bar = xcd_barrier_post((unsigned*)(WSP() + WS_CTL) + CW_BAR, MISC + 8);
#define IN(k) (lo <= (k) && (k) < hi)
#define BOTH(k) (IN(k) && IN((k) + 1))
#define GRID_BAR(k) do { if (BOTH(k)) xcd_barrier(bar); } while (0)
    const int gw = vcu * 8 + wave, NGW = G * 8;

    if (IN(0)) {
        FRESH_TID();
        unsigned char* ws = WSP();
        LAS float* scr = (LAS float*)(lds + wave * 16384);
        for (int it = gw; it < 2 * I_LAYER; it += NGW) {
            const int l = it >= I_LAYER ? 1 : 0; int r = it - l * I_LAYER;
            unsigned char* wl = ws + WS_W0 + (size_t)l * W_LAYER;
            if (r < I_IN) { const int kb = r / 320, nb = r % 320, d0 = nb * 32; cvt_item(P(1) + (size_t)l * D * NIN, NIN, win_src_col(d0), 32, (bf16_t*)(wl + OFF_WN), D, d0, kb * 64, scr, lane); continue; } r -= I_IN;
            if (r < I_Z) { cvt_item(P(1) + (size_t)l * D * NIN, NIN, SRC_ZLR, 16, (bf16_t*)(wl + OFF_WZ), D, 0, r * 64, scr, lane); continue; } r -= I_Z;
            if (r < I_O) { const int kb = r / 128, nb = r % 128; cvt_item(P(12) + (size_t)l * D * D, D, nb * 32, 32, (bf16_t*)(wl + OFF_WO), D, nb * 32, kb * 64, scr, lane); continue; } r -= I_O;
            if (r < I_UP) { const int kb = r / 688, nb = r % 688; cvt_item(P(13) + (size_t)l * D * NUP, NUP, nb * 32, 32, (bf16_t*)(wl + OFF_WUP), D, nb * 32, kb * 64, scr, lane); continue; } r -= I_UP;
            if (r < I_DN) { const int kb = r / 128, nb = r % 128; cvt_item(P(16) + (size_t)l * DFF * D, D, nb * 32, 32, (bf16_t*)(wl + OFF_WDN), DFF, nb * 32, kb * 64, scr, lane); continue; } r -= I_DN;
            { const int g = r >> 5, kb = (r >> 3) & 3, nb = r & 7; cvt_item(P(10) + ((size_t)l * 4 + g) * 65536, 256, nb * 32, 32, (bf16_t*)(wl + OFF_WP) + (size_t)g * 65536, 256, nb * 32, kb * 64, scr, lane); }
        }
        { const float* x = P(0); float* H = (float*)P(21); const float* g0 = P(17); bf16_t* HN = (bf16_t*)(ws + WS_HN);
          for (int m = gw; m < M; m += NGW) norm_row(x, H, nullptr, nullptr, g0, HN, m, lane); }
        GRID_BAR(0);
    }

    _Pragma("unroll") for (int l = 0; l < DEPTH; ++l) {
        const int pb = 1 + 10 * l;
        if (IN(pb + 0)) {
            unsigned char* ws = WSP(); unsigned char* wl = ws + WS_W0 + (size_t)l * W_LAYER;
            const bf16_t* HN = (const bf16_t*)(ws + WS_HN);
            { pg8::Gemm g; g.A[0] = HN; g.Bt[0] = (const bf16_t*)(wl + OFF_WN); g.A[1] = (const bf16_t*)(wl + OFF_WT); g.Bt[1] = HN; g.lda = D; g.ldb = D; g.K = D;
              pg8::Order2 S; S.nM0 = M / 256; S.nN0 = UNW / 256; S.nM1 = UTW / 256; S.nN1 = M / 256; S.G = G; S.c = bx;
              pg8::EpiBf16 E; E.O[0] = (bf16_t*)(ws + WS_UN); E.ldc[0] = UNW; E.O[1] = (bf16_t*)(ws + WS_UT); E.ldc[1] = M;
              pg8::gemm_phase<pg8::EpiBf16, pg8::Order2, PG8_ALIGN, PG8_SP2>(lds, g, S, E); }
            FRESH_TID();
            for (int rb = bx; rb < M / 32; rb += G) zlr_rows(HN, (const bf16_t*)(wl + OFF_WZ), (float*)(ws + WS_ZLR), rb, lds, tid, wave, lane);
            GRID_BAR(pb + 0);
        }
        if (IN(pb + 1)) {
            FRESH_TID();
            unsigned char* ws = WSP(); unsigned char* gs = ws + WS_GLA;
            const bf16_t* UN = (const bf16_t*)(ws + WS_UN); const bf16_t* UT = (const bf16_t*)(ws + WS_UT); bf16_t* MIX = (bf16_t*)(ws + WS_MIX);
            { const float* w2 = P(2) + (size_t)l * 16 * 512; const float* bgt = P(3) + (size_t)l * 512; const float* ZLR = (const float*)(ws + WS_ZLR);
              FRESH_TID();
              for (int u = vcu; u < 512; u += G) gla::g1_unit(lds, UN, UT, ZLR, w2, bgt, gs, u, tid, wave, lane); }
            { const bf16_t* WP = (const bf16_t*)(ws + WS_W0 + (size_t)l * W_LAYER + OFF_WP); const float* psc = P(11) + (size_t)l * 1024;
              FRESH_TID();
              for (int pu = vcu; pu < 256; pu += G) pool_unit(lds, UN, WP, psc, MIX, pu, tid, wave, lane); }
            { const float lam_init = 0.8f - 0.6f * expf(-0.3f * (float)l);
              float lam = lam_of(P(4) + l * 128, P(5) + l * 128, P(6) + l * 128, P(7) + l * 128, lane, lam_init);
              lam = __uint_as_float(__builtin_amdgcn_readfirstlane(__float_as_uint(lam)));
              const float* gsub = P(8) + l * 256;
              FRESH_TID();
              for (int it = vcu; it < 256; it += G) { const int bh = it >> 4, x = it & 15;
                  att::unit(lds, UN, UT, MIX, bh >> 3, bh & 7, x, lam, gsub, 1.f - lam_init, wave, lane);
                  att::unit(lds, UN, UT, MIX, bh >> 3, bh & 7, 31 - x, lam, gsub, 1.f - lam_init, wave, lane); } }
            GRID_BAR(pb + 1);
        }
        if (IN(pb + 2)) {
            FRESH_TID();
            unsigned char* gs = WSP() + WS_GLA;
            for (int p = vcu * 512 + tid; p < 131072; p += G * 512) gla::g2_scan(gs, p);
            GRID_BAR(pb + 2);
        }
        if (IN(pb + 3)) {
            FRESH_TID();
            unsigned char* ws = WSP(); unsigned char* gs = ws + WS_GLA; const float* gg = P(9) + (size_t)l * 1024;
            for (int u = vcu; u < 512; u += G) gla::g3_unit(lds, (const bf16_t*)(ws + WS_UN), gs, gg, (bf16_t*)(ws + WS_MIX), u, tid, wave, lane);
            GRID_BAR(pb + 3);
        }
        if (IN(pb + 4)) {
            unsigned char* ws = WSP(); unsigned char* wl = ws + WS_W0 + (size_t)l * W_LAYER;
            pg8::Gemm g; g.A[0] = (const bf16_t*)(ws + WS_MIX); g.Bt[0] = (const bf16_t*)(wl + OFF_WO); g.A[1] = g.A[0]; g.Bt[1] = g.Bt[0]; g.lda = D; g.ldb = D; g.K = D;
            pg8::Order2 S; S.nM0 = M / 256; S.nN0 = D / 256; S.nM1 = 0; S.nN1 = 1; S.G = G; S.c = bx;
            pg8::EpiF32 E; E.C = (float*)(ws + WS_Y); E.ldc = D;
            pg8::gemm_phase<pg8::EpiF32, pg8::Order2, PG8_ALIGN, PG8_SP2>(lds, g, S, E);
            GRID_BAR(pb + 4);
        }
        if (IN(pb + 5)) {
            FRESH_TID();
            unsigned char* ws = WSP(); float* H = (float*)P(21); const float* Y = (const float*)(ws + WS_Y); const float* gp = P(18) + (size_t)l * D; const float* gn = P(19) + (size_t)l * D; bf16_t* HN = (bf16_t*)(ws + WS_HN);
            for (int m = gw; m < M; m += NGW) norm_row(nullptr, H, Y, gp, gn, HN, m, lane);
            GRID_BAR(pb + 5);
        }
        if (IN(pb + 6)) {
            unsigned char* ws = WSP(); unsigned char* wl = ws + WS_W0 + (size_t)l * W_LAYER;
            pg8::Gemm g; g.A[0] = (const bf16_t*)(ws + WS_HN); g.Bt[0] = (const bf16_t*)(wl + OFF_WUP); g.A[1] = g.A[0]; g.Bt[1] = g.Bt[0]; g.lda = D; g.ldb = D; g.K = D;
            pg8::Order2 S; S.nM0 = M / 256; S.nN0 = NUP / 256; S.nM1 = 0; S.nN1 = 1; S.G = G; S.c = bx;
            pg8::EpiBf16 E; E.O[0] = (bf16_t*)(ws + WS_Z); E.ldc[0] = NUP; E.O[1] = E.O[0]; E.ldc[1] = NUP;
            pg8::gemm_phase<pg8::EpiBf16, pg8::Order2, PG8_ALIGN, PG8_SP2>(lds, g, S, E);
            GRID_BAR(pb + 6);
        }
        if (IN(pb + 7)) {
            FRESH_TID();
            unsigned char* ws = WSP(); const float* wc = P(14) + (size_t)l * 3 * NUP; const float* bc = P(15) + (size_t)l * NUP;
            for (int run = bx; run < M / 32; run += G) conv_run((const bf16_t*)(ws + WS_Z), wc, bc, (bf16_t*)(ws + WS_F), run, tid);
            GRID_BAR(pb + 7);
        }
        if (IN(pb + 8)) {
            unsigned char* ws = WSP(); unsigned char* wl = ws + WS_W0 + (size_t)l * W_LAYER;
            pg8::Gemm g; g.A[0] = (const bf16_t*)(ws + WS_F); g.Bt[0] = (const bf16_t*)(wl + OFF_WDN); g.A[1] = g.A[0]; g.Bt[1] = g.Bt[0]; g.lda = DFF; g.ldb = DFF; g.K = DFF;
            pg8::Order2 S; S.nM0 = M / 256; S.nN0 = D / 256; S.nM1 = 0; S.nN1 = 1; S.G = G; S.c = bx;
            pg8::EpiF32 E; E.C = (float*)(ws + WS_Y); E.ldc = D;
            pg8::gemm_phase<pg8::EpiF32, pg8::Order2, PG8_ALIGN, PG8_SP2>(lds, g, S, E);
            GRID_BAR(pb + 8);
        }
        if (IN(pb + 9)) {
            FRESH_TID();
            unsigned char* ws = WSP(); float* H = (float*)P(21); const float* Y = (const float*)(ws + WS_Y); const float* gp = P(20) + (size_t)l * D; const float* gn = l + 1 < DEPTH ? P(17) + (size_t)(l + 1) * D : nullptr; bf16_t* HN = (bf16_t*)(ws + WS_HN);
            for (int m = gw; m < M; m += NGW) norm_row(nullptr, H, Y, gp, gn, HN, m, lane);
            GRID_BAR(pb + 9);
        }
    }
#undef IN
#undef BOTH
#undef GRID_BAR
}

static int g_grid = 0;
template <int LO, int HI> static void launch_range(hipStream_t stream, const Args& a) {
    static bool attr = false;
    if (!attr) { if (hipFuncSetAttribute((const void*)fwd<LO, HI>, hipFuncAttributeMaxDynamicSharedMemorySize, LDS_BYTES) != hipSuccess) fprintf(stderr, "kernel_launch: hipFuncSetAttribute failed\n"); attr = true; }
    hipLaunchKernelGGL((fwd<LO, HI>), dim3(g_grid), dim3(512), LDS_BYTES, stream, a);
    const hipError_t le = hipPeekAtLastError();
    if (le != hipSuccess) fprintf(stderr, "kernel_launch: fwd launch [%d,%d) failed: %s\n", LO, HI, hipGetErrorName(le));
}
template <int P> static void launch_each(hipStream_t stream, const Args& a) { if constexpr (P < NPH) { launch_range<P, P + 1>(stream, a); launch_each<P + 1>(stream, a); } }
extern "C" void kernel_launch(void* const* d_in, const int* in_sizes, int n_in, void* d_out, int out_size, void* d_ws, size_t ws_size, hipStream_t stream) {
    if (n_in != 21 || ws_size < WS_END) { fprintf(stderr, "kernel_launch: unexpected n_in %d or ws %zu < %zu\n", n_in, ws_size, (size_t)WS_END); return; }
    if (g_grid == 0) {
        int dev = 0, cus = 0;
        if (hipGetDevice(&dev) != hipSuccess || hipDeviceGetAttribute(&cus, hipDeviceAttributeMultiprocessorCount, dev) != hipSuccess) { fprintf(stderr, "kernel_launch: device query failed\n"); g_grid = -1; return; }
        g_grid = cus;
    }
    if (g_grid < 0) return;
    (void)hipMemsetAsync((char*)d_ws + WS_CTL, 0, CTL_ZERO_BYTES, stream);
    Args a{};
    for (int i = 0; i < 21; ++i) a.in[i] = (const float*)d_in[i];
    a.out = (float*)d_out; a.ws = (unsigned char*)d_ws;
#if MK_ONE_LAUNCH
    launch_range<0, NPH>(stream, a);
#else
    launch_each<0>(stream, a);
#endif
}
```

```cpp
#ifndef MK_ONE_LAUNCH
#define MK_ONE_LAUNCH 1
#endif
#ifndef MK_DOUBLE_PHASE
#define MK_DOUBLE_PHASE (-1)
#endif
#include <hip/hip_runtime.h>
#include <stdint.h>
#include <stdio.h>

typedef unsigned short bf16_t;
typedef short bf16x8 __attribute__((ext_vector_type(8)));
typedef float f32x4 __attribute__((ext_vector_type(4)));
typedef float f32x16 __attribute__((ext_vector_type(16)));

constexpr int D = 4096, SEQ = 4096, M = 8192, DEPTH = 2;
constexpr int NIN = 10256, DFF = 11008, NUP = 22016;
constexpr int UNW = 7168, UTW = 3072;
constexpr float EPS = 1e-6f;
constexpr int UN_QA = 0, UN_KA = 2048, UN_QB = 4096, UN_KB = 4608, UN_GB = 5120, UN_UC = 6144;
constexpr int SRC_QA = 0, SRC_KA = 2048, SRC_VA = 4096, SRC_QB = 6144, SRC_KB = 6656, SRC_VB = 7168, SRC_GB = 8192, SRC_ZLR = 9216, SRC_UC = 9232;

constexpr size_t MiB = 1u << 20;
constexpr size_t WS_CTL = 0;
constexpr size_t WS_W0 = 1 * MiB;
constexpr size_t OFF_WN = 0, OFF_WT = 56 * MiB, OFF_WO = 80 * MiB, OFF_WUP = 112 * MiB, OFF_WDN = 284 * MiB, OFF_WP = 370 * MiB, W_LAYER = 371 * MiB;
constexpr size_t WS_HN = WS_W0 + 2 * W_LAYER;
constexpr size_t WS_UN = WS_HN + 64 * MiB;
constexpr size_t WS_UT = WS_UN + 112 * MiB;
constexpr size_t WS_ZLR = WS_UT + 48 * MiB;
constexpr size_t WS_MIX = WS_ZLR + 1 * MiB;
constexpr size_t WS_Y = WS_MIX + 64 * MiB;
constexpr size_t WS_Z = WS_Y + 128 * MiB;
constexpr size_t WS_F = WS_Z + 344 * MiB;
constexpr size_t WS_DP = WS_F + 172 * MiB;
constexpr size_t WS_END = WS_DP + 16 * MiB;

__device__ __forceinline__ bf16_t f2bf(float f) { unsigned u = __float_as_uint(f); u += 0x7fffu + ((u >> 16) & 1u); return (bf16_t)(u >> 16); }
__device__ __forceinline__ float bf2f(bf16_t b) { return __uint_as_float(((unsigned)b) << 16); }
__device__ __forceinline__ float wave_sum(float v) {
#pragma unroll
    for (int o = 1; o < 64; o <<= 1) v += __shfl_xor(v, o);
    return v;
}
__device__ __forceinline__ float wave_max(float v) {
#pragma unroll
    for (int o = 1; o < 64; o <<= 1) v = fmaxf(v, __shfl_xor(v, o));
    return v;
}

__global__ void k_cvt_t(const float* __restrict__ W, int ldw, int c0, bf16_t* __restrict__ Wt, int K, int r0) {
    __shared__ float t[64][65];
    const int nb = blockIdx.x, kb = blockIdx.y, tx = threadIdx.x & 63, ty = threadIdx.x >> 6;
    for (int i = ty; i < 64; i += 4) t[i][tx] = W[(size_t)(kb * 64 + i) * ldw + c0 + nb * 64 + tx];
    __syncthreads();
    for (int i = ty; i < 64; i += 4) Wt[(size_t)(r0 + nb * 64 + i) * K + kb * 64 + tx] = f2bf(t[tx][i]);
}

template <int OUTF32>
__global__ __launch_bounds__(256) void k_gemm(const bf16_t* __restrict__ A, int lda, const bf16_t* __restrict__ Bt, int ldb, void* C, int ldc, int K, const float* cscale) {
    const int wid = threadIdx.x >> 6, lane = threadIdx.x & 63, r = lane & 31, h = lane >> 5;
    const int m0 = blockIdx.y * 128 + (wid >> 1) * 64, n0 = blockIdx.x * 128 + (wid & 1) * 64;
    f32x16 acc[2][2];
#pragma unroll
    for (int i = 0; i < 2; ++i)
#pragma unroll
        for (int j = 0; j < 2; ++j)
#pragma unroll
            for (int e = 0; e < 16; ++e) acc[i][j][e] = 0.f;
    const bf16_t* a0 = A + (size_t)(m0 + r) * lda + 8 * h;
    const bf16_t* a1 = a0 + (size_t)32 * lda;
    const bf16_t* b0 = Bt + (size_t)(n0 + r) * ldb + 8 * h;
    const bf16_t* b1 = b0 + (size_t)32 * ldb;
    for (int k = 0; k < K; k += 16) {
        const bf16x8 fa0 = *(const bf16x8*)(a0 + k), fa1 = *(const bf16x8*)(a1 + k), fb0 = *(const bf16x8*)(b0 + k), fb1 = *(const bf16x8*)(b1 + k);
        acc[0][0] = __builtin_amdgcn_mfma_f32_32x32x16_bf16(fa0, fb0, acc[0][0], 0, 0, 0);
        acc[0][1] = __builtin_amdgcn_mfma_f32_32x32x16_bf16(fa0, fb1, acc[0][1], 0, 0, 0);
        acc[1][0] = __builtin_amdgcn_mfma_f32_32x32x16_bf16(fa1, fb0, acc[1][0], 0, 0, 0);
        acc[1][1] = __builtin_amdgcn_mfma_f32_32x32x16_bf16(fa1, fb1, acc[1][1], 0, 0, 0);
    }
#pragma unroll
    for (int i = 0; i < 2; ++i)
#pragma unroll
        for (int j = 0; j < 2; ++j)
#pragma unroll
            for (int e = 0; e < 16; ++e) {
                const int row = m0 + 32 * i + (e & 3) + 8 * (e >> 2) + 4 * h, col = n0 + 32 * j + r;
                float v = acc[i][j][e];
                if (OUTF32) ((float*)C)[(size_t)row * ldc + col] = v;
                else { if (cscale) v *= cscale[col]; ((bf16_t*)C)[(size_t)row * ldc + col] = f2bf(v); }
            }
}

__global__ __launch_bounds__(256) void k_norm(const float* X, float* H, const float* Y, const float* gpost, const float* gnext, bf16_t* HN) {
    const int row = blockIdx.x * 4 + (threadIdx.x >> 6), lane = threadIdx.x & 63;
    f32x4 hv[16];
    const f32x4* src = (const f32x4*)((X ? X : H) + (size_t)row * D) + lane;
#pragma unroll
    for (int j = 0; j < 16; ++j) hv[j] = src[64 * j];
    if (Y) {
        const f32x4* yp = (const f32x4*)(Y + (size_t)row * D) + lane;
        f32x4 yv[16]; float s = 0.f;
#pragma unroll
        for (int j = 0; j < 16; ++j) { yv[j] = yp[64 * j]; s += yv[j].x * yv[j].x + yv[j].y * yv[j].y + yv[j].z * yv[j].z + yv[j].w * yv[j].w; }
        const float rs = rsqrtf(wave_sum(s) * (1.f / D) + EPS);
#pragma unroll
        for (int j = 0; j < 16; ++j) { const f32x4 g = ((const f32x4*)gpost)[lane + 64 * j]; hv[j] += yv[j] * rs * g; }
    }
    if (X || Y) {
        f32x4* hp = (f32x4*)(H + (size_t)row * D) + lane;
#pragma unroll
        for (int j = 0; j < 16; ++j) hp[64 * j] = hv[j];
    }
    if (gnext) {
        float s = 0.f;
#pragma unroll
        for (int j = 0; j < 16; ++j) s += hv[j].x * hv[j].x + hv[j].y * hv[j].y + hv[j].z * hv[j].z + hv[j].w * hv[j].w;
        const float rs = rsqrtf(wave_sum(s) * (1.f / D) + EPS);
        uint2* op = (uint2*)(HN + (size_t)row * D) + lane;
#pragma unroll
        for (int j = 0; j < 16; ++j) { const f32x4 g = ((const f32x4*)gnext)[lane + 64 * j]; const f32x4 v = hv[j] * rs * g;
            uint2 o; o.x = (unsigned)f2bf(v.x) | ((unsigned)f2bf(v.y) << 16); o.y = (unsigned)f2bf(v.z) | ((unsigned)f2bf(v.w) << 16); op[64 * j] = o; }
    }
}

__global__ __launch_bounds__(256) void k_zlr(const bf16_t* HN, const float* w_in, float* ZLR) {
    const int row = blockIdx.x * 4 + (threadIdx.x >> 6), lane = threadIdx.x & 63;
    float acc[16];
#pragma unroll
    for (int j = 0; j < 16; ++j) acc[j] = 0.f;
    for (int k = lane; k < D; k += 64) {
        const float a = bf2f(HN[(size_t)row * D + k]);
        const f32x4* w = (const f32x4*)(w_in + (size_t)k * NIN + SRC_ZLR);
#pragma unroll
        for (int q = 0; q < 4; ++q) { const f32x4 wv = w[q]; acc[4 * q] += a * wv.x; acc[4 * q + 1] += a * wv.y; acc[4 * q + 2] += a * wv.z; acc[4 * q + 3] += a * wv.w; }
    }
#pragma unroll
    for (int j = 0; j < 16; ++j) acc[j] = wave_sum(acc[j]);
    if (lane == 0) {
#pragma unroll
        for (int j = 0; j < 16; ++j) ZLR[(size_t)row * 16 + j] = acc[j];
    }
}

__device__ __forceinline__ float lam_of(const float* q1, const float* k1, const float* q2, const float* k2, int lane, float lam_init) {
    float s1 = q1[lane] * k1[lane] + q1[lane + 64] * k1[lane + 64], s2 = q2[lane] * k2[lane] + q2[lane + 64] * k2[lane + 64];
    s1 = wave_sum(s1); s2 = wave_sum(s2);
    return expf(s1) - expf(s2) + lam_init;
}

__global__ __launch_bounds__(64) void k_attn_naive(const bf16_t* UN, const bf16_t* UT, bf16_t* MIX, const float* lq1, const float* lk1, const float* lq2, const float* lk2, const float* gsub, float lam_init) {
    __shared__ float sc[2][SEQ];
    __shared__ float qv[2][128];
    const int lane = threadIdx.x, q = blockIdx.x % SEQ, h = (blockIdx.x / SEQ) % 8, b = blockIdx.x / (SEQ * 8);
    const float lam = lam_of(lq1, lk1, lq2, lk2, lane, lam_init);
    const size_t tok = (size_t)b * SEQ + q;
    for (int i = lane; i < 256; i += 64) qv[i >> 7][i & 127] = bf2f(UN[tok * UNW + UN_QA + h * 256 + i]);
    __syncthreads();
    const int nk = (q / 64 + 1) * 64;
    const float slope = exp2f(-(float)(h + 1)), scale = 0.08838834764831845f;
    float mx[2] = {-INFINITY, -INFINITY};
    for (int j = lane; j < nk; j += 64) {
        const bf16_t* kp = UN + ((size_t)b * SEQ + j) * UNW + UN_KA + h * 256;
#pragma unroll
        for (int mp = 0; mp < 2; ++mp) {
            float d = 0.f;
            for (int c = 0; c < 128; c += 8) { const bf16x8 kv = *(const bf16x8*)(kp + mp * 128 + c);
#pragma unroll
                for (int e = 0; e < 8; ++e) d += qv[mp][c + e] * bf2f((bf16_t)kv[e]); }
            const float s = d * scale - slope * fabsf((float)(q - j));
            sc[mp][j] = s; mx[mp] = fmaxf(mx[mp], s);
        }
    }
    float l[2] = {0.f, 0.f};
#pragma unroll
    for (int mp = 0; mp < 2; ++mp) { mx[mp] = wave_max(mx[mp]); }
    for (int j = lane; j < nk; j += 64) {
#pragma unroll
        for (int mp = 0; mp < 2; ++mp) { const float p = expf(sc[mp][j] - mx[mp]); sc[mp][j] = p; l[mp] += p; }
    }
#pragma unroll
    for (int mp = 0; mp < 2; ++mp) l[mp] = wave_sum(l[mp]);
    const float i1 = 1.f / l[0], i2 = lam / l[1];
    for (int j = lane; j < nk; j += 64) sc[0][j] = sc[0][j] * i1 - sc[1][j] * i2;
    __syncthreads();
    float o[4] = {0.f, 0.f, 0.f, 0.f};
    for (int j = 0; j < nk; j += 8) {
#pragma unroll
        for (int i = 0; i < 4; ++i) {
            const bf16x8 vv = *(const bf16x8*)(UT + (size_t)(h * 256 + lane * 4 + i) * M + (size_t)b * SEQ + j);
#pragma unroll
            for (int e = 0; e < 8; ++e) o[i] += sc[0][j + e] * bf2f((bf16_t)vv[e]);
        }
    }
    float ss = o[0] * o[0] + o[1] * o[1] + o[2] * o[2] + o[3] * o[3];
    const float rs = rsqrtf(wave_sum(ss) * (1.f / 256.f) + EPS) * (1.f - lam_init);
#pragma unroll
    for (int i = 0; i < 4; ++i) MIX[tok * D + h * 256 + lane * 4 + i] = f2bf(o[i] * rs * gsub[lane * 4 + i]);
}

__global__ __launch_bounds__(256) void k_gla_naive(const bf16_t* UN, const bf16_t* UT, const float* ZLR, const float* w2, const float* bg, const float* ggla, bf16_t* MIX) {
    __shared__ float sa[128], sk[128], sq[128], red[4];
    const int e = threadIdx.x, h = blockIdx.x & 3, b = blockIdx.x >> 2;
    float S[128];
#pragma unroll
    for (int d = 0; d < 128; ++d) S[d] = 0.f;
    for (int t = 0; t < SEQ; ++t) {
        const size_t tok = (size_t)b * SEQ + t;
        if (e < 128) {
            float x = bg[h * 128 + e];
#pragma unroll
            for (int r = 0; r < 16; ++r) x += ZLR[tok * 16 + r] * w2[r * 512 + h * 128 + e];
            const float ls = fminf(x, 0.f) - log1pf(expf(-fabsf(x)));
            sa[e] = expf(ls * (1.f / 16.f));
            sk[e] = bf2f(UN[tok * UNW + UN_KB + h * 128 + e]);
            sq[e] = bf2f(UN[tok * UNW + UN_QB + h * 128 + e]) * 0.08838834764831845f;
        }
        __syncthreads();
        const float v = bf2f(UT[(size_t)(2048 + h * 256 + e) * M + tok]);
        float o = 0.f;
#pragma unroll
        for (int d = 0; d < 128; ++d) { S[d] = sa[d] * S[d] + sk[d] * v; o += sq[d] * S[d]; }
        const float ws = wave_sum(o * o);
        if ((e & 63) == 0) red[e >> 6] = ws;
        __syncthreads();
        const float ms = (red[0] + red[1] + red[2] + red[3]) * (1.f / 256.f);
        const float g = bf2f(UN[tok * UNW + UN_GB + h * 256 + e]);
        const float out = o * rsqrtf(ms + EPS) * ggla[h * 256 + e] * (g / (1.f + expf(-g)));
        MIX[tok * D + 2048 + h * 256 + e] = f2bf(out);
    }
}

__global__ void k_pool_d(const bf16_t* UN, bf16_t* DP) {
    const int idx = blockIdx.x * 256 + threadIdx.x, c = idx & 1023, tok = idx >> 10, t = tok & (SEQ - 1), g = c >> 8, w = 2 << g;
    const int lo = (t + 1 - w) > 0 ? (t + 1 - w) : 0;
    float s = 0.f;
    for (int j = lo; j <= t; ++j) s += bf2f(UN[(size_t)(tok - t + j) * UNW + UN_UC + c]);
    DP[(size_t)tok * 1024 + c] = f2bf(s / (float)(t + 1 - lo) - bf2f(UN[(size_t)tok * UNW + UN_UC + c]));
}

__device__ __forceinline__ float gelu_tanh(float x) { const float u = 0.7978845608028654f * (x + 0.044715f * x * x * x); return 0.5f * x * (1.f + tanhf(u)); }
__global__ void k_convglu(const bf16_t* Z, const float* wc, const float* bc, bf16_t* F) {
    const size_t idx = (size_t)blockIdx.x * 256 + threadIdx.x; const int c = (int)(idx % DFF); const size_t tok = idx / DFF; const int t = (int)(tok & (SEQ - 1));
    float gte = bc[c], val = bc[c + DFF];
#pragma unroll
    for (int j = 0; j < 3; ++j) { const int tt = t - 2 + j; if (tt >= 0) { const size_t r = (tok - 2 + j) * (size_t)NUP;
        gte += wc[j * NUP + c] * bf2f(Z[r + c]); val += wc[j * NUP + c + DFF] * bf2f(Z[r + c + DFF]); } }
    F[tok * DFF + c] = f2bf(gelu_tanh(gte) * val);
}


#define LAS __attribute__((address_space(3)))
#define GAS __attribute__((address_space(1)))
typedef unsigned u32x4 __attribute__((ext_vector_type(4)));
typedef unsigned u32x2 __attribute__((ext_vector_type(2)));
typedef float f32x2 __attribute__((ext_vector_type(2)));
typedef GAS unsigned gu32;
#define RLX_AGENT __ATOMIC_RELAXED, __HIP_MEMORY_SCOPE_AGENT
constexpr size_t OFF_WZ = 370 * MiB + 512 * 1024;
constexpr int RING_BYTES = 141312, LDSCTL_OFF = RING_BYTES, MISC_OFF = LDSCTL_OFF + 320, LDS_BYTES = 147456;
constexpr int CW_BAR = 4096, CW_KMAX = 8192, CW_QUEUE = 12288;
constexpr size_t CTL_ZERO_BYTES = 64 * 1024;

__device__ __forceinline__ unsigned cvt_pk_bf16(float lo, float hi) { unsigned r; asm volatile("v_cvt_pk_bf16_f32 %0, %1, %2" : "=v"(r) : "v"(lo), "v"(hi)); return r; }

#define XB_TMO      128
#define XB_XCNT(j)  (256  + 64 * (j))
#define XB_XSUB(j)  (1280 + 64 * (j))
#define XB_XGEN(j)  (2304 + 64 * (j))
#define XB_TOP      3328
#define XB_TOPGEN   3392
#define XCD_BAR_WORDS 3456
#define XB_SPIN_CAP (1u << 18)
__device__ __forceinline__ unsigned xb_ld(unsigned* p)              { return __hip_atomic_load(p, __ATOMIC_RELAXED, __HIP_MEMORY_SCOPE_AGENT); }
__device__ __forceinline__ unsigned xb_add(unsigned* p, unsigned v) { return __hip_atomic_fetch_add(p, v, __ATOMIC_RELAXED, __HIP_MEMORY_SCOPE_AGENT); }
__device__ __forceinline__ unsigned xb_xcc_id() { return (unsigned)__builtin_amdgcn_s_getreg((3 << 11) | 20) & 0xFu; }
#define XB_SPIN(cond, bar) do { unsigned _sp = 0; while (cond) { __builtin_amdgcn_s_sleep(1); \
    if ((++_sp & 255u) == 0u) { if (xb_ld(&(bar)[XB_TMO])) break; if (_sp > XB_SPIN_CAP) { atomicAdd(&(bar)[XB_TMO], 1u); break; } } } } while (0)
struct XcdBarrier { unsigned* bar; unsigned x; volatile LAS unsigned* st; };
__device__ __forceinline__ XcdBarrier xcd_barrier_post(unsigned* bar, volatile LAS unsigned* st) {
    XcdBarrier b; b.bar = bar; b.x = xb_xcc_id(); b.st = st;
    if (threadIdx.x == 0) (void)xb_add(&bar[XB_XCNT(b.x)], 1u);
    return b;
}
__device__ __forceinline__ void xcd_barrier_complete(unsigned* bar, unsigned x, unsigned& nloc, unsigned& nx) {
    const unsigned G = gridDim.x * gridDim.y * gridDim.z;
    unsigned sum, cnt, mine, sp = 0u;
    for (;;) {
        sum = 0u; cnt = 0u; mine = 0u;
#pragma unroll
        for (unsigned j = 0; j < 16; ++j) { const unsigned c = xb_ld(&bar[XB_XCNT(j)]); sum += c; cnt += (c > 0u) ? 1u : 0u; mine = (j == x) ? c : mine; }
        if (sum == G) break;
        __builtin_amdgcn_s_sleep(1);
        if ((++sp & 255u) == 0u) { if (xb_ld(&bar[XB_TMO])) break; if (sp > XB_SPIN_CAP) { atomicAdd(&bar[XB_TMO], 1u); break; } }
    }
    nloc = mine > 0u ? mine : 1u; nx = cnt > 0u ? cnt : 1u;
}
__device__ __forceinline__ void xcd_barrier(const XcdBarrier& b) {
    asm volatile("s_waitcnt vmcnt(0)" ::: "memory");
    __syncthreads();
    if (threadIdx.x == 0) {
        unsigned* bar = b.bar;
        __builtin_amdgcn_s_waitcnt(0);
        unsigned nloc = b.st[0], nx = b.st[1];
        if (nloc == 0u) { xcd_barrier_complete(bar, b.x, nloc, nx); b.st[0] = nloc; b.st[1] = nx; }
        const unsigned old = xb_add(&bar[XB_XSUB(b.x)], 1u);
        const unsigned gen = old / nloc;
        if (old + 1u == (gen + 1u) * nloc) {
            __builtin_amdgcn_fence(__ATOMIC_RELEASE, "agent");
            asm volatile("s_waitcnt vmcnt(0)" ::: "memory");
            const unsigned og = xb_add(&bar[XB_TOP], 1u);
            const unsigned tg = og / nx;
            if (og + 1u == (tg + 1u) * nx) xb_add(&bar[XB_TOPGEN], 1u);
            else XB_SPIN(xb_ld(&bar[XB_TOPGEN]) == tg, bar);
            __builtin_amdgcn_fence(__ATOMIC_ACQUIRE, "agent");
            xb_add(&bar[XB_XGEN(b.x)], 1u);
            asm volatile("s_waitcnt vmcnt(0)" ::: "memory");
        } else {
            XB_SPIN(xb_ld(&bar[XB_XGEN(b.x)]) == gen, bar);
            __builtin_amdgcn_fence(__ATOMIC_ACQUIRE, "agent");
            asm volatile("s_waitcnt vmcnt(0)" ::: "memory");
        }
    }
    __syncthreads();
}

namespace pg8 {
constexpr int BM = 256, BK = 64, HALF = 128, HTB = HALF * BK * 2, STAGE_BYTES = 8 * HTB, NXCD = 8, WGM = 8;
__host__ __device__ __forceinline__ int lds_byte(int r, int c) { const int st = (r >> 4) * 2 + (c >> 5), rr = r & 15, cc = c & 31, ob = rr * 64 + cc * 2; return st * 1024 + (ob ^ (((ob >> 9) & 1) << 5)); }
__host__ __device__ __forceinline__ void stage_rc(int b, int& R, int& C) { const int st = b / 1024, sb = b % 1024, swz = sb ^ (((sb >> 9) & 1) << 5); R = (st >> 1) * 16 + swz / 64; C = (st & 1) * 32 + (swz % 64) / 2; }
__host__ __device__ __forceinline__ int perm32(int rho) { const int n = rho >> 4, i = rho & 15; return 8 * (i >> 2) + 4 * n + (i & 3); }

struct Unit { int pm, pn, kind; };
struct Gemm { const bf16_t* A[2]; const bf16_t* Bt[2]; int lda, ldb, K; };

__device__ __forceinline__ void tile_of(int wgid, int nM, int nN, int& pm, int& pn) {
    const int nwg = nM * nN; { const int q = nwg / NXCD, r = nwg % NXCD, xcd = wgid % NXCD, off = wgid / NXCD; wgid = (xcd < r ? xcd * (q + 1) : r * (q + 1) + (xcd - r) * q) + off; }
    const int nig = WGM * nN, gid = wgid / nig, fm = gid * WGM, gsz = (nM - fm) < WGM ? (nM - fm) : WGM;
    pm = fm + ((wgid % nig) % gsz); pn = (wgid % nig) / gsz;
}
struct Order2 {
    int nM0, nN0, nM1, nN1, G, c;
    __device__ __forceinline__ bool next(int i, Unit& u) const {
        const int L = i * G + c, n0 = nM0 * nN0;
        if (L < n0) { u.kind = 0; tile_of(L, nM0, nN0, u.pm, u.pn); return true; }
        if (L < n0 + nM1 * nN1) { u.kind = 1; tile_of(L - n0, nM1, nN1, u.pm, u.pn); return true; }
        return false;
    }
    __device__ __forceinline__ void a_ready(const Unit&) const {}
    __device__ __forceinline__ void done(const Unit&) const {}
};

struct EpiBf16 {
    static constexpr bool PERM = true;
    bf16_t* O[2]; int ldc[2];
    __device__ __forceinline__ void operator()(const f32x4 (&acc)[2][2][4][2], const Unit& u, int wr, int wc, int fr, int fq) const {
        const int row0 = u.pm * BM + wr * 64 + fr, col0 = u.pn * BM + wc * 32 + 8 * fq;
        bf16_t* base = u.kind ? O[1] : O[0]; const int ld = u.kind ? ldc[1] : ldc[0];
#pragma unroll
        for (int ai = 0; ai < 2; ++ai)
#pragma unroll
            for (int m = 0; m < 4; ++m) { bf16_t* rowp = base + (size_t)(row0 + ai * HALF + m * 16) * ld + col0;
#pragma unroll
                for (int bj = 0; bj < 2; ++bj) { const f32x4 v0 = acc[ai][bj][m][0], v1 = acc[ai][bj][m][1];
                    u32x4 w; w.x = cvt_pk_bf16(v0[0], v0[1]); w.y = cvt_pk_bf16(v0[2], v0[3]); w.z = cvt_pk_bf16(v1[0], v1[1]); w.w = cvt_pk_bf16(v1[2], v1[3]);
                    *(u32x4*)(rowp + bj * HALF) = w; } }
    }
};
struct EpiF32 {
    static constexpr bool PERM = false;
    float* C; int ldc;
    __device__ __forceinline__ void operator()(const f32x4 (&acc)[2][2][4][2], const Unit& u, int wr, int wc, int fr, int fq) const {
        const int row0 = u.pm * BM + wr * 64 + fr, col0 = u.pn * BM + wc * 32 + 4 * fq;
#pragma unroll
        for (int ai = 0; ai < 2; ++ai)
#pragma unroll
            for (int m = 0; m < 4; ++m) { float* rowp = C + (size_t)(row0 + ai * HALF + m * 16) * ldc + col0;
#pragma unroll
                for (int bj = 0; bj < 2; ++bj)
#pragma unroll
                    for (int n = 0; n < 2; ++n) *(f32x4*)(rowp + bj * HALF + n * 16) = acc[ai][bj][m][n]; }
    }
};

template <class Epi, class Sched, bool ALIGN_EPI, bool SP2>
__device__ __forceinline__ void gemm_phase(LAS unsigned char* lds, const Gemm g, const Sched& S, const Epi& E) {
    int tid = threadIdx.x; asm volatile("" : "+v"(tid));
    const int wid = __builtin_amdgcn_readfirstlane(tid >> 6), lane = tid & 63, wr = wid >> 2, wc = wid & 3, fr = lane & 15, fq = lane >> 4;
    const int K = g.K, nt = K / BK;
    unsigned voffA[2], voffB[2];
#pragma unroll
    for (int i = 0; i < 2; ++i) { int R, C; stage_rc(tid * 16 + i * 8192, R, C); const int Rb = Epi::PERM ? ((R & ~31) + perm32(R & 31)) : R;
        voffA[i] = (unsigned)(R * g.lda + C) * 2u; voffB[i] = (unsigned)(Rb * g.ldb + C) * 2u; }
    const size_t kstep = (size_t)(BK * 2);
    const size_t hstepA = (size_t)HALF * g.lda * 2, hstepB = (size_t)HALF * g.ldb * 2;
    const size_t tstepA = 2 * hstepA, tstepB = 2 * hstepB;
    const unsigned ldsw = (unsigned)wid * 1024u;
    const int aoff = lds_byte(wr * 64 + fr, fq * 8), boff = lds_byte(wc * 32 + fr, fq * 8);
#define PG8_SA(b, h) (((b) * 2 + (h)) * HTB)
#define PG8_SB(b, h) ((4 + (b) * 2 + (h)) * HTB)
#define PG8_STAGE(bufoff, gbase, voff) do { _Pragma("unroll") for (int _i = 0; _i < 2; ++_i) \
        __builtin_amdgcn_global_load_lds((const unsigned*)((const char*)(gbase) + (voff)[_i]), (LAS unsigned*)(lds + (bufoff) + ldsw + _i * 8192), 16, 0, 0); } while (0)
#define PG8_LDA(dst, b, h) do { _Pragma("unroll") for (int m = 0; m < 4; ++m) _Pragma("unroll") for (int k = 0; k < 2; ++k) dst[m][k] = *(const LAS bf16x8*)(lds + PG8_SA(b, h) + aoff + m * 2048 + k * 1024); } while (0)
#define PG8_LDB(dst, b, h) do { _Pragma("unroll") for (int n = 0; n < 2; ++n) _Pragma("unroll") for (int k = 0; k < 2; ++k) dst[n][k] = *(const LAS bf16x8*)(lds + PG8_SB(b, h) + boff + n * 2048 + k * 1024); } while (0)
#define PG8_MMA(ai, bj, At, Bt) do { __builtin_amdgcn_s_setprio(1); _Pragma("unroll") for (int m = 0; m < 4; ++m) _Pragma("unroll") for (int n = 0; n < 2; ++n) _Pragma("unroll") for (int k = 0; k < 2; ++k) \
        acc[ai][bj][m][n] = __builtin_amdgcn_mfma_f32_16x16x32_bf16(Bt[n][k], At[m][k], acc[ai][bj][m][n], 0, 0, 0); __builtin_amdgcn_s_setprio(0); } while (0)
#define PG8_WAIT_V(n) asm volatile("s_waitcnt vmcnt(" #n ")" ::: "memory")
#define PG8_WAIT_L(n) asm volatile("s_waitcnt lgkmcnt(" #n ")" ::: "memory")
#define PG8_BAR __builtin_amdgcn_s_barrier()
#define PG8_SCHED __builtin_amdgcn_sched_barrier(0)
    Unit cur, nxt; int ui = 0;
    if (!S.next(0, cur)) return;
    f32x4 acc[2][2][4][2];
#pragma unroll
    for (int a = 0; a < 2; ++a)
#pragma unroll
        for (int b = 0; b < 2; ++b)
#pragma unroll
            for (int m = 0; m < 4; ++m)
#pragma unroll
                for (int n = 0; n < 2; ++n) acc[a][b][m][n] = (f32x4){0.f, 0.f, 0.f, 0.f};
    bf16x8 At[4][2], B0[2][2], B1[2][2];
    const char* cA = (const char*)(cur.kind ? g.A[1] : g.A[0]) + (size_t)cur.pm * tstepA; const char* cB = (const char*)(cur.kind ? g.Bt[1] : g.Bt[0]) + (size_t)cur.pn * tstepB;
    S.a_ready(cur);
    if constexpr (SP2) {
        PG8_STAGE(PG8_SB(0, 0), cB, voffB); PG8_STAGE(PG8_SB(0, 1), cB + hstepB, voffB); PG8_STAGE(PG8_SA(0, 0), cA, voffA); PG8_STAGE(PG8_SA(0, 1), cA + hstepA, voffA);
        if (wr == 1) PG8_BAR;
        PG8_WAIT_V(2); PG8_BAR;
        PG8_STAGE(PG8_SB(1, 0), cB + kstep, voffB); PG8_STAGE(PG8_SA(1, 0), cA + kstep, voffA); PG8_STAGE(PG8_SB(1, 1), cB + hstepB + kstep, voffB);
        PG8_WAIT_V(6); PG8_BAR;
    } else {
        PG8_STAGE(PG8_SB(0, 0), cB, voffB); PG8_STAGE(PG8_SA(0, 0), cA, voffA); PG8_STAGE(PG8_SB(0, 1), cB + hstepB, voffB); PG8_STAGE(PG8_SA(0, 1), cA + hstepA, voffA);
        if (wr == 1) PG8_BAR;
        PG8_WAIT_V(4); PG8_BAR;
        PG8_STAGE(PG8_SB(1, 0), cB + kstep, voffB); PG8_STAGE(PG8_SA(1, 0), cA + kstep, voffA); PG8_STAGE(PG8_SB(1, 1), cB + hstepB + kstep, voffB);
        PG8_WAIT_V(6); PG8_BAR;
    }
    for (;;) {
        const bool has_next = S.next(ui + 1, nxt);
        const char* nA = has_next ? (const char*)(nxt.kind ? g.A[1] : g.A[0]) + (size_t)nxt.pm * tstepA : cA; const char* nB = has_next ? (const char*)(nxt.kind ? g.Bt[1] : g.Bt[0]) + (size_t)nxt.pn * tstepB : cB;
        for (int t = 0; t < nt; t += 2) {
            const bool last = (t == nt - 2);
            const char* a1 = cA + (size_t)(t + 1) * kstep;
            const char* a2 = last ? nA : cA + (size_t)(t + 2) * kstep; const char* b2 = last ? nB : cB + (size_t)(t + 2) * kstep;
            const char* a3 = a2 + kstep; const char* b3 = b2 + kstep;
            if (last && has_next) S.a_ready(nxt);
            if constexpr (SP2) {
            PG8_LDB(B0, 0, 0); PG8_LDB(B1, 0, 1); PG8_SCHED; PG8_LDA(At, 0, 0); PG8_STAGE(PG8_SA(1, 1), a1 + hstepA, voffA);
            PG8_WAIT_V(8); PG8_WAIT_L(0); PG8_BAR; PG8_MMA(0, 0, At, B0); PG8_MMA(0, 1, At, B1); PG8_BAR; PG8_SCHED;
            PG8_LDA(At, 0, 1); PG8_STAGE(PG8_SB(0, 0), b2, voffB); PG8_STAGE(PG8_SB(0, 1), b2 + hstepB, voffB); PG8_STAGE(PG8_SA(0, 0), a2, voffA);
            PG8_WAIT_V(8); PG8_WAIT_L(0); PG8_BAR; PG8_MMA(1, 0, At, B0); PG8_MMA(1, 1, At, B1); PG8_BAR; PG8_SCHED;
            PG8_LDB(B0, 1, 0); PG8_LDB(B1, 1, 1); PG8_SCHED; PG8_LDA(At, 1, 0); PG8_STAGE(PG8_SA(0, 1), a2 + hstepA, voffA);
            PG8_WAIT_V(8); PG8_WAIT_L(0); PG8_BAR; PG8_MMA(0, 0, At, B0); PG8_MMA(0, 1, At, B1); PG8_BAR; PG8_SCHED;
            PG8_LDA(At, 1, 1); PG8_STAGE(PG8_SB(1, 0), b3, voffB); PG8_STAGE(PG8_SB(1, 1), b3 + hstepB, voffB); PG8_STAGE(PG8_SA(1, 0), a3, voffA);
            PG8_WAIT_V(8); PG8_WAIT_L(0); PG8_BAR; PG8_MMA(1, 0, At, B0); PG8_MMA(1, 1, At, B1); PG8_BAR; PG8_SCHED;
            } else {
            PG8_LDB(B0, 0, 0); PG8_SCHED; PG8_LDA(At, 0, 0); PG8_STAGE(PG8_SA(1, 1), a1 + hstepA, voffA);
            PG8_WAIT_L(8); PG8_BAR; PG8_WAIT_L(0); PG8_MMA(0, 0, At, B0); PG8_BAR; PG8_SCHED;
            PG8_LDB(B1, 0, 1); PG8_STAGE(PG8_SB(0, 0), b2, voffB);
            PG8_BAR; PG8_WAIT_L(0); PG8_MMA(0, 1, At, B1); PG8_BAR;
            PG8_LDA(At, 0, 1); PG8_STAGE(PG8_SA(0, 0), a2, voffA);
            PG8_BAR; PG8_WAIT_L(0); PG8_MMA(1, 0, At, B0); PG8_BAR; PG8_SCHED;
            PG8_STAGE(PG8_SB(0, 1), b2 + hstepB, voffB);
            PG8_WAIT_V(6); PG8_BAR; PG8_MMA(1, 1, At, B1); PG8_BAR;
            PG8_LDB(B0, 1, 0); PG8_SCHED; PG8_LDA(At, 1, 0); PG8_STAGE(PG8_SA(0, 1), a2 + hstepA, voffA);
            PG8_WAIT_L(8); PG8_BAR; PG8_WAIT_L(0); PG8_MMA(0, 0, At, B0); PG8_BAR; PG8_SCHED;
            PG8_LDB(B1, 1, 1); PG8_STAGE(PG8_SB(1, 0), b3, voffB);
            PG8_BAR; PG8_WAIT_L(0); PG8_MMA(0, 1, At, B1); PG8_BAR;
            PG8_LDA(At, 1, 1); PG8_STAGE(PG8_SA(1, 0), a3, voffA);
            PG8_BAR; PG8_WAIT_L(0); PG8_MMA(1, 0, At, B0); PG8_BAR; PG8_SCHED;
            PG8_STAGE(PG8_SB(1, 1), b3 + hstepB, voffB);
            PG8_WAIT_V(6); PG8_BAR; PG8_MMA(1, 1, At, B1); PG8_BAR;
            }
        }
        if constexpr (ALIGN_EPI) { if (wr == 0) PG8_BAR; }
        E(acc, cur, wr, wc, fr, fq); S.done(cur);
        if (!has_next) break;
#pragma unroll
        for (int a = 0; a < 2; ++a)
#pragma unroll
            for (int b = 0; b < 2; ++b)
#pragma unroll
                for (int m = 0; m < 4; ++m)
#pragma unroll
                    for (int n = 0; n < 2; ++n) acc[a][b][m][n] = (f32x4){0.f, 0.f, 0.f, 0.f};
        cur = nxt; cA = nA; cB = nB; ++ui;
        if constexpr (ALIGN_EPI) { if (wr == 1) PG8_BAR; }
    }
    PG8_WAIT_V(0);
    if constexpr (!ALIGN_EPI) { if (wr == 0) PG8_BAR; }
    PG8_BAR;
#undef PG8_SA
#undef PG8_SB
#undef PG8_STAGE
#undef PG8_LDA
#undef PG8_LDB
#undef PG8_MMA
#undef PG8_WAIT_V
#undef PG8_WAIT_L
#undef PG8_BAR
#undef PG8_SCHED
}
}
#ifndef PG8_SP2
#define PG8_SP2 true
#endif
#ifndef PG8_ALIGN
#define PG8_ALIGN true
#endif

constexpr size_t WS_GLA = WS_Z;
constexpr size_t GLA_LT = 0, GLA_OI = 64 * MiB, GLA_ST = 96 * MiB, GLA_QT = 128 * MiB, GLA_DEC = 136 * MiB;
__device__ __forceinline__ int crow(int i, int hh) { return (i & 3) + 8 * (i >> 2) + 4 * hh; }
#define MFMA32(a, b, c) __builtin_amdgcn_mfma_f32_32x32x16_bf16((a), (b), (c), 0, 0, 0)
#define WG_BAR() do { asm volatile("s_waitcnt vmcnt(0) lgkmcnt(0)" ::: "memory"); __builtin_amdgcn_s_barrier(); asm volatile("" ::: "memory"); } while (0)

__device__ __forceinline__ f32x16 mma_lds(const LAS bf16_t* A, int pa, const LAS bf16_t* B, int pb, int K, f32x16 acc, int r, int hh) {
    const LAS bf16_t* ap = A + r * pa + 8 * hh; const LAS bf16_t* bp = B + r * pb + 8 * hh;
    for (int k = 0; k < K; k += 16) acc = MFMA32(*(const LAS bf16x8*)(ap + k), *(const LAS bf16x8*)(bp + k), acc);
    return acc;
}

namespace att {
constexpr float LOG2E = 1.4426950408889634f, C1 = 0.08838834764831845f * LOG2E, THRL = 8.f;
constexpr int KP = 528, VP = 144, VBYTES = 256 * VP, KBYTES = 64 * KP, ABUF = VBYTES + KBYTES, XP = 1040;
__device__ __forceinline__ void stage_tile(LAS unsigned char* buf, const char* kt, const char* vt, int wave, int lane) {
    asm volatile("" : "+v"(lane));
#pragma unroll
    for (int i = 0; i < 5; ++i) { const int iv = wave + 8 * i; if (iv < 36) { const unsigned q = iv * 64 + lane, row = q / 9u, cp = q - 9u * row, cc = cp < 8u ? cp : 7u;
        __builtin_amdgcn_global_load_lds((const GAS unsigned*)(vt + (row * (unsigned)(M * 2) + cc * 16u)), (LAS unsigned*)(buf + iv * 1024), 16, 0, 0); } }
#pragma unroll
    for (int i = 0; i < 5; ++i) { const int ik = wave + 8 * i; if (ik < 33) { const unsigned q = ik * 64 + lane, row = q / 33u, cp = q - 33u * row, cc = cp < 32u ? cp : 31u;
        __builtin_amdgcn_global_load_lds((const GAS unsigned*)(kt + (row * (unsigned)(UNW * 2) + cc * 16u)), (LAS unsigned*)(buf + VBYTES + ik * 1024), 16, 0, 0); } }
}
constexpr float TSKIP = 64.f;
__device__ __forceinline__ void unit(LAS unsigned char* lds, const bf16_t* UN, const bf16_t* UT, bf16_t* MIX, const unsigned* KMAX, int b, int h, int qb, float lam, const float* gsub, float post_scale, int wave, int lane) {
    const int mp = wave >> 2, wq = wave & 3, r = lane & 31, hh = lane >> 5;
    const int q0 = qb * 128 + wq * 32, qpos = q0 + r, cw = q0 >> 6;
    const float C2 = __uint_as_float((unsigned)(127 - (h + 1)) << 23) * LOG2E;
    const char* kt = (const char*)(UN + (size_t)(b * SEQ) * UNW + UN_KA + h * 256);
    const char* vt = (const char*)(UT + (size_t)(h * 256) * M + (size_t)b * SEQ);
    bf16x8 qf[8];
    { const bf16_t* qp = UN + (size_t)(b * SEQ + qpos) * UNW + UN_QA + h * 256 + mp * 128 + 8 * hh;
#pragma unroll
      for (int kk = 0; kk < 8; ++kk) qf[kk] = *(const bf16x8*)(qp + 16 * kk); }
    unsigned long long mask;
    { float qs = 0.f;
#pragma unroll
      for (int kk = 0; kk < 8; ++kk)
#pragma unroll
          for (int e = 0; e < 8; ++e) { const float x = bf2f((bf16_t)qf[kk][e]); qs += x * x; }
      { auto rr = __builtin_amdgcn_permlane32_swap(__float_as_uint(qs), __float_as_uint(qs), false, false); qs = __uint_as_float(rr[0]) + __uint_as_float(rr[1]); }
#pragma unroll
      for (int o = 1; o < 32; o <<= 1) qs = fmaxf(qs, __shfl_xor(qs, o));
      const float qn = sqrtf(qs) * 1.001f;
      const float km = __uint_as_float(__hip_atomic_load(KMAX + ((b * 8 + h) * 2 + mp) * 64 + lane, __ATOMIC_RELAXED, __HIP_MEMORY_SCOPE_AGENT)) * 1.001f;
      const float kcw = __uint_as_float(__builtin_amdgcn_readlane(__float_as_uint(km), cw));
      const int md = q0 - (64 * lane + 63);
      const bool need = (lane <= cw) && (C1 * qn * (km + kcw) - C2 * (float)(md > 0 ? md : 0) >= -TSKIP);
      mask = __ballot(need); }
    volatile LAS unsigned long long* masks = (volatile LAS unsigned long long*)(lds + LDSCTL_OFF + 512);
    if (lane == 0) masks[wave] = mask;
    f32x16 O[8];
#pragma unroll
    for (int eb = 0; eb < 8; ++eb)
#pragma unroll
        for (int i = 0; i < 16; ++i) O[eb][i] = 0.f;
    float m_ref = -INFINITY, l_acc = 0.f;
    WG_BAR();
    unsigned long long rem = 0ull;
#pragma unroll
    for (int w = 0; w < 8; ++w) { const unsigned long long mw = masks[w]; rem |= ((unsigned long long)__builtin_amdgcn_readfirstlane((unsigned)(mw >> 32)) << 32) | (unsigned long long)__builtin_amdgcn_readfirstlane((unsigned)mw); }
    int j = __builtin_ctzll(rem); rem &= rem - 1ull;
    stage_tile(lds, kt + (size_t)j * 64 * UNW * 2, vt + (size_t)j * 128, wave, lane);
    const int kbase = VBYTES + r * KP + mp * 256 + hh * 16, vbase = r * VP + hh * 16;
    for (int it = 0;; ++it) {
        WG_BAR();
        LAS unsigned char* buf = lds + (it & 1) * ABUF;
        const int jn = rem ? __builtin_ctzll(rem) : -1;
        if (jn >= 0) { rem &= rem - 1ull; stage_tile(lds + ((it + 1) & 1) * ABUF, kt + (size_t)jn * 64 * UNW * 2, vt + (size_t)jn * 128, wave, lane); }
        if ((mask >> j) & 1ull) {
            const LAS unsigned char* kp = buf + kbase; const LAS unsigned char* vp = buf + vbase;
#pragma unroll
            for (int hf = 0; hf < 2; ++hf) {
                f32x16 p0;
#pragma unroll
                for (int i = 0; i < 16; ++i) p0[i] = 0.f;
#pragma unroll
                for (int kk = 0; kk < 8; ++kk) p0 = MFMA32(*(const LAS bf16x8*)(kp + hf * 32 * KP + kk * 32), qf[kk], p0);
                const float base0 = (float)(qpos - 64 * j - 32 * hf - 4 * hh);
                float pmax = -INFINITY;
#pragma unroll
                for (int i = 0; i < 16; ++i) { const float off = (float)((i & 3) + 8 * (i >> 2));
                    p0[i] = fmaf(p0[i], C1, -C2 * fabsf(base0 - off)); pmax = fmaxf(pmax, p0[i]); }
                { auto rr = __builtin_amdgcn_permlane32_swap(__float_as_uint(pmax), __float_as_uint(pmax), false, false); pmax = fmaxf(__uint_as_float(rr[0]), __uint_as_float(rr[1])); }
                if (!__all(pmax - m_ref <= THRL)) {
                    const float mn = fmaxf(m_ref, pmax), alpha = __builtin_amdgcn_exp2f(m_ref - mn); m_ref = mn; l_acc *= alpha;
#pragma unroll
                    for (int eb = 0; eb < 8; ++eb)
#pragma unroll
                        for (int i = 0; i < 16; ++i) O[eb][i] *= alpha;
                }
                float ps = 0.f;
#pragma unroll
                for (int i = 0; i < 16; ++i) { p0[i] = __builtin_amdgcn_exp2f(p0[i] - m_ref); ps += p0[i]; }
                l_acc += ps;
                bf16x8 pf[2];
#define PK4(P, BASE, OUT) do { const unsigned a0 = cvt_pk_bf16(P[BASE + 0], P[BASE + 1]), a1 = cvt_pk_bf16(P[BASE + 2], P[BASE + 3]); \
    const unsigned b0 = cvt_pk_bf16(P[BASE + 4], P[BASE + 5]), b1 = cvt_pk_bf16(P[BASE + 6], P[BASE + 7]); \
    auto r0 = __builtin_amdgcn_permlane32_swap(a0, b0, false, false); auto r1 = __builtin_amdgcn_permlane32_swap(a1, b1, false, false); \
    u32x4 w = {r0[0], r1[0], r0[1], r1[1]}; OUT = *reinterpret_cast<bf16x8*>(&w); } while (0)
                PK4(p0, 0, pf[0]); PK4(p0, 8, pf[1]);
#undef PK4
#define LDV(EB, S2) (*(const LAS bf16x8*)(vp + (EB) * 32 * VP + (4 * hf + 2 * (S2)) * 16))
                { bf16x8 va[4] = {LDV(0, 0), LDV(0, 1), LDV(1, 0), LDV(1, 1)};
#pragma unroll
                  for (int eb = 0; eb < 8; eb += 2) { bf16x8 vn[4];
                      if (eb < 6) { vn[0] = LDV(eb + 2, 0); vn[1] = LDV(eb + 2, 1); vn[2] = LDV(eb + 3, 0); vn[3] = LDV(eb + 3, 1); }
                      O[eb] = MFMA32(va[0], pf[0], O[eb]); O[eb + 1] = MFMA32(va[2], pf[0], O[eb + 1]); O[eb] = MFMA32(va[1], pf[1], O[eb]); O[eb + 1] = MFMA32(va[3], pf[1], O[eb + 1]);
                      __builtin_amdgcn_sched_barrier(0);
                      if (eb < 6) { va[0] = vn[0]; va[1] = vn[1]; va[2] = vn[2]; va[3] = vn[3]; } } }
#undef LDV
            }
        }
        if (jn < 0) break;
        j = jn;
    }
    { auto rr = __builtin_amdgcn_permlane32_swap(__float_as_uint(l_acc), __float_as_uint(l_acc), false, false); l_acc = __uint_as_float(rr[0]) + __uint_as_float(rr[1]); }
    WG_BAR();
    LAS unsigned char* xp = lds + (wq * 32 + r) * XP + hh * 16;
    if (mp == 1) {
        const float inv = lam / l_acc;
#pragma unroll
        for (int eb = 0; eb < 8; ++eb)
#pragma unroll
            for (int g4 = 0; g4 < 4; ++g4) { const f32x4 v = {O[eb][4 * g4] * inv, O[eb][4 * g4 + 1] * inv, O[eb][4 * g4 + 2] * inv, O[eb][4 * g4 + 3] * inv};
                *(LAS f32x4*)(xp + (8 * eb + 2 * g4) * 16) = v; }
    }
    WG_BAR();
    if (mp == 0) {
        const float inv = 1.f / l_acc; float ss = 0.f;
#pragma unroll
        for (int eb = 0; eb < 8; ++eb) {
#pragma unroll
            for (int g4 = 0; g4 < 4; ++g4) { const f32x4 x = *(const LAS f32x4*)(xp + (8 * eb + 2 * g4) * 16);
#pragma unroll
                for (int e = 0; e < 4; ++e) { const float v = O[eb][4 * g4 + e] * inv - x[e]; O[eb][4 * g4 + e] = v; ss += v * v; } }
            asm volatile("" ::: "memory"); }
        { auto rr = __builtin_amdgcn_permlane32_swap(__float_as_uint(ss), __float_as_uint(ss), false, false); ss = __uint_as_float(rr[0]) + __uint_as_float(rr[1]); }
        const float rs = rsqrtf(ss * (1.f / 256.f) + EPS) * post_scale;
        bf16_t* op = MIX + (size_t)(b * SEQ + qpos) * D + h * 256 + 4 * hh; const float* gp = gsub + 4 * hh;
#pragma unroll
        for (int eb = 0; eb < 8; ++eb) {
#pragma unroll
            for (int g4 = 0; g4 < 4; ++g4) { const int e0 = 32 * eb + 8 * g4; const f32x4 g = *(const f32x4*)(gp + e0);
                u32x2 w; w.x = cvt_pk_bf16(O[eb][4 * g4] * rs * g[0], O[eb][4 * g4 + 1] * rs * g[1]); w.y = cvt_pk_bf16(O[eb][4 * g4 + 2] * rs * g[2], O[eb][4 * g4 + 3] * rs * g[3]);
                *(u32x2*)(op + e0) = w; }
            asm volatile("" ::: "memory"); }
    }
    WG_BAR();
}
}

namespace gla {
constexpr int O_LA = 0, O_ZL = 32768, O_QT = 36864, O_KT = 54272, O_KHT = 71680, O_VT = 90112, O_AM = 0;
constexpr int PQ = 136, PS = 72;
__device__ __forceinline__ void g1_unit(LAS unsigned char* lds, const bf16_t* UN, const bf16_t* UT, const float* ZLR, const float* w2, const float* bgate, unsigned char* gs, int u, int tid, int wave, int lane) {
    const int c = u & 63, h = (u >> 6) & 3, b = u >> 8; const size_t tok0 = (size_t)b * SEQ + c * 64;
    LAS float* LA = (LAS float*)(lds + O_LA); LAS float* ZL = (LAS float*)(lds + O_ZL);
    LAS bf16_t* QT = (LAS bf16_t*)(lds + O_QT); LAS bf16_t* KT = (LAS bf16_t*)(lds + O_KT); LAS bf16_t* KHT = (LAS bf16_t*)(lds + O_KHT); LAS bf16_t* VT = (LAS bf16_t*)(lds + O_VT); LAS bf16_t* AM = (LAS bf16_t*)(lds + O_AM);
    if (tid < 256) *(LAS f32x4*)(ZL + tid * 4) = *(const f32x4*)(ZLR + tok0 * 16 + tid * 4);
#pragma unroll
    for (int i = 0; i < 4; ++i) { const int id = tid + 512 * i, row = id >> 3, ch = id & 7;
        *(LAS u32x4*)(VT + row * PS + ch * 8) = *(const u32x4*)(UT + (size_t)(2048 + h * 256 + row) * M + tok0 + ch * 8); }
    WG_BAR();
    const int d = tid & 127, qd = tid >> 7;
    float bt[16];
    { float w[16];
#pragma unroll
      for (int rr = 0; rr < 16; ++rr) w[rr] = w2[rr * 512 + h * 128 + d];
      const float bias = bgate[h * 128 + d]; float run = 0.f;
#pragma unroll
      for (int i = 0; i < 16; ++i) { const int t = qd * 16 + i; float x = bias;
#pragma unroll
          for (int rr = 0; rr < 16; ++rr) x += ZL[t * 16 + rr] * w[rr];
          const float ls = fminf(x, 0.f) - log1pf(__expf(-fabsf(x)));
          run += ls * (1.f / 16.f); bt[i] = run; }
      WG_BAR();
      ZL[qd * 128 + d] = run; }
    WG_BAR();
    float off = 0.f, btot = 0.f;
#pragma unroll
    for (int q = 0; q < 4; ++q) { const float p = ZL[q * 128 + d]; btot += p; if (q < qd) off += p; }
    bf16_t* QTg = (bf16_t*)(gs + GLA_QT) + (size_t)u * 64 * 128;
#pragma unroll
    for (int i = 0; i < 16; ++i) { const int t = qd * 16 + i; const float bb = bt[i] + off;
        const float qv = bf2f(UN[(tok0 + t) * UNW + UN_QB + h * 128 + d]) * 0.08838834764831845f, kv = bf2f(UN[(tok0 + t) * UNW + UN_KB + h * 128 + d]);
        const bf16_t qt = f2bf(qv * __expf(bb));
        QT[t * PQ + d] = qt; QTg[t * 128 + d] = qt; KT[t * PQ + d] = f2bf(kv * __expf(-bb)); KHT[d * PS + t] = f2bf(kv * __expf(btot - bb)); }
    if (qd == 0) ((float*)(gs + GLA_DEC))[(size_t)u * 128 + d] = __expf(btot);
    WG_BAR();
    const int r = lane & 31, hh = lane >> 5;
    f32x16 zero;
#pragma unroll
    for (int i = 0; i < 16; ++i) zero[i] = 0.f;
    if (wave < 4) {
        const int mi = wave >> 1, ni = wave & 1;
        const f32x16 a = mma_lds(QT + 32 * mi * PQ, PQ, KT + 32 * ni * PQ, PQ, 128, zero, r, hh);
#pragma unroll
        for (int i = 0; i < 16; ++i) { const int t = 32 * mi + crow(i, hh), s = 32 * ni + r; AM[t * PS + s] = f2bf(s <= t ? a[i] : 0.f); }
    }
    { float* LT = (float*)(gs + GLA_LT) + (size_t)u * 256 * 128;
#pragma unroll
      for (int db = 0; db < 4; ++db) { const f32x16 a = mma_lds(VT + 32 * wave * PS, PS, KHT + 32 * db * PS, PS, 64, zero, r, hh);
#pragma unroll
          for (int i = 0; i < 16; ++i) LT[(size_t)(32 * wave + crow(i, hh)) * 128 + 32 * db + r] = a[i]; } }
    WG_BAR();
    { float* OI = (float*)(gs + GLA_OI) + (size_t)u * 64 * 256;
#pragma unroll
      for (int tb = 0; tb < 2; ++tb) { const f32x16 a = mma_lds(AM + 32 * tb * PS, PS, VT + 32 * wave * PS, PS, 64, zero, r, hh);
#pragma unroll
          for (int i = 0; i < 16; ++i) OI[(size_t)(32 * tb + crow(i, hh)) * 256 + 32 * wave + r] = a[i]; } }
    WG_BAR();
}
__device__ __forceinline__ void g2_scan(unsigned char* gs, int p) {
    const int bh = p >> 14, rem = p & 16383, e = rem >> 6, d2 = (rem & 63) * 2;
    const float* LT = (const float*)(gs + GLA_LT); const float* DEC = (const float*)(gs + GLA_DEC); bf16_t* ST = (bf16_t*)(gs + GLA_ST);
    float s0 = 0.f, s1 = 0.f;
#pragma unroll 8
    for (int c = 0; c < 64; ++c) { const size_t u = (size_t)bh * 64 + c;
        *(unsigned*)(ST + (u * 256 + e) * 128 + d2) = cvt_pk_bf16(s0, s1);
        const f32x2 dc = *(const f32x2*)(DEC + u * 128 + d2), lv = *(const f32x2*)(LT + (u * 256 + e) * 128 + d2);
        s0 = dc.x * s0 + lv.x; s1 = dc.y * s1 + lv.y; }
}
__device__ __forceinline__ void g3_unit(LAS unsigned char* lds, const bf16_t* UN, unsigned char* gs, const float* ggla, bf16_t* MIX, int u, int tid, int wave, int lane) {
    const int c = u & 63, h = (u >> 6) & 3, b = u >> 8; const size_t tok0 = (size_t)b * SEQ + c * 64;
    LAS bf16_t* QT = (LAS bf16_t*)lds; LAS bf16_t* STs = (LAS bf16_t*)(lds + 17408); LAS float* OT = (LAS float*)lds;
    const bf16_t* QTg = (const bf16_t*)(gs + GLA_QT) + (size_t)u * 64 * 128; const bf16_t* ST = (const bf16_t*)(gs + GLA_ST) + (size_t)u * 256 * 128;
#pragma unroll
    for (int i = 0; i < 2; ++i) { const int id = tid + 512 * i, row = id >> 4, ch = id & 15; *(LAS u32x4*)(QT + row * PQ + ch * 8) = *(const u32x4*)(QTg + row * 128 + ch * 8); }
#pragma unroll
    for (int i = 0; i < 8; ++i) { const int id = tid + 512 * i, row = id >> 4, ch = id & 15; *(LAS u32x4*)(STs + row * PQ + ch * 8) = *(const u32x4*)(ST + row * 128 + ch * 8); }
    const int r = lane & 31, hh = lane >> 5;
    const float* OI = (const float*)(gs + GLA_OI) + (size_t)u * 64 * 256;
    f32x16 acc[2];
#pragma unroll
    for (int tb = 0; tb < 2; ++tb)
#pragma unroll
        for (int i = 0; i < 16; ++i) acc[tb][i] = OI[(size_t)(32 * tb + crow(i, hh)) * 256 + 32 * wave + r];
    WG_BAR();
#pragma unroll
    for (int tb = 0; tb < 2; ++tb) acc[tb] = mma_lds(QT + 32 * tb * PQ, PQ, STs + 32 * wave * PQ, PQ, 128, acc[tb], r, hh);
    WG_BAR();
#pragma unroll
    for (int tb = 0; tb < 2; ++tb)
#pragma unroll
        for (int i = 0; i < 16; ++i) OT[(32 * tb + crow(i, hh)) * 260 + 32 * wave + r] = acc[tb][i];
    WG_BAR();
    { const int t = tid >> 3, part = tid & 7; const LAS float* op = OT + t * 260 + part * 32; float v[32]; float ss = 0.f;
#pragma unroll
      for (int q = 0; q < 8; ++q) { const f32x4 x = *(const LAS f32x4*)(op + 4 * q); v[4 * q] = x[0]; v[4 * q + 1] = x[1]; v[4 * q + 2] = x[2]; v[4 * q + 3] = x[3]; ss += x[0] * x[0] + x[1] * x[1] + x[2] * x[2] + x[3] * x[3]; }
      ss += __shfl_xor(ss, 1); ss += __shfl_xor(ss, 2); ss += __shfl_xor(ss, 4);
      const float rs = rsqrtf(ss * (1.f / 256.f) + EPS);
      const bf16_t* gbp = UN + (tok0 + t) * UNW + UN_GB + h * 256 + part * 32; const float* gg = ggla + h * 256 + part * 32;
      bf16_t* mp = MIX + (tok0 + t) * D + 2048 + h * 256 + part * 32;
#pragma unroll
      for (int q = 0; q < 4; ++q) { const bf16x8 gv = *(const bf16x8*)(gbp + 8 * q); float o[8];
#pragma unroll
          for (int e = 0; e < 8; ++e) { const float g = bf2f((bf16_t)gv[e]); o[e] = v[8 * q + e] * rs * gg[8 * q + e] * (g / (1.f + __expf(-g))); }
          u32x4 w; w.x = cvt_pk_bf16(o[0], o[1]); w.y = cvt_pk_bf16(o[2], o[3]); w.z = cvt_pk_bf16(o[4], o[5]); w.w = cvt_pk_bf16(o[6], o[7]);
          *(u32x4*)(mp + 8 * q) = w; } }
    WG_BAR();
}
}

__device__ __forceinline__ void pool_unit(LAS unsigned char* lds, const bf16_t* UN, const bf16_t* WP, const float* pscale, bf16_t* MIX, int pu, int tid, int wave, int lane) {
    const int g = pu & 3, rb = pu >> 2, w = 2 << g; const size_t tok0 = (size_t)rb * 128;
    LAS bf16_t* DT = (LAS bf16_t*)lds; constexpr int PD = 264;
    { const int c = tid & 255, half = tid >> 8, tf = (int)(tok0 & (SEQ - 1)) + 64 * half;
      const bf16_t* up = UN + (tok0 + 64 * half) * UNW + UN_UC + g * 256 + c;
      float s = 0.f;
      for (int j = 1; j < w; ++j) if (tf - j >= 0) s += bf2f(up[-(ptrdiff_t)j * UNW]);
      for (int i = 0; i < 64; ++i) { const int t = tf + i; const float ut = bf2f(up[(size_t)i * UNW]);
          s += ut; const int cnt = (t + 1 < w) ? t + 1 : w;
          DT[(64 * half + i) * PD + c] = f2bf(s / (float)cnt - ut);
          if (t + 1 - w >= 0) s -= bf2f(up[(ptrdiff_t)(i + 1 - w) * UNW]); } }
    WG_BAR();
    const int r = lane & 31, hh = lane >> 5;
    f32x16 acc[4];
#pragma unroll
    for (int mb = 0; mb < 4; ++mb)
#pragma unroll
        for (int i = 0; i < 16; ++i) acc[mb][i] = 0.f;
    const bf16_t* bp = WP + (size_t)g * 65536 + (size_t)(32 * wave + r) * 256 + 8 * hh;
#pragma unroll 4
    for (int ks = 0; ks < 16; ++ks) { const bf16x8 bf = *(const bf16x8*)(bp + 16 * ks);
#pragma unroll
        for (int mb = 0; mb < 4; ++mb) acc[mb] = MFMA32(*(const LAS bf16x8*)(DT + (32 * mb + r) * PD + 16 * ks + 8 * hh), bf, acc[mb]); }
    const int n = 32 * wave + r; const float sc = pscale[g * 256 + n];
#pragma unroll
    for (int mb = 0; mb < 4; ++mb)
#pragma unroll
        for (int i = 0; i < 16; ++i) MIX[(tok0 + 32 * mb + crow(i, hh)) * D + 3072 + g * 256 + n] = f2bf(acc[mb][i] * sc);
    WG_BAR();
}

#define LDS_WAIT() asm volatile("s_waitcnt lgkmcnt(0)" ::: "memory")
#define VM_WAIT() asm volatile("s_waitcnt vmcnt(0)" ::: "memory")
__device__ __forceinline__ unsigned pk2(float lo, float hi) { return (unsigned)f2bf(lo) | ((unsigned)f2bf(hi) << 16); }

__device__ __forceinline__ void cvt_item(const float* __restrict__ W, int ldw, int srccol, int nvalid, bf16_t* __restrict__ Wt, int K, int dstrow, int k0, LAS float* scr, int lane) {
    const int c = lane & 31;
#pragma unroll 8
    for (int i = 0; i < 32; ++i) { const int kk = 2 * i + (lane >> 5); scr[kk * 33 + c] = (c < nvalid) ? W[(size_t)(k0 + kk) * ldw + srccol + c] : 0.f; }
    LDS_WAIT(); asm volatile("" ::: "memory");
    const int c8 = lane & 7;
#pragma unroll
    for (int j = 0; j < 4; ++j) { const int n = (lane >> 3) + 8 * j; const LAS float* s = scr + (8 * c8) * 33 + n;
        u32x4 o; o.x = pk2(s[0 * 33], s[1 * 33]); o.y = pk2(s[2 * 33], s[3 * 33]); o.z = pk2(s[4 * 33], s[5 * 33]); o.w = pk2(s[6 * 33], s[7 * 33]);
        *(u32x4*)(Wt + (size_t)(dstrow + n) * K + k0 + 8 * c8) = o; }
    LDS_WAIT(); asm volatile("" ::: "memory");
}
__device__ __forceinline__ int win_src_col(int d) {
    if (d < 2048) return d + (SRC_QA - 0);
    if (d < 4096) return d + (SRC_KA - 2048);
    if (d < 4608) return d + (SRC_QB - 4096);
    if (d < 5120) return d + (SRC_KB - 4608);
    if (d < 6144) return d + (SRC_GB - 5120);
    if (d < 7168) return d + (SRC_UC - 6144);
    if (d < 9216) return d + (SRC_VA - 7168);
    return d + (SRC_VB - 9216);
}
constexpr int I_IN = 64 * 320, I_Z = 64, I_O = 64 * 128, I_UP = 64 * 688, I_DN = 172 * 128, I_P = 128, I_LAYER = I_IN + I_Z + I_O + I_UP + I_DN + I_P;

__device__ __forceinline__ void norm_row(const float* X, float* H, const bf16_t* Y, const float* gpost, const float* gnext, bf16_t* HN, int row, int lane) {
    f32x4 hv[16];
    const f32x4* src = (const f32x4*)((X ? X : H) + (size_t)row * D) + lane;
#pragma unroll
    for (int j = 0; j < 16; ++j) hv[j] = src[64 * j];
    if (Y) {
        const u32x2* yp = (const u32x2*)(Y + (size_t)row * D) + lane;
        f32x4 yv[16]; float s = 0.f;
#pragma unroll
        for (int j = 0; j < 16; ++j) { const u32x2 w = yp[64 * j]; yv[j] = (f32x4){__uint_as_float(w.x << 16), __uint_as_float(w.x & 0xffff0000u), __uint_as_float(w.y << 16), __uint_as_float(w.y & 0xffff0000u)}; s += yv[j].x * yv[j].x + yv[j].y * yv[j].y + yv[j].z * yv[j].z + yv[j].w * yv[j].w; }
        const float rs = rsqrtf(wave_sum(s) * (1.f / D) + EPS);
#pragma unroll
        for (int j = 0; j < 16; ++j) { const f32x4 g = ((const f32x4*)gpost)[lane + 64 * j]; hv[j] += yv[j] * rs * g; }
    }
    if (X || Y) {
        f32x4* hp = (f32x4*)(H + (size_t)row * D) + lane;
#pragma unroll
        for (int j = 0; j < 16; ++j) hp[64 * j] = hv[j];
    }
    if (gnext) {
        float s = 0.f;
#pragma unroll
        for (int j = 0; j < 16; ++j) s += hv[j].x * hv[j].x + hv[j].y * hv[j].y + hv[j].z * hv[j].z + hv[j].w * hv[j].w;
        const float rs = rsqrtf(wave_sum(s) * (1.f / D) + EPS);
        u32x2* op = (u32x2*)(HN + (size_t)row * D) + lane;
#pragma unroll
        for (int j = 0; j < 16; ++j) { const f32x4 g = ((const f32x4*)gnext)[lane + 64 * j]; const f32x4 v = hv[j] * rs * g;
            u32x2 o; o.x = cvt_pk_bf16(v.x, v.y); o.y = cvt_pk_bf16(v.z, v.w); op[64 * j] = o; }
    }
}

__device__ __forceinline__ void zlr_rows(const bf16_t* HN, const bf16_t* WZ, float* ZLR, int rb, LAS unsigned char* lds, int tid, int wave, int lane) {
    const int r = lane & 31, h = lane >> 5;
    f32x16 acc;
#pragma unroll
    for (int e = 0; e < 16; ++e) acc[e] = 0.f;
    const bf16_t* ap = HN + (size_t)(rb * 32 + r) * D + wave * 512 + 8 * h;
    const bf16_t* bp = WZ + (size_t)r * D + wave * 512 + 8 * h;
#pragma unroll 8
    for (int k = 0; k < 512; k += 16) acc = __builtin_amdgcn_mfma_f32_32x32x16_bf16(*(const bf16x8*)(ap + k), *(const bf16x8*)(bp + k), acc, 0, 0, 0);
    LAS float* red = (LAS float*)lds;
    if (r < 16) {
#pragma unroll
        for (int e = 0; e < 16; ++e) red[(wave * 32 + (e & 3) + 8 * (e >> 2) + 4 * h) * 16 + r] = acc[e];
    }
    __syncthreads();
    { const int row = tid >> 4, n = tid & 15; float s = 0.f;
#pragma unroll
      for (int w = 0; w < 8; ++w) s += red[(w * 32 + row) * 16 + n];
      ZLR[(size_t)(rb * 32 + row) * 16 + n] = s; }
    __syncthreads();
}


__device__ __forceinline__ void knorm_rows(const bf16_t* UN, unsigned* KMAX, int rb, LAS unsigned char* lds, int tid) {
    const int row = tid >> 4, hm = tid & 15; const size_t tok = (size_t)rb * 32 + row;
    const bf16_t* kp = UN + tok * UNW + UN_KA + hm * 128; float s = 0.f;
#pragma unroll
    for (int c = 0; c < 16; ++c) { const bf16x8 v = *(const bf16x8*)(kp + 8 * c);
#pragma unroll
        for (int e = 0; e < 8; ++e) { const float x = bf2f((bf16_t)v[e]); s += x * x; } }
    LAS float* red = (LAS float*)lds;
    red[hm * 33 + row] = sqrtf(s);
    __syncthreads();
    if (tid < 16) { float m = 0.f;
#pragma unroll
        for (int r2 = 0; r2 < 32; ++r2) m = fmaxf(m, red[tid * 33 + r2]);
        const int b = (int)(((size_t)rb * 32) >> 12), tile = (int)((((size_t)rb * 32) & (SEQ - 1)) >> 6);
        __hip_atomic_fetch_max(KMAX + (b * 16 + tid) * 64 + tile, __float_as_uint(m), __ATOMIC_RELAXED, __HIP_MEMORY_SCOPE_AGENT); }
    __syncthreads();
}
__device__ __forceinline__ float gelu_tanh_fast(float x) { const float u = 1.5957691216057308f * (x + 0.044715f * x * x * x); return x / (1.f + __expf(-u)); }
__device__ __forceinline__ void conv_run(const bf16_t* Z, const float* wc, const float* bc, bf16_t* F, int run, int tid) {
    const size_t t0 = (size_t)run * 32; const bool first = ((run * 32) & (SEQ - 1)) == 0;
    for (int oc = tid; oc < DFF / 8; oc += 512) {
        const int c0 = oc * 8;
        float wg[3][8], wv[3][8], bg[8], bv[8];
#pragma unroll
        for (int j = 0; j < 3; ++j)
#pragma unroll
            for (int q = 0; q < 2; ++q) { const f32x4 a = *(const f32x4*)(wc + (size_t)j * NUP + c0 + 4 * q), b = *(const f32x4*)(wc + (size_t)j * NUP + DFF + c0 + 4 * q);
#pragma unroll
                for (int e = 0; e < 4; ++e) { wg[j][4 * q + e] = a[e]; wv[j][4 * q + e] = b[e]; } }
#pragma unroll
        for (int q = 0; q < 2; ++q) { const f32x4 a = *(const f32x4*)(bc + c0 + 4 * q), b = *(const f32x4*)(bc + DFF + c0 + 4 * q);
#pragma unroll
            for (int e = 0; e < 4; ++e) { bg[4 * q + e] = a[e]; bv[4 * q + e] = b[e]; } }
        float g2[8], g1[8], v2[8], v1[8];
        if (first) {
#pragma unroll
            for (int e = 0; e < 8; ++e) { g2[e] = 0.f; g1[e] = 0.f; v2[e] = 0.f; v1[e] = 0.f; }
        } else {
            const bf16x8 a2 = *(const bf16x8*)(Z + (t0 - 2) * NUP + c0), a1 = *(const bf16x8*)(Z + (t0 - 1) * NUP + c0), b2 = *(const bf16x8*)(Z + (t0 - 2) * NUP + DFF + c0), b1 = *(const bf16x8*)(Z + (t0 - 1) * NUP + DFF + c0);
#pragma unroll
            for (int e = 0; e < 8; ++e) { g2[e] = bf2f((bf16_t)a2[e]); g1[e] = bf2f((bf16_t)a1[e]); v2[e] = bf2f((bf16_t)b2[e]); v1[e] = bf2f((bf16_t)b1[e]); }
        }
#pragma unroll 4
        for (int r = 0; r < 32; ++r) {
            const bf16x8 a0 = *(const bf16x8*)(Z + (t0 + r) * NUP + c0), b0 = *(const bf16x8*)(Z + (t0 + r) * NUP + DFF + c0);
            float o[8];
#pragma unroll
            for (int e = 0; e < 8; ++e) { const float g0 = bf2f((bf16_t)a0[e]), v0 = bf2f((bf16_t)b0[e]);
                const float gt = bg[e] + wg[0][e] * g2[e] + wg[1][e] * g1[e] + wg[2][e] * g0, vl = bv[e] + wv[0][e] * v2[e] + wv[1][e] * v1[e] + wv[2][e] * v0;
                o[e] = gelu_tanh_fast(gt) * vl; g2[e] = g1[e]; g1[e] = g0; v2[e] = v1[e]; v1[e] = v0; }
            u32x4 w; w.x = cvt_pk_bf16(o[0], o[1]); w.y = cvt_pk_bf16(o[2], o[3]); w.z = cvt_pk_bf16(o[4], o[5]); w.w = cvt_pk_bf16(o[6], o[7]);
            *(u32x4*)(F + (t0 + r) * DFF + c0) = w;
        }
    }
}

constexpr int NPH = 21;
struct Args { const float* in[21]; float* out; unsigned char* ws; int ph_lo, ph_hi; };

__device__ __forceinline__ const void* lds_ptr(volatile LAS unsigned* A, int i) {
    const unsigned lo = __builtin_amdgcn_readfirstlane(A[2 * i]), hi = __builtin_amdgcn_readfirstlane(A[2 * i + 1]);
    return (const void*)(const GAS void*)(((unsigned long long)hi << 32) | (unsigned long long)lo);
}
constexpr int ARGS_OFF = RING_BYTES + 1024;
template <int LO, int HI> __global__ void __launch_bounds__(512, 2) fwd(Args args) {
    extern __shared__ __attribute__((aligned(16))) unsigned char lds_raw[];
    LAS unsigned char* lds = (LAS unsigned char*)lds_raw;
    volatile LAS unsigned* MISC = (volatile LAS unsigned*)(lds + MISC_OFF);
    volatile LAS unsigned* AP = (volatile LAS unsigned*)(lds + ARGS_OFF);
    const int wave = __builtin_amdgcn_readfirstlane((int)threadIdx.x >> 6);
#define FRESH_TID() int tid = threadIdx.x; asm volatile("" : "+v"(tid)); const int lane = tid & 63
#define P(i) ((const float*)lds_ptr(AP, (i)))
#define WSP() ((unsigned char*)lds_ptr(AP, 22))
    const int G = gridDim.x; const int bx = blockIdx.x; const int vcu = (G % 8 == 0) ? (bx % 8) * (G / 8) + bx / 8 : bx;
    constexpr int lo = LO, hi = HI;
    for (int u = threadIdx.x; u < (LDS_BYTES - LDSCTL_OFF) / 4; u += 512) ((LAS unsigned*)(lds + LDSCTL_OFF))[u] = 0u;
    __syncthreads();
    if (threadIdx.x == 0) {
        volatile LAS unsigned long long* A8 = (volatile LAS unsigned long long*)(lds + ARGS_OFF);
#pragma unroll
        for (int i = 0; i < 21; ++i) A8[i] = (unsigned long long)args.in[i];
        A8[21] = (unsigned long long)args.out; A8[22] = (unsigned long long)args.ws;
    }
    __syncthreads();
    XcdBarrier bar; bar.bar = (unsigned*)(WSP() + WS_CTL) + CW_BAR; bar.x = 0; bar.st = nullptr;
    if (hi - lo > 1) bar = xcd_barrier_post((unsigned*)(WSP() + WS_CTL) + CW_BAR, MISC + 8);
#define IN(k) (lo <= (k) && (k) < hi)
#define BOTH(k) (IN(k) && IN((k) + 1))
#define GRID_BAR(k) do { if (BOTH(k)) xcd_barrier(bar); } while (0)
#define REP(k) _Pragma("unroll") for (int rep_ = 0; rep_ < ((k) == MK_DOUBLE_PHASE ? 2 : 1); ++rep_)
    const int gw = vcu * 8 + wave, NGW = G * 8;

    if (IN(0)) REP(0) {
        FRESH_TID();
        unsigned char* ws = WSP();
        LAS float* scr = (LAS float*)(lds + wave * 16384);
        for (int it = gw; it < 2 * I_LAYER; it += NGW) {
            const int l = it >= I_LAYER ? 1 : 0; int r = it - l * I_LAYER;
            unsigned char* wl = ws + WS_W0 + (size_t)l * W_LAYER;
            if (r < I_IN) { const int kb = r / 320, nb = r % 320, d0 = nb * 32; cvt_item(P(1) + (size_t)l * D * NIN, NIN, win_src_col(d0), 32, (bf16_t*)(wl + OFF_WN), D, d0, kb * 64, scr, lane); continue; } r -= I_IN;
            if (r < I_Z) { cvt_item(P(1) + (size_t)l * D * NIN, NIN, SRC_ZLR, 16, (bf16_t*)(wl + OFF_WZ), D, 0, r * 64, scr, lane); continue; } r -= I_Z;
            if (r < I_O) { const int kb = r / 128, nb = r % 128; cvt_item(P(12) + (size_t)l * D * D, D, nb * 32, 32, (bf16_t*)(wl + OFF_WO), D, nb * 32, kb * 64, scr, lane); continue; } r -= I_O;
            if (r < I_UP) { const int kb = r / 688, nb = r % 688; cvt_item(P(13) + (size_t)l * D * NUP, NUP, nb * 32, 32, (bf16_t*)(wl + OFF_WUP), D, nb * 32, kb * 64, scr, lane); continue; } r -= I_UP;
            if (r < I_DN) { const int kb = r / 128, nb = r % 128; cvt_item(P(16) + (size_t)l * DFF * D, D, nb * 32, 32, (bf16_t*)(wl + OFF_WDN), DFF, nb * 32, kb * 64, scr, lane); continue; } r -= I_DN;
            { const int g = r >> 5, kb = (r >> 3) & 3, nb = r & 7; cvt_item(P(10) + ((size_t)l * 4 + g) * 65536, 256, nb * 32, 32, (bf16_t*)(wl + OFF_WP) + (size_t)g * 65536, 256, nb * 32, kb * 64, scr, lane); }
        }
        { const float* x = P(0); float* H = (float*)P(21); const float* g0 = P(17); bf16_t* HN = (bf16_t*)(ws + WS_HN);
          for (int m = gw; m < M; m += NGW) norm_row(x, H, nullptr, nullptr, g0, HN, m, lane); }
        GRID_BAR(0);
    }

    _Pragma("unroll") for (int l = 0; l < DEPTH; ++l) {
        const int pb = 1 + 10 * l;
        if (IN(pb + 0)) REP(pb + 0) {
            unsigned char* ws = WSP(); unsigned char* wl = ws + WS_W0 + (size_t)l * W_LAYER;
            const bf16_t* HN = (const bf16_t*)(ws + WS_HN);
            { pg8::Gemm g; g.A[0] = HN; g.Bt[0] = (const bf16_t*)(wl + OFF_WN); g.A[1] = (const bf16_t*)(wl + OFF_WT); g.Bt[1] = HN; g.lda = D; g.ldb = D; g.K = D;
              pg8::Order2 S; S.nM0 = M / 256; S.nN0 = UNW / 256; S.nM1 = UTW / 256; S.nN1 = M / 256; S.G = G; S.c = bx;
              pg8::EpiBf16 E; E.O[0] = (bf16_t*)(ws + WS_UN); E.ldc[0] = UNW; E.O[1] = (bf16_t*)(ws + WS_UT); E.ldc[1] = M;
              pg8::gemm_phase<pg8::EpiBf16, pg8::Order2, PG8_ALIGN, PG8_SP2>(lds, g, S, E); }
            FRESH_TID();
            for (int rb = bx; rb < M / 32; rb += G) zlr_rows(HN, (const bf16_t*)(wl + OFF_WZ), (float*)(ws + WS_ZLR), rb, lds, tid, wave, lane);
            for (int rb = bx; rb < M / 32; rb += G) knorm_rows((const bf16_t*)(ws + WS_UN), (unsigned*)(ws + WS_CTL) + CW_KMAX + l * 2048, rb, lds, tid);
            GRID_BAR(pb + 0);
        }
        if (IN(pb + 1)) REP(pb + 1) {
            FRESH_TID();
            unsigned char* ws = WSP(); unsigned char* gs = ws + WS_GLA;
            const bf16_t* UN = (const bf16_t*)(ws + WS_UN); const bf16_t* UT = (const bf16_t*)(ws + WS_UT); bf16_t* MIX = (bf16_t*)(ws + WS_MIX);
            { const float* w2 = P(2) + (size_t)l * 16 * 512; const float* bgt = P(3) + (size_t)l * 512; const float* ZLR = (const float*)(ws + WS_ZLR);
              FRESH_TID();
              for (int u = vcu; u < 512; u += G) gla::g1_unit(lds, UN, UT, ZLR, w2, bgt, gs, u, tid, wave, lane); }
            { const bf16_t* WP = (const bf16_t*)(ws + WS_W0 + (size_t)l * W_LAYER + OFF_WP); const float* psc = P(11) + (size_t)l * 1024;
              FRESH_TID();
              for (int pu = vcu; pu < 256; pu += G) pool_unit(lds, UN, WP, psc, MIX, pu, tid, wave, lane); }
            { const float lam_init = 0.8f - 0.6f * expf(-0.3f * (float)l);
              float lam = lam_of(P(4) + l * 128, P(5) + l * 128, P(6) + l * 128, P(7) + l * 128, lane, lam_init);
              lam = __uint_as_float(__builtin_amdgcn_readfirstlane(__float_as_uint(lam)));
              const float* gsub = P(8) + l * 256;
              FRESH_TID();
              unsigned* ctl = (unsigned*)(ws + WS_CTL);
              for (;;) {
                  if (tid == 0) MISC[16] = __hip_atomic_fetch_add(ctl + CW_QUEUE + l * 64, 1u, __ATOMIC_RELAXED, __HIP_MEMORY_SCOPE_AGENT);
                  __syncthreads();
                  const int idx = __builtin_amdgcn_readfirstlane((int)MISC[16]);
                  __syncthreads();
                  if (idx >= 512) break;
                  att::unit(lds, UN, UT, MIX, ctl + CW_KMAX + l * 2048, idx & 1, 7 - ((idx >> 1) & 7), 31 - (idx >> 4), lam, gsub, 1.f - lam_init, wave, lane); } }
            GRID_BAR(pb + 1);
        }
        if (IN(pb + 2)) REP(pb + 2) {
            FRESH_TID();
            unsigned char* gs = WSP() + WS_GLA;
            for (int p = vcu * 512 + tid; p < 131072; p += G * 512) gla::g2_scan(gs, p);
            GRID_BAR(pb + 2);
        }
        if (IN(pb + 3)) REP(pb + 3) {
            FRESH_TID();
            unsigned char* ws = WSP(); unsigned char* gs = ws + WS_GLA; const float* gg = P(9) + (size_t)l * 1024;
            for (int u = vcu; u < 512; u += G) gla::g3_unit(lds, (const bf16_t*)(ws + WS_UN), gs, gg, (bf16_t*)(ws + WS_MIX), u, tid, wave, lane);
            GRID_BAR(pb + 3);
        }
        if (IN(pb + 4)) REP(pb + 4) {
            unsigned char* ws = WSP(); unsigned char* wl = ws + WS_W0 + (size_t)l * W_LAYER;
            pg8::Gemm g; g.A[0] = (const bf16_t*)(ws + WS_MIX); g.Bt[0] = (const bf16_t*)(wl + OFF_WO); g.A[1] = g.A[0]; g.Bt[1] = g.Bt[0]; g.lda = D; g.ldb = D; g.K = D;
            pg8::Order2 S; S.nM0 = M / 256; S.nN0 = D / 256; S.nM1 = 0; S.nN1 = 1; S.G = G; S.c = bx;
            pg8::EpiBf16 E; E.O[0] = (bf16_t*)(ws + WS_Y); E.ldc[0] = D; E.O[1] = E.O[0]; E.ldc[1] = D;
            pg8::gemm_phase<pg8::EpiBf16, pg8::Order2, PG8_ALIGN, PG8_SP2>(lds, g, S, E);
            GRID_BAR(pb + 4);
        }
        if (IN(pb + 5)) {
            FRESH_TID();
            unsigned char* ws = WSP(); float* H = (float*)P(21); const bf16_t* Y = (const bf16_t*)(ws + WS_Y); const float* gp = P(18) + (size_t)l * D; const float* gn = P(19) + (size_t)l * D; bf16_t* HN = (bf16_t*)(ws + WS_HN);
            for (int m = gw; m < M; m += NGW) norm_row(nullptr, H, Y, gp, gn, HN, m, lane);
            GRID_BAR(pb + 5);
        }
        if (IN(pb + 6)) REP(pb + 6) {
            unsigned char* ws = WSP(); unsigned char* wl = ws + WS_W0 + (size_t)l * W_LAYER;
            pg8::Gemm g; g.A[0] = (const bf16_t*)(ws + WS_HN); g.Bt[0] = (const bf16_t*)(wl + OFF_WUP); g.A[1] = g.A[0]; g.Bt[1] = g.Bt[0]; g.lda = D; g.ldb = D; g.K = D;
            pg8::Order2 S; S.nM0 = M / 256; S.nN0 = NUP / 256; S.nM1 = 0; S.nN1 = 1; S.G = G; S.c = bx;
            pg8::EpiBf16 E; E.O[0] = (bf16_t*)(ws + WS_Z); E.ldc[0] = NUP; E.O[1] = E.O[0]; E.ldc[1] = NUP;
            pg8::gemm_phase<pg8::EpiBf16, pg8::Order2, PG8_ALIGN, PG8_SP2>(lds, g, S, E);
            GRID_BAR(pb + 6);
        }
        if (IN(pb + 7)) REP(pb + 7) {
            FRESH_TID();
            unsigned char* ws = WSP(); const float* wc = P(14) + (size_t)l * 3 * NUP; const float* bc = P(15) + (size_t)l * NUP;
            for (int run = bx; run < M / 32; run += G) conv_run((const bf16_t*)(ws + WS_Z), wc, bc, (bf16_t*)(ws + WS_F), run, tid);
            GRID_BAR(pb + 7);
        }
        if (IN(pb + 8)) REP(pb + 8) {
            unsigned char* ws = WSP(); unsigned char* wl = ws + WS_W0 + (size_t)l * W_LAYER;
            pg8::Gemm g; g.A[0] = (const bf16_t*)(ws + WS_F); g.Bt[0] = (const bf16_t*)(wl + OFF_WDN); g.A[1] = g.A[0]; g.Bt[1] = g.Bt[0]; g.lda = DFF; g.ldb = DFF; g.K = DFF;
            pg8::Order2 S; S.nM0 = M / 256; S.nN0 = D / 256; S.nM1 = 0; S.nN1 = 1; S.G = G; S.c = bx;
            pg8::EpiBf16 E; E.O[0] = (bf16_t*)(ws + WS_Y); E.ldc[0] = D; E.O[1] = E.O[0]; E.ldc[1] = D;
            pg8::gemm_phase<pg8::EpiBf16, pg8::Order2, PG8_ALIGN, PG8_SP2>(lds, g, S, E);
            GRID_BAR(pb + 8);
        }
        if (IN(pb + 9)) {
            FRESH_TID();
            unsigned char* ws = WSP(); float* H = (float*)P(21); const bf16_t* Y = (const bf16_t*)(ws + WS_Y); const float* gp = P(20) + (size_t)l * D; const float* gn = l + 1 < DEPTH ? P(17) + (size_t)(l + 1) * D : nullptr; bf16_t* HN = (bf16_t*)(ws + WS_HN);
            for (int m = gw; m < M; m += NGW) norm_row(nullptr, H, Y, gp, gn, HN, m, lane);
            GRID_BAR(pb + 9);
        }
    }
#undef IN
#undef BOTH
#undef GRID_BAR
}

static int g_grid = 0;
template <int LO, int HI> static void launch_range(hipStream_t stream, const Args& a) {
    static bool attr = false;
    if (!attr) { if (hipFuncSetAttribute((const void*)fwd<LO, HI>, hipFuncAttributeMaxDynamicSharedMemorySize, LDS_BYTES) != hipSuccess) fprintf(stderr, "kernel_launch: hipFuncSetAttribute failed\n"); attr = true; }
    hipLaunchKernelGGL((fwd<LO, HI>), dim3(g_grid), dim3(512), LDS_BYTES, stream, a);
    const hipError_t le = hipPeekAtLastError();
    if (le != hipSuccess) fprintf(stderr, "kernel_launch: fwd launch [%d,%d) failed: %s\n", LO, HI, hipGetErrorName(le));
}
template <int P> static void launch_each(hipStream_t stream, const Args& a) { if constexpr (P < NPH) { launch_range<P, P + 1>(stream, a); launch_each<P + 1>(stream, a); } }
extern "C" void kernel_launch(void* const* d_in, const int* in_sizes, int n_in, void* d_out, int out_size, void* d_ws, size_t ws_size, hipStream_t stream) {
    if (n_in != 21 || ws_size < WS_END) { fprintf(stderr, "kernel_launch: unexpected n_in %d or ws %zu < %zu\n", n_in, ws_size, (size_t)WS_END); return; }
    if (g_grid == 0) {
        int dev = 0, cus = 0;
        if (hipGetDevice(&dev) != hipSuccess || hipDeviceGetAttribute(&cus, hipDeviceAttributeMultiprocessorCount, dev) != hipSuccess) { fprintf(stderr, "kernel_launch: device query failed\n"); g_grid = -1; return; }
        g_grid = cus;
    }
    if (g_grid < 0) return;
    (void)hipMemsetAsync((char*)d_ws + WS_CTL, 0, CTL_ZERO_BYTES, stream);
    Args a{};
    for (int i = 0; i < 21; ++i) a.in[i] = (const float*)d_in[i];
    a.out = (float*)d_out; a.ws = (unsigned char*)d_ws;
#if MK_ONE_LAUNCH
    launch_range<0, NPH>(stream, a);
#else
    launch_each<0>(stream, a);
#endif
}
```

```cpp
#ifndef MK_ONE_LAUNCH
#define MK_ONE_LAUNCH 1
#endif
#ifndef MK_DOUBLE_PHASE
#define MK_DOUBLE_PHASE (-1)
#endif
#include <hip/hip_runtime.h>
#include <stdint.h>
#include <stdio.h>

typedef unsigned short bf16_t;
typedef short bf16x8 __attribute__((ext_vector_type(8)));
typedef float f32x4 __attribute__((ext_vector_type(4)));
typedef float f32x16 __attribute__((ext_vector_type(16)));

constexpr int D = 4096, SEQ = 4096, M = 8192, DEPTH = 2;
constexpr int NIN = 10256, DFF = 11008, NUP = 22016;
constexpr int UNW = 7168, UTW = 3072;
constexpr float EPS = 1e-6f;
constexpr int UN_QA = 0, UN_KA = 2048, UN_QB = 4096, UN_KB = 4608, UN_GB = 5120, UN_UC = 6144;
constexpr int SRC_QA = 0, SRC_KA = 2048, SRC_VA = 4096, SRC_QB = 6144, SRC_KB = 6656, SRC_VB = 7168, SRC_GB = 8192, SRC_ZLR = 9216, SRC_UC = 9232;

constexpr size_t MiB = 1u << 20;
constexpr size_t WS_CTL = 0;
constexpr size_t WS_W0 = 1 * MiB;
constexpr size_t OFF_WN = 0, OFF_WT = 56 * MiB, OFF_WO = 80 * MiB, OFF_WUP = 112 * MiB, OFF_WDN = 284 * MiB, OFF_WP = 370 * MiB, W_LAYER = 371 * MiB;
constexpr size_t WS_HN = WS_W0 + 2 * W_LAYER;
constexpr size_t WS_UN = WS_HN + 64 * MiB;
constexpr size_t WS_UT = WS_UN + 112 * MiB;
constexpr size_t WS_ZLR = WS_UT + 48 * MiB;
constexpr size_t WS_MIX = WS_ZLR + 1 * MiB;
constexpr size_t WS_Y = WS_MIX + 64 * MiB;
constexpr size_t WS_Z = WS_Y + 128 * MiB;
constexpr size_t WS_F = WS_Z + 344 * MiB;
constexpr size_t WS_DP = WS_F + 172 * MiB;
constexpr size_t WS_END = WS_DP + 16 * MiB;

__device__ __forceinline__ bf16_t f2bf(float f) { unsigned u = __float_as_uint(f); u += 0x7fffu + ((u >> 16) & 1u); return (bf16_t)(u >> 16); }
__device__ __forceinline__ float bf2f(bf16_t b) { return __uint_as_float(((unsigned)b) << 16); }
__device__ __forceinline__ float wave_sum(float v) {
#pragma unroll
    for (int o = 1; o < 64; o <<= 1) v += __shfl_xor(v, o);
    return v;
}
__device__ __forceinline__ float wave_max(float v) {
#pragma unroll
    for (int o = 1; o < 64; o <<= 1) v = fmaxf(v, __shfl_xor(v, o));
    return v;
}

__global__ void k_cvt_t(const float* __restrict__ W, int ldw, int c0, bf16_t* __restrict__ Wt, int K, int r0) {
    __shared__ float t[64][65];
    const int nb = blockIdx.x, kb = blockIdx.y, tx = threadIdx.x & 63, ty = threadIdx.x >> 6;
    for (int i = ty; i < 64; i += 4) t[i][tx] = W[(size_t)(kb * 64 + i) * ldw + c0 + nb * 64 + tx];
    __syncthreads();
    for (int i = ty; i < 64; i += 4) Wt[(size_t)(r0 + nb * 64 + i) * K + kb * 64 + tx] = f2bf(t[tx][i]);
}

template <int OUTF32>
__global__ __launch_bounds__(256) void k_gemm(const bf16_t* __restrict__ A, int lda, const bf16_t* __restrict__ Bt, int ldb, void* C, int ldc, int K, const float* cscale) {
    const int wid = threadIdx.x >> 6, lane = threadIdx.x & 63, r = lane & 31, h = lane >> 5;
    const int m0 = blockIdx.y * 128 + (wid >> 1) * 64, n0 = blockIdx.x * 128 + (wid & 1) * 64;
    f32x16 acc[2][2];
#pragma unroll
    for (int i = 0; i < 2; ++i)
#pragma unroll
        for (int j = 0; j < 2; ++j)
#pragma unroll
            for (int e = 0; e < 16; ++e) acc[i][j][e] = 0.f;
    const bf16_t* a0 = A + (size_t)(m0 + r) * lda + 8 * h;
    const bf16_t* a1 = a0 + (size_t)32 * lda;
    const bf16_t* b0 = Bt + (size_t)(n0 + r) * ldb + 8 * h;
    const bf16_t* b1 = b0 + (size_t)32 * ldb;
    for (int k = 0; k < K; k += 16) {
        const bf16x8 fa0 = *(const bf16x8*)(a0 + k), fa1 = *(const bf16x8*)(a1 + k), fb0 = *(const bf16x8*)(b0 + k), fb1 = *(const bf16x8*)(b1 + k);
        acc[0][0] = __builtin_amdgcn_mfma_f32_32x32x16_bf16(fa0, fb0, acc[0][0], 0, 0, 0);
        acc[0][1] = __builtin_amdgcn_mfma_f32_32x32x16_bf16(fa0, fb1, acc[0][1], 0, 0, 0);
        acc[1][0] = __builtin_amdgcn_mfma_f32_32x32x16_bf16(fa1, fb0, acc[1][0], 0, 0, 0);
        acc[1][1] = __builtin_amdgcn_mfma_f32_32x32x16_bf16(fa1, fb1, acc[1][1], 0, 0, 0);
    }
#pragma unroll
    for (int i = 0; i < 2; ++i)
#pragma unroll
        for (int j = 0; j < 2; ++j)
#pragma unroll
            for (int e = 0; e < 16; ++e) {
                const int row = m0 + 32 * i + (e & 3) + 8 * (e >> 2) + 4 * h, col = n0 + 32 * j + r;
                float v = acc[i][j][e];
                if (OUTF32) ((float*)C)[(size_t)row * ldc + col] = v;
                else { if (cscale) v *= cscale[col]; ((bf16_t*)C)[(size_t)row * ldc + col] = f2bf(v); }
            }
}

__global__ __launch_bounds__(256) void k_norm(const float* X, float* H, const float* Y, const float* gpost, const float* gnext, bf16_t* HN) {
    const int row = blockIdx.x * 4 + (threadIdx.x >> 6), lane = threadIdx.x & 63;
    f32x4 hv[16];
    const f32x4* src = (const f32x4*)((X ? X : H) + (size_t)row * D) + lane;
#pragma unroll
    for (int j = 0; j < 16; ++j) hv[j] = src[64 * j];
    if (Y) {
        const f32x4* yp = (const f32x4*)(Y + (size_t)row * D) + lane;
        f32x4 yv[16]; float s = 0.f;
#pragma unroll
        for (int j = 0; j < 16; ++j) { yv[j] = yp[64 * j]; s += yv[j].x * yv[j].x + yv[j].y * yv[j].y + yv[j].z * yv[j].z + yv[j].w * yv[j].w; }
        const float rs = rsqrtf(wave_sum(s) * (1.f / D) + EPS);
#pragma unroll
        for (int j = 0; j < 16; ++j) { const f32x4 g = ((const f32x4*)gpost)[lane + 64 * j]; hv[j] += yv[j] * rs * g; }
    }
    if (X || Y) {
        f32x4* hp = (f32x4*)(H + (size_t)row * D) + lane;
#pragma unroll
        for (int j = 0; j < 16; ++j) hp[64 * j] = hv[j];
    }
    if (gnext) {
        float s = 0.f;
#pragma unroll
        for (int j = 0; j < 16; ++j) s += hv[j].x * hv[j].x + hv[j].y * hv[j].y + hv[j].z * hv[j].z + hv[j].w * hv[j].w;
        const float rs = rsqrtf(wave_sum(s) * (1.f / D) + EPS);
        uint2* op = (uint2*)(HN + (size_t)row * D) + lane;
#pragma unroll
        for (int j = 0; j < 16; ++j) { const f32x4 g = ((const f32x4*)gnext)[lane + 64 * j]; const f32x4 v = hv[j] * rs * g;
            uint2 o; o.x = (unsigned)f2bf(v.x) | ((unsigned)f2bf(v.y) << 16); o.y = (unsigned)f2bf(v.z) | ((unsigned)f2bf(v.w) << 16); op[64 * j] = o; }
    }
}

__global__ __launch_bounds__(256) void k_zlr(const bf16_t* HN, const float* w_in, float* ZLR) {
    const int row = blockIdx.x * 4 + (threadIdx.x >> 6), lane = threadIdx.x & 63;
    float acc[16];
#pragma unroll
    for (int j = 0; j < 16; ++j) acc[j] = 0.f;
    for (int k = lane; k < D; k += 64) {
        const float a = bf2f(HN[(size_t)row * D + k]);
        const f32x4* w = (const f32x4*)(w_in + (size_t)k * NIN + SRC_ZLR);
#pragma unroll
        for (int q = 0; q < 4; ++q) { const f32x4 wv = w[q]; acc[4 * q] += a * wv.x; acc[4 * q + 1] += a * wv.y; acc[4 * q + 2] += a * wv.z; acc[4 * q + 3] += a * wv.w; }
    }
#pragma unroll
    for (int j = 0; j < 16; ++j) acc[j] = wave_sum(acc[j]);
    if (lane == 0) {
#pragma unroll
        for (int j = 0; j < 16; ++j) ZLR[(size_t)row * 16 + j] = acc[j];
    }
}

__device__ __forceinline__ float lam_of(const float* q1, const float* k1, const float* q2, const float* k2, int lane, float lam_init) {
    float s1 = q1[lane] * k1[lane] + q1[lane + 64] * k1[lane + 64], s2 = q2[lane] * k2[lane] + q2[lane + 64] * k2[lane + 64];
    s1 = wave_sum(s1); s2 = wave_sum(s2);
    return expf(s1) - expf(s2) + lam_init;
}

__global__ __launch_bounds__(64) void k_attn_naive(const bf16_t* UN, const bf16_t* UT, bf16_t* MIX, const float* lq1, const float* lk1, const float* lq2, const float* lk2, const float* gsub, float lam_init) {
    __shared__ float sc[2][SEQ];
    __shared__ float qv[2][128];
    const int lane = threadIdx.x, q = blockIdx.x % SEQ, h = (blockIdx.x / SEQ) % 8, b = blockIdx.x / (SEQ * 8);
    const float lam = lam_of(lq1, lk1, lq2, lk2, lane, lam_init);
    const size_t tok = (size_t)b * SEQ + q;
    for (int i = lane; i < 256; i += 64) qv[i >> 7][i & 127] = bf2f(UN[tok * UNW + UN_QA + h * 256 + i]);
    __syncthreads();
    const int nk = (q / 64 + 1) * 64;
    const float slope = exp2f(-(float)(h + 1)), scale = 0.08838834764831845f;
    float mx[2] = {-INFINITY, -INFINITY};
    for (int j = lane; j < nk; j += 64) {
        const bf16_t* kp = UN + ((size_t)b * SEQ + j) * UNW + UN_KA + h * 256;
#pragma unroll
        for (int mp = 0; mp < 2; ++mp) {
            float d = 0.f;
            for (int c = 0; c < 128; c += 8) { const bf16x8 kv = *(const bf16x8*)(kp + mp * 128 + c);
#pragma unroll
                for (int e = 0; e < 8; ++e) d += qv[mp][c + e] * bf2f((bf16_t)kv[e]); }
            const float s = d * scale - slope * fabsf((float)(q - j));
            sc[mp][j] = s; mx[mp] = fmaxf(mx[mp], s);
        }
    }
    float l[2] = {0.f, 0.f};
#pragma unroll
    for (int mp = 0; mp < 2; ++mp) { mx[mp] = wave_max(mx[mp]); }
    for (int j = lane; j < nk; j += 64) {
#pragma unroll
        for (int mp = 0; mp < 2; ++mp) { const float p = expf(sc[mp][j] - mx[mp]); sc[mp][j] = p; l[mp] += p; }
    }
#pragma unroll
    for (int mp = 0; mp < 2; ++mp) l[mp] = wave_sum(l[mp]);
    const float i1 = 1.f / l[0], i2 = lam / l[1];
    for (int j = lane; j < nk; j += 64) sc[0][j] = sc[0][j] * i1 - sc[1][j] * i2;
    __syncthreads();
    float o[4] = {0.f, 0.f, 0.f, 0.f};
    for (int j = 0; j < nk; j += 8) {
#pragma unroll
        for (int i = 0; i < 4; ++i) {
            const bf16x8 vv = *(const bf16x8*)(UT + (size_t)(h * 256 + lane * 4 + i) * M + (size_t)b * SEQ + j);
#pragma unroll
            for (int e = 0; e < 8; ++e) o[i] += sc[0][j + e] * bf2f((bf16_t)vv[e]);
        }
    }
    float ss = o[0] * o[0] + o[1] * o[1] + o[2] * o[2] + o[3] * o[3];
    const float rs = rsqrtf(wave_sum(ss) * (1.f / 256.f) + EPS) * (1.f - lam_init);
#pragma unroll
    for (int i = 0; i < 4; ++i) MIX[tok * D + h * 256 + lane * 4 + i] = f2bf(o[i] * rs * gsub[lane * 4 + i]);
}

__global__ __launch_bounds__(256) void k_gla_naive(const bf16_t* UN, const bf16_t* UT, const float* ZLR, const float* w2, const float* bg, const float* ggla, bf16_t* MIX) {
    __shared__ float sa[128], sk[128], sq[128], red[4];
    const int e = threadIdx.x, h = blockIdx.x & 3, b = blockIdx.x >> 2;
    float S[128];
#pragma unroll
    for (int d = 0; d < 128; ++d) S[d] = 0.f;
    for (int t = 0; t < SEQ; ++t) {
        const size_t tok = (size_t)b * SEQ + t;
        if (e < 128) {
            float x = bg[h * 128 + e];
#pragma unroll
            for (int r = 0; r < 16; ++r) x += ZLR[tok * 16 + r] * w2[r * 512 + h * 128 + e];
            const float ls = fminf(x, 0.f) - log1pf(expf(-fabsf(x)));
            sa[e] = expf(ls * (1.f / 16.f));
            sk[e] = bf2f(UN[tok * UNW + UN_KB + h * 128 + e]);
            sq[e] = bf2f(UN[tok * UNW + UN_QB + h * 128 + e]) * 0.08838834764831845f;
        }
        __syncthreads();
        const float v = bf2f(UT[(size_t)(2048 + h * 256 + e) * M + tok]);
        float o = 0.f;
#pragma unroll
        for (int d = 0; d < 128; ++d) { S[d] = sa[d] * S[d] + sk[d] * v; o += sq[d] * S[d]; }
        const float ws = wave_sum(o * o);
        if ((e & 63) == 0) red[e >> 6] = ws;
        __syncthreads();
        const float ms = (red[0] + red[1] + red[2] + red[3]) * (1.f / 256.f);
        const float g = bf2f(UN[tok * UNW + UN_GB + h * 256 + e]);
        const float out = o * rsqrtf(ms + EPS) * ggla[h * 256 + e] * (g / (1.f + expf(-g)));
        MIX[tok * D + 2048 + h * 256 + e] = f2bf(out);
    }
}

__global__ void k_pool_d(const bf16_t* UN, bf16_t* DP) {
    const int idx = blockIdx.x * 256 + threadIdx.x, c = idx & 1023, tok = idx >> 10, t = tok & (SEQ - 1), g = c >> 8, w = 2 << g;
    const int lo = (t + 1 - w) > 0 ? (t + 1 - w) : 0;
    float s = 0.f;
    for (int j = lo; j <= t; ++j) s += bf2f(UN[(size_t)(tok - t + j) * UNW + UN_UC + c]);
    DP[(size_t)tok * 1024 + c] = f2bf(s / (float)(t + 1 - lo) - bf2f(UN[(size_t)tok * UNW + UN_UC + c]));
}

__device__ __forceinline__ float gelu_tanh(float x) { const float u = 0.7978845608028654f * (x + 0.044715f * x * x * x); return 0.5f * x * (1.f + tanhf(u)); }
__global__ void k_convglu(const bf16_t* Z, const float* wc, const float* bc, bf16_t* F) {
    const size_t idx = (size_t)blockIdx.x * 256 + threadIdx.x; const int c = (int)(idx % DFF); const size_t tok = idx / DFF; const int t = (int)(tok & (SEQ - 1));
    float gte = bc[c], val = bc[c + DFF];
#pragma unroll
    for (int j = 0; j < 3; ++j) { const int tt = t - 2 + j; if (tt >= 0) { const size_t r = (tok - 2 + j) * (size_t)NUP;
        gte += wc[j * NUP + c] * bf2f(Z[r + c]); val += wc[j * NUP + c + DFF] * bf2f(Z[r + c + DFF]); } }
    F[tok * DFF + c] = f2bf(gelu_tanh(gte) * val);
}


#define LAS __attribute__((address_space(3)))
#define GAS __attribute__((address_space(1)))
typedef unsigned u32x4 __attribute__((ext_vector_type(4)));
typedef unsigned u32x2 __attribute__((ext_vector_type(2)));
typedef float f32x2 __attribute__((ext_vector_type(2)));
typedef GAS unsigned gu32;
#define RLX_AGENT __ATOMIC_RELAXED, __HIP_MEMORY_SCOPE_AGENT
constexpr size_t WS_ZB = WS_DP;
constexpr size_t OFF_WZ = 370 * MiB + 512 * 1024;
constexpr int RING_BYTES = 141312, LDSCTL_OFF = RING_BYTES, MISC_OFF = LDSCTL_OFF + 320, LDS_BYTES = 147456;
constexpr int CW_BAR = 4096, CW_KMAX = 8192, CW_QUEUE = 12288;
constexpr size_t CTL_ZERO_BYTES = 64 * 1024;

__device__ __forceinline__ unsigned cvt_pk_bf16(float lo, float hi) { unsigned r; asm volatile("v_cvt_pk_bf16_f32 %0, %1, %2" : "=v"(r) : "v"(lo), "v"(hi)); return r; }

#define XB_TMO      128
#define XB_XCNT(j)  (256  + 64 * (j))
#define XB_XSUB(j)  (1280 + 64 * (j))
#define XB_XGEN(j)  (2304 + 64 * (j))
#define XB_TOP      3328
#define XB_TOPGEN   3392
#define XCD_BAR_WORDS 3456
#define XB_SPIN_CAP (1u << 18)
__device__ __forceinline__ unsigned xb_ld(unsigned* p)              { return __hip_atomic_load(p, __ATOMIC_RELAXED, __HIP_MEMORY_SCOPE_AGENT); }
__device__ __forceinline__ unsigned xb_add(unsigned* p, unsigned v) { return __hip_atomic_fetch_add(p, v, __ATOMIC_RELAXED, __HIP_MEMORY_SCOPE_AGENT); }
__device__ __forceinline__ unsigned xb_xcc_id() { return (unsigned)__builtin_amdgcn_s_getreg((3 << 11) | 20) & 0xFu; }
#define XB_SPIN(cond, bar) do { unsigned _sp = 0; while (cond) { __builtin_amdgcn_s_sleep(1); \
    if ((++_sp & 255u) == 0u) { if (xb_ld(&(bar)[XB_TMO])) break; if (_sp > XB_SPIN_CAP) { atomicAdd(&(bar)[XB_TMO], 1u); break; } } } } while (0)
struct XcdBarrier { unsigned* bar; unsigned x; volatile LAS unsigned* st; };
__device__ __forceinline__ XcdBarrier xcd_barrier_post(unsigned* bar, volatile LAS unsigned* st) {
    XcdBarrier b; b.bar = bar; b.x = xb_xcc_id(); b.st = st;
    if (threadIdx.x == 0) (void)xb_add(&bar[XB_XCNT(b.x)], 1u);
    return b;
}
__device__ __forceinline__ void xcd_barrier_complete(unsigned* bar, unsigned x, unsigned& nloc, unsigned& nx) {
    const unsigned G = gridDim.x * gridDim.y * gridDim.z;
    unsigned sum, cnt, mine, sp = 0u;
    for (;;) {
        sum = 0u; cnt = 0u; mine = 0u;
#pragma unroll
        for (unsigned j = 0; j < 16; ++j) { const unsigned c = xb_ld(&bar[XB_XCNT(j)]); sum += c; cnt += (c > 0u) ? 1u : 0u; mine = (j == x) ? c : mine; }
        if (sum == G) break;
        __builtin_amdgcn_s_sleep(1);
        if ((++sp & 255u) == 0u) { if (xb_ld(&bar[XB_TMO])) break; if (sp > XB_SPIN_CAP) { atomicAdd(&bar[XB_TMO], 1u); break; } }
    }
    nloc = mine > 0u ? mine : 1u; nx = cnt > 0u ? cnt : 1u;
}
__device__ __forceinline__ void xcd_barrier(const XcdBarrier& b) {
    asm volatile("s_waitcnt vmcnt(0)" ::: "memory");
    __syncthreads();
    if (threadIdx.x == 0) {
        unsigned* bar = b.bar;
        __builtin_amdgcn_s_waitcnt(0);
        unsigned nloc = b.st[0], nx = b.st[1];
        if (nloc == 0u) { xcd_barrier_complete(bar, b.x, nloc, nx); b.st[0] = nloc; b.st[1] = nx; }
        const unsigned old = xb_add(&bar[XB_XSUB(b.x)], 1u);
        const unsigned gen = old / nloc;
        if (old + 1u == (gen + 1u) * nloc) {
            __builtin_amdgcn_fence(__ATOMIC_RELEASE, "agent");
            asm volatile("s_waitcnt vmcnt(0)" ::: "memory");
            const unsigned og = xb_add(&bar[XB_TOP], 1u);
            const unsigned tg = og / nx;
            if (og + 1u == (tg + 1u) * nx) xb_add(&bar[XB_TOPGEN], 1u);
            else XB_SPIN(xb_ld(&bar[XB_TOPGEN]) == tg, bar);
            __builtin_amdgcn_fence(__ATOMIC_ACQUIRE, "agent");
            xb_add(&bar[XB_XGEN(b.x)], 1u);
            asm volatile("s_waitcnt vmcnt(0)" ::: "memory");
        } else {
            XB_SPIN(xb_ld(&bar[XB_XGEN(b.x)]) == gen, bar);
            __builtin_amdgcn_fence(__ATOMIC_ACQUIRE, "agent");
            asm volatile("s_waitcnt vmcnt(0)" ::: "memory");
        }
    }
    __syncthreads();
}

namespace pg8 {
constexpr int BM = 256, BK = 64, HALF = 128, HTB = HALF * BK * 2, STAGE_BYTES = 8 * HTB, NXCD = 8, WGM = 8;
__host__ __device__ __forceinline__ int lds_byte(int r, int c) { const int st = (r >> 4) * 2 + (c >> 5), rr = r & 15, cc = c & 31, ob = rr * 64 + cc * 2; return st * 1024 + (ob ^ (((ob >> 9) & 1) << 5)); }
__host__ __device__ __forceinline__ void stage_rc(int b, int& R, int& C) { const int st = b / 1024, sb = b % 1024, swz = sb ^ (((sb >> 9) & 1) << 5); R = (st >> 1) * 16 + swz / 64; C = (st & 1) * 32 + (swz % 64) / 2; }
__host__ __device__ __forceinline__ int perm32(int rho) { const int n = rho >> 4, i = rho & 15; return 8 * (i >> 2) + 4 * n + (i & 3); }

struct Unit { int pm, pn, kind; };
struct Gemm { const bf16_t* A[2]; const bf16_t* Bt[2]; int lda, ldb, K; };

__device__ __forceinline__ void tile_of(int wgid, int nM, int nN, int& pm, int& pn) {
    const int nwg = nM * nN; { const int q = nwg / NXCD, r = nwg % NXCD, xcd = wgid % NXCD, off = wgid / NXCD; wgid = (xcd < r ? xcd * (q + 1) : r * (q + 1) + (xcd - r) * q) + off; }
    const int nig = WGM * nN, gid = wgid / nig, fm = gid * WGM, gsz = (nM - fm) < WGM ? (nM - fm) : WGM;
    pm = fm + ((wgid % nig) % gsz); pn = (wgid % nig) / gsz;
}
struct Order2 {
    int nM0, nN0, nM1, nN1, G, c;
    __device__ __forceinline__ bool next(int i, Unit& u) const {
        const int L = i * G + c, n0 = nM0 * nN0;
        if (L < n0) { u.kind = 0; tile_of(L, nM0, nN0, u.pm, u.pn); return true; }
        if (L < n0 + nM1 * nN1) { u.kind = 1; tile_of(L - n0, nM1, nN1, u.pm, u.pn); return true; }
        return false;
    }
    __device__ __forceinline__ void a_ready(const Unit&) const {}
    __device__ __forceinline__ void done(const Unit&) const {}
};

struct EpiBf16 {
    static constexpr bool PERM = true;
    bf16_t* O[2]; int ldc[2];
    __device__ __forceinline__ void operator()(const f32x4 (&acc)[2][2][4][2], const Unit& u, int wr, int wc, int fr, int fq) const {
        const int row0 = u.pm * BM + wr * 64 + fr, col0 = u.pn * BM + wc * 32 + 8 * fq;
        bf16_t* base = u.kind ? O[1] : O[0]; const int ld = u.kind ? ldc[1] : ldc[0];
#pragma unroll
        for (int ai = 0; ai < 2; ++ai)
#pragma unroll
            for (int m = 0; m < 4; ++m) { bf16_t* rowp = base + (size_t)(row0 + ai * HALF + m * 16) * ld + col0;
#pragma unroll
                for (int bj = 0; bj < 2; ++bj) { const f32x4 v0 = acc[ai][bj][m][0], v1 = acc[ai][bj][m][1];
                    u32x4 w; w.x = cvt_pk_bf16(v0[0], v0[1]); w.y = cvt_pk_bf16(v0[2], v0[3]); w.z = cvt_pk_bf16(v1[0], v1[1]); w.w = cvt_pk_bf16(v1[2], v1[3]);
                    *(u32x4*)(rowp + bj * HALF) = w; } }
    }
};
struct EpiF32 {
    static constexpr bool PERM = false;
    float* C; int ldc;
    __device__ __forceinline__ void operator()(const f32x4 (&acc)[2][2][4][2], const Unit& u, int wr, int wc, int fr, int fq) const {
        const int row0 = u.pm * BM + wr * 64 + fr, col0 = u.pn * BM + wc * 32 + 4 * fq;
#pragma unroll
        for (int ai = 0; ai < 2; ++ai)
#pragma unroll
            for (int m = 0; m < 4; ++m) { float* rowp = C + (size_t)(row0 + ai * HALF + m * 16) * ldc + col0;
#pragma unroll
                for (int bj = 0; bj < 2; ++bj)
#pragma unroll
                    for (int n = 0; n < 2; ++n) *(f32x4*)(rowp + bj * HALF + n * 16) = acc[ai][bj][m][n]; }
    }
};


__device__ __forceinline__ float dpp_ror1(float x) { return __int_as_float(__builtin_amdgcn_update_dpp(0, __float_as_int(x), 0x121, 0xf, 0xf, false)); }
__device__ __forceinline__ float dpp_ror2(float x) { return __int_as_float(__builtin_amdgcn_update_dpp(0, __float_as_int(x), 0x122, 0xf, 0xf, false)); }
__device__ __forceinline__ float gelu_tanh_e(float x) { const float u = 1.5957691216057308f * (x + 0.044715f * x * x * x); return x * __builtin_amdgcn_rcpf(1.f + __expf(-u)); }
struct EpiConvGlu {
    static constexpr bool PERM = true;
    bf16_t* F; float* ZB; const float* wcv; const float* bcv; LAS unsigned char* halo;
    __device__ __forceinline__ void operator()(const f32x4 (&acc)[2][2][4][2], const Unit& u, int wr, int wc, int fr, int fq) const {
        const int colt = wc * 32 + 8 * fq, ch = u.pn * 128 + colt;
        LAS float* HL = (LAS float*)halo;
        if (fr >= 14) {
#pragma unroll
            for (int ai = 0; ai < 2; ++ai) { const int blk = 2 * ai + wr;
#pragma unroll
                for (int bj = 0; bj < 2; ++bj)
#pragma unroll
                    for (int n = 0; n < 2; ++n) { const f32x4 v = acc[ai][bj][3][n];
                        if (blk < 3) *(LAS f32x4*)(HL + ((blk + 1) * 2 + (fr - 14)) * 256 + bj * 128 + colt + 4 * n) = v;
                        else *(f32x4*)(ZB + ((size_t)u.pm * 4 + 2 + (fr - 14)) * NUP + bj * DFF + ch + 4 * n) = v; } }
        }
        if (wr == 0 && fr < 2) {
#pragma unroll
            for (int bj = 0; bj < 2; ++bj)
#pragma unroll
                for (int n = 0; n < 2; ++n) *(f32x4*)(ZB + ((size_t)u.pm * 4 + fr) * NUP + bj * DFF + ch + 4 * n) = acc[0][bj][0][n];
        }
        asm volatile("s_waitcnt lgkmcnt(0)" ::: "memory"); __builtin_amdgcn_s_barrier(); asm volatile("" ::: "memory");
#pragma unroll
        for (int n = 0; n < 2; ++n) {
            float wg[3][4], wv[3][4], bg[4], bv[4];
#pragma unroll
            for (int j = 0; j < 3; ++j) { const f32x4 a = *(const f32x4*)(wcv + (size_t)j * NUP + ch + 4 * n), b = *(const f32x4*)(wcv + (size_t)j * NUP + DFF + ch + 4 * n);
#pragma unroll
                for (int e = 0; e < 4; ++e) { wg[j][e] = a[e]; wv[j][e] = b[e]; } }
            { const f32x4 a = *(const f32x4*)(bcv + ch + 4 * n), b = *(const f32x4*)(bcv + DFF + ch + 4 * n);
#pragma unroll
              for (int e = 0; e < 4; ++e) { bg[e] = a[e]; bv[e] = b[e]; } }
#pragma unroll
            for (int ai = 0; ai < 2; ++ai) { const int blk = 2 * ai + wr;
                f32x4 pg = (f32x4){0.f, 0.f, 0.f, 0.f}, pv = (f32x4){0.f, 0.f, 0.f, 0.f};
                if (blk > 0 && fr >= 14) { pg = *(const LAS f32x4*)(HL + (blk * 2 + (fr - 14)) * 256 + colt + 4 * n); pv = *(const LAS f32x4*)(HL + (blk * 2 + (fr - 14)) * 256 + 128 + colt + 4 * n); }
#pragma unroll
                for (int m = 0; m < 4; ++m) { float o[4];
#pragma unroll
                    for (int j = 0; j < 4; ++j) {
                        const float g0 = acc[ai][0][m][n][j], v0 = acc[ai][1][m][n][j];
                        const float g1 = dpp_ror1(fr == 15 ? pg[j] : g0), g2 = dpp_ror2(fr >= 14 ? pg[j] : g0);
                        const float v1 = dpp_ror1(fr == 15 ? pv[j] : v0), v2 = dpp_ror2(fr >= 14 ? pv[j] : v0);
                        const float gt = bg[j] + wg[0][j] * g2 + wg[1][j] * g1 + wg[2][j] * g0, vl = bv[j] + wv[0][j] * v2 + wv[1][j] * v1 + wv[2][j] * v0;
                        o[j] = gelu_tanh_e(gt) * vl; }
                    u32x2 w; w.x = cvt_pk_bf16(o[0], o[1]); w.y = cvt_pk_bf16(o[2], o[3]);
                    *(u32x2*)(F + (size_t)(u.pm * BM + ai * HALF + wr * 64 + m * 16 + fr) * DFF + ch + 4 * n) = w;
                    pg = acc[ai][0][m][n]; pv = acc[ai][1][m][n]; }
            }
        }
    }
};

template <class Epi, class Sched, bool ALIGN_EPI, bool SP2>
__device__ __forceinline__ void gemm_phase(LAS unsigned char* lds, const Gemm g, const Sched& S, const Epi& E) {
    int tid = threadIdx.x; asm volatile("" : "+v"(tid));
    const int wid = __builtin_amdgcn_readfirstlane(tid >> 6), lane = tid & 63, wr = wid >> 2, wc = wid & 3, fr = lane & 15, fq = lane >> 4;
    const int K = g.K, nt = K / BK;
    unsigned voffA[2], voffB[2];
#pragma unroll
    for (int i = 0; i < 2; ++i) { int R, C; stage_rc(tid * 16 + i * 8192, R, C); const int Rb = Epi::PERM ? ((R & ~31) + perm32(R & 31)) : R;
        voffA[i] = (unsigned)(R * g.lda + C) * 2u; voffB[i] = (unsigned)(Rb * g.ldb + C) * 2u; }
    const size_t kstep = (size_t)(BK * 2);
    const size_t hstepA = (size_t)HALF * g.lda * 2, hstepB = (size_t)HALF * g.ldb * 2;
    const size_t tstepA = 2 * hstepA, tstepB = 2 * hstepB;
    const unsigned ldsw = (unsigned)wid * 1024u;
    const int aoff = lds_byte(wr * 64 + fr, fq * 8), boff = lds_byte(wc * 32 + fr, fq * 8);
#define PG8_SA(b, h) (((b) * 2 + (h)) * HTB)
#define PG8_SB(b, h) ((4 + (b) * 2 + (h)) * HTB)
#define PG8_STAGE(bufoff, gbase, voff) do { _Pragma("unroll") for (int _i = 0; _i < 2; ++_i) \
        __builtin_amdgcn_global_load_lds((const unsigned*)((const char*)(gbase) + (voff)[_i]), (LAS unsigned*)(lds + (bufoff) + ldsw + _i * 8192), 16, 0, 0); } while (0)
#define PG8_LDA(dst, b, h) do { _Pragma("unroll") for (int m = 0; m < 4; ++m) _Pragma("unroll") for (int k = 0; k < 2; ++k) dst[m][k] = *(const LAS bf16x8*)(lds + PG8_SA(b, h) + aoff + m * 2048 + k * 1024); } while (0)
#define PG8_LDB(dst, b, h) do { _Pragma("unroll") for (int n = 0; n < 2; ++n) _Pragma("unroll") for (int k = 0; k < 2; ++k) dst[n][k] = *(const LAS bf16x8*)(lds + PG8_SB(b, h) + boff + n * 2048 + k * 1024); } while (0)
#define PG8_MMA(ai, bj, At, Bt) do { __builtin_amdgcn_s_setprio(1); _Pragma("unroll") for (int m = 0; m < 4; ++m) _Pragma("unroll") for (int n = 0; n < 2; ++n) _Pragma("unroll") for (int k = 0; k < 2; ++k) \
        acc[ai][bj][m][n] = __builtin_amdgcn_mfma_f32_16x16x32_bf16(Bt[n][k], At[m][k], acc[ai][bj][m][n], 0, 0, 0); __builtin_amdgcn_s_setprio(0); } while (0)
#define PG8_WAIT_V(n) asm volatile("s_waitcnt vmcnt(" #n ")" ::: "memory")
#define PG8_WAIT_L(n) asm volatile("s_waitcnt lgkmcnt(" #n ")" ::: "memory")
#define PG8_BAR __builtin_amdgcn_s_barrier()
#define PG8_SCHED __builtin_amdgcn_sched_barrier(0)
    Unit cur, nxt; int ui = 0;
    if (!S.next(0, cur)) return;
    f32x4 acc[2][2][4][2];
#pragma unroll
    for (int a = 0; a < 2; ++a)
#pragma unroll
        for (int b = 0; b < 2; ++b)
#pragma unroll
            for (int m = 0; m < 4; ++m)
#pragma unroll
                for (int n = 0; n < 2; ++n) acc[a][b][m][n] = (f32x4){0.f, 0.f, 0.f, 0.f};
    bf16x8 At[4][2], B0[2][2], B1[2][2];
    const char* cA = (const char*)(cur.kind ? g.A[1] : g.A[0]) + (size_t)cur.pm * tstepA; const char* cB = (const char*)(cur.kind ? g.Bt[1] : g.Bt[0]) + (size_t)cur.pn * tstepB;
    S.a_ready(cur);
    if constexpr (SP2) {
        PG8_STAGE(PG8_SB(0, 0), cB, voffB); PG8_STAGE(PG8_SB(0, 1), cB + hstepB, voffB); PG8_STAGE(PG8_SA(0, 0), cA, voffA); PG8_STAGE(PG8_SA(0, 1), cA + hstepA, voffA);
        if (wr == 1) PG8_BAR;
        PG8_WAIT_V(2); PG8_BAR;
        PG8_STAGE(PG8_SB(1, 0), cB + kstep, voffB); PG8_STAGE(PG8_SA(1, 0), cA + kstep, voffA); PG8_STAGE(PG8_SB(1, 1), cB + hstepB + kstep, voffB);
        PG8_WAIT_V(6); PG8_BAR;
    } else {
        PG8_STAGE(PG8_SB(0, 0), cB, voffB); PG8_STAGE(PG8_SA(0, 0), cA, voffA); PG8_STAGE(PG8_SB(0, 1), cB + hstepB, voffB); PG8_STAGE(PG8_SA(0, 1), cA + hstepA, voffA);
        if (wr == 1) PG8_BAR;
        PG8_WAIT_V(4); PG8_BAR;
        PG8_STAGE(PG8_SB(1, 0), cB + kstep, voffB); PG8_STAGE(PG8_SA(1, 0), cA + kstep, voffA); PG8_STAGE(PG8_SB(1, 1), cB + hstepB + kstep, voffB);
        PG8_WAIT_V(6); PG8_BAR;
    }
    for (;;) {
        const bool has_next = S.next(ui + 1, nxt);
        const char* nA = has_next ? (const char*)(nxt.kind ? g.A[1] : g.A[0]) + (size_t)nxt.pm * tstepA : cA; const char* nB = has_next ? (const char*)(nxt.kind ? g.Bt[1] : g.Bt[0]) + (size_t)nxt.pn * tstepB : cB;
        for (int t = 0; t < nt; t += 2) {
            const bool last = (t == nt - 2);
            const char* a1 = cA + (size_t)(t + 1) * kstep;
            const char* a2 = last ? nA : cA + (size_t)(t + 2) * kstep; const char* b2 = last ? nB : cB + (size_t)(t + 2) * kstep;
            const char* a3 = a2 + kstep; const char* b3 = b2 + kstep;
            if (last && has_next) S.a_ready(nxt);
            if constexpr (SP2) {
            PG8_LDB(B0, 0, 0); PG8_LDB(B1, 0, 1); PG8_SCHED; PG8_LDA(At, 0, 0); PG8_STAGE(PG8_SA(1, 1), a1 + hstepA, voffA);
            PG8_WAIT_V(8); PG8_WAIT_L(0); PG8_BAR; PG8_MMA(0, 0, At, B0); PG8_MMA(0, 1, At, B1); PG8_BAR; PG8_SCHED;
            PG8_LDA(At, 0, 1); PG8_STAGE(PG8_SB(0, 0), b2, voffB); PG8_STAGE(PG8_SB(0, 1), b2 + hstepB, voffB); PG8_STAGE(PG8_SA(0, 0), a2, voffA);
            PG8_WAIT_V(8); PG8_WAIT_L(0); PG8_BAR; PG8_MMA(1, 0, At, B0); PG8_MMA(1, 1, At, B1); PG8_BAR; PG8_SCHED;
            PG8_LDB(B0, 1, 0); PG8_LDB(B1, 1, 1); PG8_SCHED; PG8_LDA(At, 1, 0); PG8_STAGE(PG8_SA(0, 1), a2 + hstepA, voffA);
            PG8_WAIT_V(8); PG8_WAIT_L(0); PG8_BAR; PG8_MMA(0, 0, At, B0); PG8_MMA(0, 1, At, B1); PG8_BAR; PG8_SCHED;
            PG8_LDA(At, 1, 1); PG8_STAGE(PG8_SB(1, 0), b3, voffB); PG8_STAGE(PG8_SB(1, 1), b3 + hstepB, voffB); PG8_STAGE(PG8_SA(1, 0), a3, voffA);
            PG8_WAIT_V(8); PG8_WAIT_L(0); PG8_BAR; PG8_MMA(1, 0, At, B0); PG8_MMA(1, 1, At, B1); PG8_BAR; PG8_SCHED;
            } else {
            PG8_LDB(B0, 0, 0); PG8_SCHED; PG8_LDA(At, 0, 0); PG8_STAGE(PG8_SA(1, 1), a1 + hstepA, voffA);
            PG8_WAIT_L(8); PG8_BAR; PG8_WAIT_L(0); PG8_MMA(0, 0, At, B0); PG8_BAR; PG8_SCHED;
            PG8_LDB(B1, 0, 1); PG8_STAGE(PG8_SB(0, 0), b2, voffB);
            PG8_BAR; PG8_WAIT_L(0); PG8_MMA(0, 1, At, B1); PG8_BAR;
            PG8_LDA(At, 0, 1); PG8_STAGE(PG8_SA(0, 0), a2, voffA);
            PG8_BAR; PG8_WAIT_L(0); PG8_MMA(1, 0, At, B0); PG8_BAR; PG8_SCHED;
            PG8_STAGE(PG8_SB(0, 1), b2 + hstepB, voffB);
            PG8_WAIT_V(6); PG8_BAR; PG8_MMA(1, 1, At, B1); PG8_BAR;
            PG8_LDB(B0, 1, 0); PG8_SCHED; PG8_LDA(At, 1, 0); PG8_STAGE(PG8_SA(0, 1), a2 + hstepA, voffA);
            PG8_WAIT_L(8); PG8_BAR; PG8_WAIT_L(0); PG8_MMA(0, 0, At, B0); PG8_BAR; PG8_SCHED;
            PG8_LDB(B1, 1, 1); PG8_STAGE(PG8_SB(1, 0), b3, voffB);
            PG8_BAR; PG8_WAIT_L(0); PG8_MMA(0, 1, At, B1); PG8_BAR;
            PG8_LDA(At, 1, 1); PG8_STAGE(PG8_SA(1, 0), a3, voffA);
            PG8_BAR; PG8_WAIT_L(0); PG8_MMA(1, 0, At, B0); PG8_BAR; PG8_SCHED;
            PG8_STAGE(PG8_SB(1, 1), b3 + hstepB, voffB);
            PG8_WAIT_V(6); PG8_BAR; PG8_MMA(1, 1, At, B1); PG8_BAR;
            }
        }
        if constexpr (ALIGN_EPI) { if (wr == 0) PG8_BAR; }
        E(acc, cur, wr, wc, fr, fq); S.done(cur);
        if (!has_next) break;
#pragma unroll
        for (int a = 0; a < 2; ++a)
#pragma unroll
            for (int b = 0; b < 2; ++b)
#pragma unroll
                for (int m = 0; m < 4; ++m)
#pragma unroll
                    for (int n = 0; n < 2; ++n) acc[a][b][m][n] = (f32x4){0.f, 0.f, 0.f, 0.f};
        cur = nxt; cA = nA; cB = nB; ++ui;
        if constexpr (ALIGN_EPI) { if (wr == 1) PG8_BAR; }
    }
    PG8_WAIT_V(0);
    if constexpr (!ALIGN_EPI) { if (wr == 0) PG8_BAR; }
    PG8_BAR;
#undef PG8_SA
#undef PG8_SB
#undef PG8_STAGE
#undef PG8_LDA
#undef PG8_LDB
#undef PG8_MMA
#undef PG8_WAIT_V
#undef PG8_WAIT_L
#undef PG8_BAR
#undef PG8_SCHED
}
}
#ifndef PG8_SP2
#define PG8_SP2 true
#endif
#ifndef PG8_ALIGN
#define PG8_ALIGN true
#endif

constexpr size_t WS_GLA = WS_Z;
constexpr size_t GLA_LT = 0, GLA_OI = 64 * MiB, GLA_ST = 96 * MiB, GLA_QT = 128 * MiB, GLA_DEC = 136 * MiB;
__device__ __forceinline__ int crow(int i, int hh) { return (i & 3) + 8 * (i >> 2) + 4 * hh; }
#define MFMA32(a, b, c) __builtin_amdgcn_mfma_f32_32x32x16_bf16((a), (b), (c), 0, 0, 0)
#define WG_BAR() do { asm volatile("s_waitcnt vmcnt(0) lgkmcnt(0)" ::: "memory"); __builtin_amdgcn_s_barrier(); asm volatile("" ::: "memory"); } while (0)

__device__ __forceinline__ f32x16 mma_lds(const LAS bf16_t* A, int pa, const LAS bf16_t* B, int pb, int K, f32x16 acc, int r, int hh) {
    const LAS bf16_t* ap = A + r * pa + 8 * hh; const LAS bf16_t* bp = B + r * pb + 8 * hh;
    for (int k = 0; k < K; k += 16) acc = MFMA32(*(const LAS bf16x8*)(ap + k), *(const LAS bf16x8*)(bp + k), acc);
    return acc;
}

namespace att {
constexpr float LOG2E = 1.4426950408889634f, C1 = 0.08838834764831845f * LOG2E, THRL = 8.f;
constexpr int KP = 528, VP = 144, VBYTES = 256 * VP, KBYTES = 64 * KP, ABUF = VBYTES + KBYTES, XP = 1040;
__device__ __forceinline__ void stage_tile(LAS unsigned char* buf, const char* kt, const char* vt, int wave, int lane) {
    asm volatile("" : "+v"(lane));
#pragma unroll
    for (int i = 0; i < 5; ++i) { const int iv = wave + 8 * i; if (iv < 36) { const unsigned q = iv * 64 + lane, row = q / 9u, cp = q - 9u * row, cc = cp < 8u ? cp : 7u;
        __builtin_amdgcn_global_load_lds((const GAS unsigned*)(vt + (row * (unsigned)(M * 2) + cc * 16u)), (LAS unsigned*)(buf + iv * 1024), 16, 0, 0); } }
#pragma unroll
    for (int i = 0; i < 5; ++i) { const int ik = wave + 8 * i; if (ik < 33) { const unsigned q = ik * 64 + lane, row = q / 33u, cp = q - 33u * row, cc = cp < 32u ? cp : 31u;
        __builtin_amdgcn_global_load_lds((const GAS unsigned*)(kt + (row * (unsigned)(UNW * 2) + cc * 16u)), (LAS unsigned*)(buf + VBYTES + ik * 1024), 16, 0, 0); } }
}
constexpr float TSKIP = 64.f;
__device__ __forceinline__ void unit(LAS unsigned char* lds, const bf16_t* UN, const bf16_t* UT, bf16_t* MIX, const unsigned* KMAX, int b, int h, int qb, float lam, const float* gsub, float post_scale, int wave, int lane) {
    const int mp = wave >> 2, wq = wave & 3, r = lane & 31, hh = lane >> 5;
    const int q0 = qb * 128 + wq * 32, qpos = q0 + r, cw = q0 >> 6;
    const float C2 = __uint_as_float((unsigned)(127 - (h + 1)) << 23) * LOG2E;
    const char* kt = (const char*)(UN + (size_t)(b * SEQ) * UNW + UN_KA + h * 256);
    const char* vt = (const char*)(UT + (size_t)(h * 256) * M + (size_t)b * SEQ);
    bf16x8 qf[8];
    { const bf16_t* qp = UN + (size_t)(b * SEQ + qpos) * UNW + UN_QA + h * 256 + mp * 128 + 8 * hh;
#pragma unroll
      for (int kk = 0; kk < 8; ++kk) qf[kk] = *(const bf16x8*)(qp + 16 * kk); }
    unsigned long long mask;
    { float qs = 0.f;
#pragma unroll
      for (int kk = 0; kk < 8; ++kk)
#pragma unroll
          for (int e = 0; e < 8; ++e) { const float x = bf2f((bf16_t)qf[kk][e]); qs += x * x; }
      { auto rr = __builtin_amdgcn_permlane32_swap(__float_as_uint(qs), __float_as_uint(qs), false, false); qs = __uint_as_float(rr[0]) + __uint_as_float(rr[1]); }
#pragma unroll
      for (int o = 1; o < 32; o <<= 1) qs = fmaxf(qs, __shfl_xor(qs, o));
      const float qn = sqrtf(qs) * 1.001f;
      const float km = __uint_as_float(__hip_atomic_load(KMAX + ((b * 8 + h) * 2 + mp) * 64 + lane, __ATOMIC_RELAXED, __HIP_MEMORY_SCOPE_AGENT)) * 1.001f;
      const float kcw = __uint_as_float(__builtin_amdgcn_readlane(__float_as_uint(km), cw));
      const int md = q0 - (64 * lane + 63);
      const bool need = (lane <= cw) && (C1 * qn * (km + kcw) - C2 * (float)(md > 0 ? md : 0) >= -TSKIP);
      mask = __ballot(need); }
    volatile LAS unsigned long long* masks = (volatile LAS unsigned long long*)(lds + LDSCTL_OFF + 512);
    if (lane == 0) masks[wave] = mask;
    f32x16 O[8];
#pragma unroll
    for (int eb = 0; eb < 8; ++eb)
#pragma unroll
        for (int i = 0; i < 16; ++i) O[eb][i] = 0.f;
    float m_ref = -INFINITY, l_acc = 0.f;
    WG_BAR();
    unsigned long long rem = 0ull;
#pragma unroll
    for (int w = 0; w < 8; ++w) { const unsigned long long mw = masks[w]; rem |= ((unsigned long long)__builtin_amdgcn_readfirstlane((unsigned)(mw >> 32)) << 32) | (unsigned long long)__builtin_amdgcn_readfirstlane((unsigned)mw); }
    int j = __builtin_ctzll(rem); rem &= rem - 1ull;
    stage_tile(lds, kt + (size_t)j * 64 * UNW * 2, vt + (size_t)j * 128, wave, lane);
    const int kbase = VBYTES + r * KP + mp * 256 + hh * 16, vbase = r * VP + hh * 16;
    for (int it = 0;; ++it) {
        WG_BAR();
        LAS unsigned char* buf = lds + (it & 1) * ABUF;
        const int jn = rem ? __builtin_ctzll(rem) : -1;
        if (jn >= 0) { rem &= rem - 1ull; stage_tile(lds + ((it + 1) & 1) * ABUF, kt + (size_t)jn * 64 * UNW * 2, vt + (size_t)jn * 128, wave, lane); }
        if ((mask >> j) & 1ull) {
            const LAS unsigned char* kp = buf + kbase; const LAS unsigned char* vp = buf + vbase;
#pragma unroll
            for (int hf = 0; hf < 2; ++hf) {
                f32x16 p0;
#pragma unroll
                for (int i = 0; i < 16; ++i) p0[i] = 0.f;
#pragma unroll
                for (int kk = 0; kk < 8; ++kk) p0 = MFMA32(*(const LAS bf16x8*)(kp + hf * 32 * KP + kk * 32), qf[kk], p0);
                const float base0 = (float)(qpos - 64 * j - 32 * hf - 4 * hh);
                float pmax = -INFINITY;
#pragma unroll
                for (int i = 0; i < 16; ++i) { const float off = (float)((i & 3) + 8 * (i >> 2));
                    p0[i] = fmaf(p0[i], C1, -C2 * fabsf(base0 - off)); pmax = fmaxf(pmax, p0[i]); }
                { auto rr = __builtin_amdgcn_permlane32_swap(__float_as_uint(pmax), __float_as_uint(pmax), false, false); pmax = fmaxf(__uint_as_float(rr[0]), __uint_as_float(rr[1])); }
                if (!__all(pmax - m_ref <= THRL)) {
                    const float mn = fmaxf(m_ref, pmax), alpha = __builtin_amdgcn_exp2f(m_ref - mn); m_ref = mn; l_acc *= alpha;
#pragma unroll
                    for (int eb = 0; eb < 8; ++eb)
#pragma unroll
                        for (int i = 0; i < 16; ++i) O[eb][i] *= alpha;
                }
                float ps = 0.f;
#pragma unroll
                for (int i = 0; i < 16; ++i) { p0[i] = __builtin_amdgcn_exp2f(p0[i] - m_ref); ps += p0[i]; }
                l_acc += ps;
                bf16x8 pf[2];
#define PK4(P, BASE, OUT) do { const unsigned a0 = cvt_pk_bf16(P[BASE + 0], P[BASE + 1]), a1 = cvt_pk_bf16(P[BASE + 2], P[BASE + 3]); \
    const unsigned b0 = cvt_pk_bf16(P[BASE + 4], P[BASE + 5]), b1 = cvt_pk_bf16(P[BASE + 6], P[BASE + 7]); \
    auto r0 = __builtin_amdgcn_permlane32_swap(a0, b0, false, false); auto r1 = __builtin_amdgcn_permlane32_swap(a1, b1, false, false); \
    u32x4 w = {r0[0], r1[0], r0[1], r1[1]}; OUT = *reinterpret_cast<bf16x8*>(&w); } while (0)
                PK4(p0, 0, pf[0]); PK4(p0, 8, pf[1]);
#undef PK4
#define LDV(EB, S2) (*(const LAS bf16x8*)(vp + (EB) * 32 * VP + (4 * hf + 2 * (S2)) * 16))
                { bf16x8 va[4] = {LDV(0, 0), LDV(0, 1), LDV(1, 0), LDV(1, 1)};
#pragma unroll
                  for (int eb = 0; eb < 8; eb += 2) { bf16x8 vn[4];
                      if (eb < 6) { vn[0] = LDV(eb + 2, 0); vn[1] = LDV(eb + 2, 1); vn[2] = LDV(eb + 3, 0); vn[3] = LDV(eb + 3, 1); }
                      O[eb] = MFMA32(va[0], pf[0], O[eb]); O[eb + 1] = MFMA32(va[2], pf[0], O[eb + 1]); O[eb] = MFMA32(va[1], pf[1], O[eb]); O[eb + 1] = MFMA32(va[3], pf[1], O[eb + 1]);
                      __builtin_amdgcn_sched_barrier(0);
                      if (eb < 6) { va[0] = vn[0]; va[1] = vn[1]; va[2] = vn[2]; va[3] = vn[3]; } } }
#undef LDV
            }
        }
        if (jn < 0) break;
        j = jn;
    }
    { auto rr = __builtin_amdgcn_permlane32_swap(__float_as_uint(l_acc), __float_as_uint(l_acc), false, false); l_acc = __uint_as_float(rr[0]) + __uint_as_float(rr[1]); }
    WG_BAR();
    LAS unsigned char* xp = lds + (wq * 32 + r) * XP + hh * 16;
    if (mp == 1) {
        const float inv = lam / l_acc;
#pragma unroll
        for (int eb = 0; eb < 8; ++eb)
#pragma unroll
            for (int g4 = 0; g4 < 4; ++g4) { const f32x4 v = {O[eb][4 * g4] * inv, O[eb][4 * g4 + 1] * inv, O[eb][4 * g4 + 2] * inv, O[eb][4 * g4 + 3] * inv};
                *(LAS f32x4*)(xp + (8 * eb + 2 * g4) * 16) = v; }
    }
    WG_BAR();
    if (mp == 0) {
        const float inv = 1.f / l_acc; float ss = 0.f;
#pragma unroll
        for (int eb = 0; eb < 8; ++eb) {
#pragma unroll
            for (int g4 = 0; g4 < 4; ++g4) { const f32x4 x = *(const LAS f32x4*)(xp + (8 * eb + 2 * g4) * 16);
#pragma unroll
                for (int e = 0; e < 4; ++e) { const float v = O[eb][4 * g4 + e] * inv - x[e]; O[eb][4 * g4 + e] = v; ss += v * v; } }
            asm volatile("" ::: "memory"); }
        { auto rr = __builtin_amdgcn_permlane32_swap(__float_as_uint(ss), __float_as_uint(ss), false, false); ss = __uint_as_float(rr[0]) + __uint_as_float(rr[1]); }
        const float rs = rsqrtf(ss * (1.f / 256.f) + EPS) * post_scale;
        bf16_t* op = MIX + (size_t)(b * SEQ + qpos) * D + h * 256 + 4 * hh; const float* gp = gsub + 4 * hh;
#pragma unroll
        for (int eb = 0; eb < 8; ++eb) {
#pragma unroll
            for (int g4 = 0; g4 < 4; ++g4) { const int e0 = 32 * eb + 8 * g4; const f32x4 g = *(const f32x4*)(gp + e0);
                u32x2 w; w.x = cvt_pk_bf16(O[eb][4 * g4] * rs * g[0], O[eb][4 * g4 + 1] * rs * g[1]); w.y = cvt_pk_bf16(O[eb][4 * g4 + 2] * rs * g[2], O[eb][4 * g4 + 3] * rs * g[3]);
                *(u32x2*)(op + e0) = w; }
            asm volatile("" ::: "memory"); }
    }
    WG_BAR();
}
}

namespace gla {
constexpr int O_LA = 0, O_ZL = 32768, O_QT = 36864, O_KT = 54272, O_KHT = 71680, O_VT = 90112, O_AM = 0;
constexpr int PQ = 136, PS = 72;
__device__ __forceinline__ void g1_unit(LAS unsigned char* lds, const bf16_t* UN, const bf16_t* UT, const float* ZLR, const float* w2, const float* bgate, unsigned char* gs, int u, int tid, int wave, int lane) {
    const int c = u & 63, h = (u >> 6) & 3, b = u >> 8; const size_t tok0 = (size_t)b * SEQ + c * 64;
    LAS float* LA = (LAS float*)(lds + O_LA); LAS float* ZL = (LAS float*)(lds + O_ZL);
    LAS bf16_t* QT = (LAS bf16_t*)(lds + O_QT); LAS bf16_t* KT = (LAS bf16_t*)(lds + O_KT); LAS bf16_t* KHT = (LAS bf16_t*)(lds + O_KHT); LAS bf16_t* VT = (LAS bf16_t*)(lds + O_VT); LAS bf16_t* AM = (LAS bf16_t*)(lds + O_AM);
    if (tid < 256) *(LAS f32x4*)(ZL + tid * 4) = *(const f32x4*)(ZLR + tok0 * 16 + tid * 4);
#pragma unroll
    for (int i = 0; i < 4; ++i) { const int id = tid + 512 * i, row = id >> 3, ch = id & 7;
        *(LAS u32x4*)(VT + row * PS + ch * 8) = *(const u32x4*)(UT + (size_t)(2048 + h * 256 + row) * M + tok0 + ch * 8); }
    WG_BAR();
    const int d = tid & 127, qd = tid >> 7;
    float bt[16];
    { float w[16];
#pragma unroll
      for (int rr = 0; rr < 16; ++rr) w[rr] = w2[rr * 512 + h * 128 + d];
      const float bias = bgate[h * 128 + d]; float run = 0.f;
#pragma unroll
      for (int i = 0; i < 16; ++i) { const int t = qd * 16 + i; float x = bias;
#pragma unroll
          for (int rr = 0; rr < 16; ++rr) x += ZL[t * 16 + rr] * w[rr];
          const float ls = fminf(x, 0.f) - log1pf(__expf(-fabsf(x)));
          run += ls * (1.f / 16.f); bt[i] = run; }
      WG_BAR();
      ZL[qd * 128 + d] = run; }
    WG_BAR();
    float off = 0.f, btot = 0.f;
#pragma unroll
    for (int q = 0; q < 4; ++q) { const float p = ZL[q * 128 + d]; btot += p; if (q < qd) off += p; }
    bf16_t* QTg = (bf16_t*)(gs + GLA_QT) + (size_t)u * 64 * 128;
#pragma unroll
    for (int i = 0; i < 16; ++i) { const int t = qd * 16 + i; const float bb = bt[i] + off;
        const float qv = bf2f(UN[(tok0 + t) * UNW + UN_QB + h * 128 + d]) * 0.08838834764831845f, kv = bf2f(UN[(tok0 + t) * UNW + UN_KB + h * 128 + d]);
        const bf16_t qt = f2bf(qv * __expf(bb));
        QT[t * PQ + d] = qt; QTg[t * 128 + d] = qt; KT[t * PQ + d] = f2bf(kv * __expf(-bb)); KHT[d * PS + t] = f2bf(kv * __expf(btot - bb)); }
    if (qd == 0) ((float*)(gs + GLA_DEC))[(size_t)u * 128 + d] = __expf(btot);
    WG_BAR();
    const int r = lane & 31, hh = lane >> 5;
    f32x16 zero;
#pragma unroll
    for (int i = 0; i < 16; ++i) zero[i] = 0.f;
    if (wave < 4) {
        const int mi = wave >> 1, ni = wave & 1;
        const f32x16 a = mma_lds(QT + 32 * mi * PQ, PQ, KT + 32 * ni * PQ, PQ, 128, zero, r, hh);
#pragma unroll
        for (int i = 0; i < 16; ++i) { const int t = 32 * mi + crow(i, hh), s = 32 * ni + r; AM[t * PS + s] = f2bf(s <= t ? a[i] : 0.f); }
    }
    { float* LT = (float*)(gs + GLA_LT) + (size_t)u * 256 * 128;
#pragma unroll
      for (int db = 0; db < 4; ++db) { const f32x16 a = mma_lds(VT + 32 * wave * PS, PS, KHT + 32 * db * PS, PS, 64, zero, r, hh);
#pragma unroll
          for (int i = 0; i < 16; ++i) LT[(size_t)(32 * wave + crow(i, hh)) * 128 + 32 * db + r] = a[i]; } }
    WG_BAR();
    { float* OI = (float*)(gs + GLA_OI) + (size_t)u * 64 * 256;
#pragma unroll
      for (int tb = 0; tb < 2; ++tb) { const f32x16 a = mma_lds(AM + 32 * tb * PS, PS, VT + 32 * wave * PS, PS, 64, zero, r, hh);
#pragma unroll
          for (int i = 0; i < 16; ++i) OI[(size_t)(32 * tb + crow(i, hh)) * 256 + 32 * wave + r] = a[i]; } }
    WG_BAR();
}
__device__ __forceinline__ void g2_scan(unsigned char* gs, int p) {
    const int bh = p >> 14, rem = p & 16383, e = rem >> 6, d2 = (rem & 63) * 2;
    const float* LT = (const float*)(gs + GLA_LT); const float* DEC = (const float*)(gs + GLA_DEC); bf16_t* ST = (bf16_t*)(gs + GLA_ST);
    float s0 = 0.f, s1 = 0.f;
#pragma unroll 8
    for (int c = 0; c < 64; ++c) { const size_t u = (size_t)bh * 64 + c;
        *(unsigned*)(ST + (u * 256 + e) * 128 + d2) = cvt_pk_bf16(s0, s1);
        const f32x2 dc = *(const f32x2*)(DEC + u * 128 + d2), lv = *(const f32x2*)(LT + (u * 256 + e) * 128 + d2);
        s0 = dc.x * s0 + lv.x; s1 = dc.y * s1 + lv.y; }
}
__device__ __forceinline__ void g3_unit(LAS unsigned char* lds, const bf16_t* UN, unsigned char* gs, const float* ggla, bf16_t* MIX, int u, int tid, int wave, int lane) {
    const int c = u & 63, h = (u >> 6) & 3, b = u >> 8; const size_t tok0 = (size_t)b * SEQ + c * 64;
    LAS bf16_t* QT = (LAS bf16_t*)lds; LAS bf16_t* STs = (LAS bf16_t*)(lds + 17408); LAS float* OT = (LAS float*)lds;
    const bf16_t* QTg = (const bf16_t*)(gs + GLA_QT) + (size_t)u * 64 * 128; const bf16_t* ST = (const bf16_t*)(gs + GLA_ST) + (size_t)u * 256 * 128;
#pragma unroll
    for (int i = 0; i < 2; ++i) { const int id = tid + 512 * i, row = id >> 4, ch = id & 15; *(LAS u32x4*)(QT + row * PQ + ch * 8) = *(const u32x4*)(QTg + row * 128 + ch * 8); }
#pragma unroll
    for (int i = 0; i < 8; ++i) { const int id = tid + 512 * i, row = id >> 4, ch = id & 15; *(LAS u32x4*)(STs + row * PQ + ch * 8) = *(const u32x4*)(ST + row * 128 + ch * 8); }
    const int r = lane & 31, hh = lane >> 5;
    const float* OI = (const float*)(gs + GLA_OI) + (size_t)u * 64 * 256;
    f32x16 acc[2];
#pragma unroll
    for (int tb = 0; tb < 2; ++tb)
#pragma unroll
        for (int i = 0; i < 16; ++i) acc[tb][i] = OI[(size_t)(32 * tb + crow(i, hh)) * 256 + 32 * wave + r];
    WG_BAR();
#pragma unroll
    for (int tb = 0; tb < 2; ++tb) acc[tb] = mma_lds(QT + 32 * tb * PQ, PQ, STs + 32 * wave * PQ, PQ, 128, acc[tb], r, hh);
    WG_BAR();
#pragma unroll
    for (int tb = 0; tb < 2; ++tb)
#pragma unroll
        for (int i = 0; i < 16; ++i) OT[(32 * tb + crow(i, hh)) * 260 + 32 * wave + r] = acc[tb][i];
    WG_BAR();
    { const int t = tid >> 3, part = tid & 7; const LAS float* op = OT + t * 260 + part * 32; float v[32]; float ss = 0.f;
#pragma unroll
      for (int q = 0; q < 8; ++q) { const f32x4 x = *(const LAS f32x4*)(op + 4 * q); v[4 * q] = x[0]; v[4 * q + 1] = x[1]; v[4 * q + 2] = x[2]; v[4 * q + 3] = x[3]; ss += x[0] * x[0] + x[1] * x[1] + x[2] * x[2] + x[3] * x[3]; }
      ss += __shfl_xor(ss, 1); ss += __shfl_xor(ss, 2); ss += __shfl_xor(ss, 4);
      const float rs = rsqrtf(ss * (1.f / 256.f) + EPS);
      const bf16_t* gbp = UN + (tok0 + t) * UNW + UN_GB + h * 256 + part * 32; const float* gg = ggla + h * 256 + part * 32;
      bf16_t* mp = MIX + (tok0 + t) * D + 2048 + h * 256 + part * 32;
#pragma unroll
      for (int q = 0; q < 4; ++q) { const bf16x8 gv = *(const bf16x8*)(gbp + 8 * q); float o[8];
#pragma unroll
          for (int e = 0; e < 8; ++e) { const float g = bf2f((bf16_t)gv[e]); o[e] = v[8 * q + e] * rs * gg[8 * q + e] * (g / (1.f + __expf(-g))); }
          u32x4 w; w.x = cvt_pk_bf16(o[0], o[1]); w.y = cvt_pk_bf16(o[2], o[3]); w.z = cvt_pk_bf16(o[4], o[5]); w.w = cvt_pk_bf16(o[6], o[7]);
          *(u32x4*)(mp + 8 * q) = w; } }
    WG_BAR();
}
}

__device__ __forceinline__ void pool_unit(LAS unsigned char* lds, const bf16_t* UN, const bf16_t* WP, const float* pscale, bf16_t* MIX, int pu, int tid, int wave, int lane) {
    const int g = pu & 3, rb = pu >> 2, w = 2 << g; const size_t tok0 = (size_t)rb * 128;
    LAS bf16_t* DT = (LAS bf16_t*)lds; constexpr int PD = 264;
    { const int c = tid & 255, half = tid >> 8, tf = (int)(tok0 & (SEQ - 1)) + 64 * half;
      const bf16_t* up = UN + (tok0 + 64 * half) * UNW + UN_UC + g * 256 + c;
      float s = 0.f;
      for (int j = 1; j < w; ++j) if (tf - j >= 0) s += bf2f(up[-(ptrdiff_t)j * UNW]);
      for (int i = 0; i < 64; ++i) { const int t = tf + i; const float ut = bf2f(up[(size_t)i * UNW]);
          s += ut; const int cnt = (t + 1 < w) ? t + 1 : w;
          DT[(64 * half + i) * PD + c] = f2bf(s / (float)cnt - ut);
          if (t + 1 - w >= 0) s -= bf2f(up[(ptrdiff_t)(i + 1 - w) * UNW]); } }
    WG_BAR();
    const int r = lane & 31, hh = lane >> 5;
    f32x16 acc[4];
#pragma unroll
    for (int mb = 0; mb < 4; ++mb)
#pragma unroll
        for (int i = 0; i < 16; ++i) acc[mb][i] = 0.f;
    const bf16_t* bp = WP + (size_t)g * 65536 + (size_t)(32 * wave + r) * 256 + 8 * hh;
#pragma unroll 4
    for (int ks = 0; ks < 16; ++ks) { const bf16x8 bf = *(const bf16x8*)(bp + 16 * ks);
#pragma unroll
        for (int mb = 0; mb < 4; ++mb) acc[mb] = MFMA32(*(const LAS bf16x8*)(DT + (32 * mb + r) * PD + 16 * ks + 8 * hh), bf, acc[mb]); }
    const int n = 32 * wave + r; const float sc = pscale[g * 256 + n];
#pragma unroll
    for (int mb = 0; mb < 4; ++mb)
#pragma unroll
        for (int i = 0; i < 16; ++i) MIX[(tok0 + 32 * mb + crow(i, hh)) * D + 3072 + g * 256 + n] = f2bf(acc[mb][i] * sc);
    WG_BAR();
}

#define LDS_WAIT() asm volatile("s_waitcnt lgkmcnt(0)" ::: "memory")
#define VM_WAIT() asm volatile("s_waitcnt vmcnt(0)" ::: "memory")
__device__ __forceinline__ unsigned pk2(float lo, float hi) { return (unsigned)f2bf(lo) | ((unsigned)f2bf(hi) << 16); }

__device__ __forceinline__ void cvt_item(const float* __restrict__ W, int ldw, int srccol, int nvalid, bf16_t* __restrict__ Wt, int K, int dstrow, int k0, LAS float* scr, int lane) {
    const int c = lane & 31;
#pragma unroll 8
    for (int i = 0; i < 32; ++i) { const int kk = 2 * i + (lane >> 5); scr[kk * 33 + c] = (c < nvalid) ? W[(size_t)(k0 + kk) * ldw + srccol + c] : 0.f; }
    LDS_WAIT(); asm volatile("" ::: "memory");
    const int c8 = lane & 7;
#pragma unroll
    for (int j = 0; j < 4; ++j) { const int n = (lane >> 3) + 8 * j; const LAS float* s = scr + (8 * c8) * 33 + n;
        u32x4 o; o.x = pk2(s[0 * 33], s[1 * 33]); o.y = pk2(s[2 * 33], s[3 * 33]); o.z = pk2(s[4 * 33], s[5 * 33]); o.w = pk2(s[6 * 33], s[7 * 33]);
        *(u32x4*)(Wt + (size_t)(dstrow + n) * K + k0 + 8 * c8) = o; }
    LDS_WAIT(); asm volatile("" ::: "memory");
}
__device__ __forceinline__ int win_src_col(int d) {
    if (d < 2048) return d + (SRC_QA - 0);
    if (d < 4096) return d + (SRC_KA - 2048);
    if (d < 4608) return d + (SRC_QB - 4096);
    if (d < 5120) return d + (SRC_KB - 4608);
    if (d < 6144) return d + (SRC_GB - 5120);
    if (d < 7168) return d + (SRC_UC - 6144);
    if (d < 9216) return d + (SRC_VA - 7168);
    return d + (SRC_VB - 9216);
}
constexpr int I_IN = 64 * 320, I_Z = 64, I_O = 64 * 128, I_UP = 64 * 688, I_DN = 172 * 128, I_P = 128, I_LAYER = I_IN + I_Z + I_O + I_UP + I_DN + I_P;

__device__ __forceinline__ void norm_row(const float* X, float* H, const bf16_t* Y, const float* gpost, const float* gnext, bf16_t* HN, int row, int lane) {
    f32x4 hv[16];
    const f32x4* src = (const f32x4*)((X ? X : H) + (size_t)row * D) + lane;
#pragma unroll
    for (int j = 0; j < 16; ++j) hv[j] = src[64 * j];
    if (Y) {
        const u32x2* yp = (const u32x2*)(Y + (size_t)row * D) + lane;
        f32x4 yv[16]; float s = 0.f;
#pragma unroll
        for (int j = 0; j < 16; ++j) { const u32x2 w = yp[64 * j]; yv[j] = (f32x4){__uint_as_float(w.x << 16), __uint_as_float(w.x & 0xffff0000u), __uint_as_float(w.y << 16), __uint_as_float(w.y & 0xffff0000u)}; s += yv[j].x * yv[j].x + yv[j].y * yv[j].y + yv[j].z * yv[j].z + yv[j].w * yv[j].w; }
        const float rs = rsqrtf(wave_sum(s) * (1.f / D) + EPS);
#pragma unroll
        for (int j = 0; j < 16; ++j) { const f32x4 g = ((const f32x4*)gpost)[lane + 64 * j]; hv[j] += yv[j] * rs * g; }
    }
    if (X || Y) {
        f32x4* hp = (f32x4*)(H + (size_t)row * D) + lane;
#pragma unroll
        for (int j = 0; j < 16; ++j) hp[64 * j] = hv[j];
    }
    if (gnext) {
        float s = 0.f;
#pragma unroll
        for (int j = 0; j < 16; ++j) s += hv[j].x * hv[j].x + hv[j].y * hv[j].y + hv[j].z * hv[j].z + hv[j].w * hv[j].w;
        const float rs = rsqrtf(wave_sum(s) * (1.f / D) + EPS);
        u32x2* op = (u32x2*)(HN + (size_t)row * D) + lane;
#pragma unroll
        for (int j = 0; j < 16; ++j) { const f32x4 g = ((const f32x4*)gnext)[lane + 64 * j]; const f32x4 v = hv[j] * rs * g;
            u32x2 o; o.x = cvt_pk_bf16(v.x, v.y); o.y = cvt_pk_bf16(v.z, v.w); op[64 * j] = o; }
    }
}

__device__ __forceinline__ void zlr_rows(const bf16_t* HN, const bf16_t* WZ, float* ZLR, int rb, LAS unsigned char* lds, int tid, int wave, int lane) {
    const int r = lane & 31, h = lane >> 5;
    f32x16 acc;
#pragma unroll
    for (int e = 0; e < 16; ++e) acc[e] = 0.f;
    const bf16_t* ap = HN + (size_t)(rb * 32 + r) * D + wave * 512 + 8 * h;
    const bf16_t* bp = WZ + (size_t)r * D + wave * 512 + 8 * h;
#pragma unroll 8
    for (int k = 0; k < 512; k += 16) acc = __builtin_amdgcn_mfma_f32_32x32x16_bf16(*(const bf16x8*)(ap + k), *(const bf16x8*)(bp + k), acc, 0, 0, 0);
    LAS float* red = (LAS float*)lds;
    if (r < 16) {
#pragma unroll
        for (int e = 0; e < 16; ++e) red[(wave * 32 + (e & 3) + 8 * (e >> 2) + 4 * h) * 16 + r] = acc[e];
    }
    __syncthreads();
    { const int row = tid >> 4, n = tid & 15; float s = 0.f;
#pragma unroll
      for (int w = 0; w < 8; ++w) s += red[(w * 32 + row) * 16 + n];
      ZLR[(size_t)(rb * 32 + row) * 16 + n] = s; }
    __syncthreads();
}


__device__ __forceinline__ void fix_rows(const float* ZB, const float* wc, const float* bc, bf16_t* F, int it) {
    const int c4 = it % (DFF / 4), rest = it / (DFF / 4), rr = rest & 1, ti = rest >> 1, pm = ti + 1 + ti / 15, c0 = c4 * 4;
    const float* zb = ZB + (size_t)pm * 4 * NUP; const float* zp = zb - (size_t)4 * NUP;
    const float* r0 = zb + (size_t)rr * NUP; const float* r1 = rr ? zb : zp + (size_t)3 * NUP; const float* r2 = rr ? zp + (size_t)3 * NUP : zp + (size_t)2 * NUP;
    const f32x4 g0 = *(const f32x4*)(r0 + c0), g1 = *(const f32x4*)(r1 + c0), g2 = *(const f32x4*)(r2 + c0), v0 = *(const f32x4*)(r0 + DFF + c0), v1 = *(const f32x4*)(r1 + DFF + c0), v2 = *(const f32x4*)(r2 + DFF + c0);
    const f32x4 wg0 = *(const f32x4*)(wc + c0), wg1 = *(const f32x4*)(wc + NUP + c0), wg2 = *(const f32x4*)(wc + 2 * NUP + c0), wv0 = *(const f32x4*)(wc + DFF + c0), wv1 = *(const f32x4*)(wc + NUP + DFF + c0), wv2 = *(const f32x4*)(wc + 2 * NUP + DFF + c0);
    const f32x4 gt = *(const f32x4*)(bc + c0) + wg0 * g2 + wg1 * g1 + wg2 * g0, vl = *(const f32x4*)(bc + DFF + c0) + wv0 * v2 + wv1 * v1 + wv2 * v0;
    u32x2 w; w.x = cvt_pk_bf16(pg8::gelu_tanh_e(gt[0]) * vl[0], pg8::gelu_tanh_e(gt[1]) * vl[1]); w.y = cvt_pk_bf16(pg8::gelu_tanh_e(gt[2]) * vl[2], pg8::gelu_tanh_e(gt[3]) * vl[3]);
    *(u32x2*)(F + (size_t)(pm * 256 + rr) * DFF + c0) = w;
}
__device__ __forceinline__ void knorm_rows(const bf16_t* UN, unsigned* KMAX, int rb, LAS unsigned char* lds, int tid) {
    const int row = tid >> 4, hm = tid & 15; const size_t tok = (size_t)rb * 32 + row;
    const bf16_t* kp = UN + tok * UNW + UN_KA + hm * 128; float s = 0.f;
#pragma unroll
    for (int c = 0; c < 16; ++c) { const bf16x8 v = *(const bf16x8*)(kp + 8 * c);
#pragma unroll
        for (int e = 0; e < 8; ++e) { const float x = bf2f((bf16_t)v[e]); s += x * x; } }
    LAS float* red = (LAS float*)lds;
    red[hm * 33 + row] = sqrtf(s);
    __syncthreads();
    if (tid < 16) { float m = 0.f;
#pragma unroll
        for (int r2 = 0; r2 < 32; ++r2) m = fmaxf(m, red[tid * 33 + r2]);
        const int b = (int)(((size_t)rb * 32) >> 12), tile = (int)((((size_t)rb * 32) & (SEQ - 1)) >> 6);
        __hip_atomic_fetch_max(KMAX + (b * 16 + tid) * 64 + tile, __float_as_uint(m), __ATOMIC_RELAXED, __HIP_MEMORY_SCOPE_AGENT); }
    __syncthreads();
}
__device__ __forceinline__ float gelu_tanh_fast(float x) { const float u = 1.5957691216057308f * (x + 0.044715f * x * x * x); return x / (1.f + __expf(-u)); }
__device__ __forceinline__ void conv_run(const bf16_t* Z, const float* wc, const float* bc, bf16_t* F, int run, int tid) {
    const size_t t0 = (size_t)run * 32; const bool first = ((run * 32) & (SEQ - 1)) == 0;
    for (int oc = tid; oc < DFF / 8; oc += 512) {
        const int c0 = oc * 8;
        float wg[3][8], wv[3][8], bg[8], bv[8];
#pragma unroll
        for (int j = 0; j < 3; ++j)
#pragma unroll
            for (int q = 0; q < 2; ++q) { const f32x4 a = *(const f32x4*)(wc + (size_t)j * NUP + c0 + 4 * q), b = *(const f32x4*)(wc + (size_t)j * NUP + DFF + c0 + 4 * q);
#pragma unroll
                for (int e = 0; e < 4; ++e) { wg[j][4 * q + e] = a[e]; wv[j][4 * q + e] = b[e]; } }
#pragma unroll
        for (int q = 0; q < 2; ++q) { const f32x4 a = *(const f32x4*)(bc + c0 + 4 * q), b = *(const f32x4*)(bc + DFF + c0 + 4 * q);
#pragma unroll
            for (int e = 0; e < 4; ++e) { bg[4 * q + e] = a[e]; bv[4 * q + e] = b[e]; } }
        float g2[8], g1[8], v2[8], v1[8];
        if (first) {
#pragma unroll
            for (int e = 0; e < 8; ++e) { g2[e] = 0.f; g1[e] = 0.f; v2[e] = 0.f; v1[e] = 0.f; }
        } else {
            const bf16x8 a2 = *(const bf16x8*)(Z + (t0 - 2) * NUP + c0), a1 = *(const bf16x8*)(Z + (t0 - 1) * NUP + c0), b2 = *(const bf16x8*)(Z + (t0 - 2) * NUP + DFF + c0), b1 = *(const bf16x8*)(Z + (t0 - 1) * NUP + DFF + c0);
#pragma unroll
            for (int e = 0; e < 8; ++e) { g2[e] = bf2f((bf16_t)a2[e]); g1[e] = bf2f((bf16_t)a1[e]); v2[e] = bf2f((bf16_t)b2[e]); v1[e] = bf2f((bf16_t)b1[e]); }
        }
#pragma unroll 4
        for (int r = 0; r < 32; ++r) {
            const bf16x8 a0 = *(const bf16x8*)(Z + (t0 + r) * NUP + c0), b0 = *(const bf16x8*)(Z + (t0 + r) * NUP + DFF + c0);
            float o[8];
#pragma unroll
            for (int e = 0; e < 8; ++e) { const float g0 = bf2f((bf16_t)a0[e]), v0 = bf2f((bf16_t)b0[e]);
                const float gt = bg[e] + wg[0][e] * g2[e] + wg[1][e] * g1[e] + wg[2][e] * g0, vl = bv[e] + wv[0][e] * v2[e] + wv[1][e] * v1[e] + wv[2][e] * v0;
                o[e] = gelu_tanh_fast(gt) * vl; g2[e] = g1[e]; g1[e] = g0; v2[e] = v1[e]; v1[e] = v0; }
            u32x4 w; w.x = cvt_pk_bf16(o[0], o[1]); w.y = cvt_pk_bf16(o[2], o[3]); w.z = cvt_pk_bf16(o[4], o[5]); w.w = cvt_pk_bf16(o[6], o[7]);
            *(u32x4*)(F + (t0 + r) * DFF + c0) = w;
        }
    }
}

constexpr int NPH = 21;
struct Args { const float* in[21]; float* out; unsigned char* ws; int ph_lo, ph_hi; };

__device__ __forceinline__ const void* lds_ptr(volatile LAS unsigned* A, int i) {
    const unsigned lo = __builtin_amdgcn_readfirstlane(A[2 * i]), hi = __builtin_amdgcn_readfirstlane(A[2 * i + 1]);
    return (const void*)(const GAS void*)(((unsigned long long)hi << 32) | (unsigned long long)lo);
}
constexpr int ARGS_OFF = RING_BYTES + 1024;
template <int LO, int HI> __global__ void __launch_bounds__(512, 2) fwd(Args args) {
    extern __shared__ __attribute__((aligned(16))) unsigned char lds_raw[];
    LAS unsigned char* lds = (LAS unsigned char*)lds_raw;
    volatile LAS unsigned* MISC = (volatile LAS unsigned*)(lds + MISC_OFF);
    volatile LAS unsigned* AP = (volatile LAS unsigned*)(lds + ARGS_OFF);
    const int wave = __builtin_amdgcn_readfirstlane((int)threadIdx.x >> 6);
#define FRESH_TID() int tid = threadIdx.x; asm volatile("" : "+v"(tid)); const int lane = tid & 63
#define P(i) ((const float*)lds_ptr(AP, (i)))
#define WSP() ((unsigned char*)lds_ptr(AP, 22))
    const int G = gridDim.x; const int bx = blockIdx.x; const int vcu = (G % 8 == 0) ? (bx % 8) * (G / 8) + bx / 8 : bx;
    constexpr int lo = LO, hi = HI;
    for (int u = threadIdx.x; u < (LDS_BYTES - LDSCTL_OFF) / 4; u += 512) ((LAS unsigned*)(lds + LDSCTL_OFF))[u] = 0u;
    __syncthreads();
    if (threadIdx.x == 0) {
        volatile LAS unsigned long long* A8 = (volatile LAS unsigned long long*)(lds + ARGS_OFF);
#pragma unroll
        for (int i = 0; i < 21; ++i) A8[i] = (unsigned long long)args.in[i];
        A8[21] = (unsigned long long)args.out; A8[22] = (unsigned long long)args.ws;
    }
    __syncthreads();
    XcdBarrier bar; bar.bar = (unsigned*)(WSP() + WS_CTL) + CW_BAR; bar.x = 0; bar.st = nullptr;
    if (hi - lo > 1) bar = xcd_barrier_post((unsigned*)(WSP() + WS_CTL) + CW_BAR, MISC + 8);
#define IN(k) (lo <= (k) && (k) < hi)
#define BOTH(k) (IN(k) && IN((k) + 1))
#define GRID_BAR(k) do { if (BOTH(k)) xcd_barrier(bar); } while (0)
#define REP(k) _Pragma("unroll") for (int rep_ = 0; rep_ < ((k) == MK_DOUBLE_PHASE ? 2 : 1); ++rep_)
    const int gw = vcu * 8 + wave, NGW = G * 8;

    if (IN(0)) REP(0) {
        FRESH_TID();
        unsigned char* ws = WSP();
        LAS float* scr = (LAS float*)(lds + wave * 16384);
        for (int it = gw; it < 2 * I_LAYER; it += NGW) {
            const int l = it >= I_LAYER ? 1 : 0; int r = it - l * I_LAYER;
            unsigned char* wl = ws + WS_W0 + (size_t)l * W_LAYER;
            if (r < I_IN) { const int kb = r / 320, nb = r % 320, d0 = nb * 32; cvt_item(P(1) + (size_t)l * D * NIN, NIN, win_src_col(d0), 32, (bf16_t*)(wl + OFF_WN), D, d0, kb * 64, scr, lane); continue; } r -= I_IN;
            if (r < I_Z) { cvt_item(P(1) + (size_t)l * D * NIN, NIN, SRC_ZLR, 16, (bf16_t*)(wl + OFF_WZ), D, 0, r * 64, scr, lane); continue; } r -= I_Z;
            if (r < I_O) { const int kb = r / 128, nb = r % 128; cvt_item(P(12) + (size_t)l * D * D, D, nb * 32, 32, (bf16_t*)(wl + OFF_WO), D, nb * 32, kb * 64, scr, lane); continue; } r -= I_O;
            if (r < I_UP) { const int kb = r / 688, nb = r % 688, d0 = nb * 32, src = ((d0 >> 7) & 1) * DFF + 128 * (d0 >> 8) + (d0 & 127);
                cvt_item(P(13) + (size_t)l * D * NUP, NUP, src, 32, (bf16_t*)(wl + OFF_WUP), D, d0, kb * 64, scr, lane); continue; } r -= I_UP;
            if (r < I_DN) { const int kb = r / 128, nb = r % 128; cvt_item(P(16) + (size_t)l * DFF * D, D, nb * 32, 32, (bf16_t*)(wl + OFF_WDN), DFF, nb * 32, kb * 64, scr, lane); continue; } r -= I_DN;
            { const int g = r >> 5, kb = (r >> 3) & 3, nb = r & 7; cvt_item(P(10) + ((size_t)l * 4 + g) * 65536, 256, nb * 32, 32, (bf16_t*)(wl + OFF_WP) + (size_t)g * 65536, 256, nb * 32, kb * 64, scr, lane); }
        }
        { const float* x = P(0); float* H = (float*)P(21); const float* g0 = P(17); bf16_t* HN = (bf16_t*)(ws + WS_HN);
          for (int m = gw; m < M; m += NGW) norm_row(x, H, nullptr, nullptr, g0, HN, m, lane); }
        GRID_BAR(0);
    }

    _Pragma("unroll") for (int l = 0; l < DEPTH; ++l) {
        const int pb = 1 + 10 * l;
        if (IN(pb + 0)) REP(pb + 0) {
            unsigned char* ws = WSP(); unsigned char* wl = ws + WS_W0 + (size_t)l * W_LAYER;
            const bf16_t* HN = (const bf16_t*)(ws + WS_HN);
            { pg8::Gemm g; g.A[0] = HN; g.Bt[0] = (const bf16_t*)(wl + OFF_WN); g.A[1] = (const bf16_t*)(wl + OFF_WT); g.Bt[1] = HN; g.lda = D; g.ldb = D; g.K = D;
              pg8::Order2 S; S.nM0 = M / 256; S.nN0 = UNW / 256; S.nM1 = UTW / 256; S.nN1 = M / 256; S.G = G; S.c = bx;
              pg8::EpiBf16 E; E.O[0] = (bf16_t*)(ws + WS_UN); E.ldc[0] = UNW; E.O[1] = (bf16_t*)(ws + WS_UT); E.ldc[1] = M;
              pg8::gemm_phase<pg8::EpiBf16, pg8::Order2, PG8_ALIGN, PG8_SP2>(lds, g, S, E); }
            FRESH_TID();
            for (int rb = bx; rb < M / 32; rb += G) zlr_rows(HN, (const bf16_t*)(wl + OFF_WZ), (float*)(ws + WS_ZLR), rb, lds, tid, wave, lane);
            for (int rb = bx; rb < M / 32; rb += G) knorm_rows((const bf16_t*)(ws + WS_UN), (unsigned*)(ws + WS_CTL) + CW_KMAX + l * 2048, rb, lds, tid);
            GRID_BAR(pb + 0);
        }
        if (IN(pb + 1)) REP(pb + 1) {
            FRESH_TID();
            unsigned char* ws = WSP(); unsigned char* gs = ws + WS_GLA;
            const bf16_t* UN = (const bf16_t*)(ws + WS_UN); const bf16_t* UT = (const bf16_t*)(ws + WS_UT); bf16_t* MIX = (bf16_t*)(ws + WS_MIX);
            { const float* w2 = P(2) + (size_t)l * 16 * 512; const float* bgt = P(3) + (size_t)l * 512; const float* ZLR = (const float*)(ws + WS_ZLR);
              FRESH_TID();
              for (int u = vcu; u < 512; u += G) gla::g1_unit(lds, UN, UT, ZLR, w2, bgt, gs, u, tid, wave, lane); }
            { const bf16_t* WP = (const bf16_t*)(ws + WS_W0 + (size_t)l * W_LAYER + OFF_WP); const float* psc = P(11) + (size_t)l * 1024;
              FRESH_TID();
              for (int pu = vcu; pu < 256; pu += G) pool_unit(lds, UN, WP, psc, MIX, pu, tid, wave, lane); }
            { const float lam_init = 0.8f - 0.6f * expf(-0.3f * (float)l);
              float lam = lam_of(P(4) + l * 128, P(5) + l * 128, P(6) + l * 128, P(7) + l * 128, lane, lam_init);
              lam = __uint_as_float(__builtin_amdgcn_readfirstlane(__float_as_uint(lam)));
              const float* gsub = P(8) + l * 256;
              FRESH_TID();
              unsigned* ctl = (unsigned*)(ws + WS_CTL);
              for (;;) {
                  if (tid == 0) MISC[16] = __hip_atomic_fetch_add(ctl + CW_QUEUE + l * 64, 1u, __ATOMIC_RELAXED, __HIP_MEMORY_SCOPE_AGENT);
                  __syncthreads();
                  const int idx = __builtin_amdgcn_readfirstlane((int)MISC[16]);
                  __syncthreads();
                  if (idx >= 512) break;
                  att::unit(lds, UN, UT, MIX, ctl + CW_KMAX + l * 2048, idx & 1, 7 - ((idx >> 1) & 7), 31 - (idx >> 4), lam, gsub, 1.f - lam_init, wave, lane); } }
            GRID_BAR(pb + 1);
        }
        if (IN(pb + 2)) REP(pb + 2) {
            FRESH_TID();
            unsigned char* gs = WSP() + WS_GLA;
            for (int p = vcu * 512 + tid; p < 131072; p += G * 512) gla::g2_scan(gs, p);
            GRID_BAR(pb + 2);
        }
        if (IN(pb + 3)) REP(pb + 3) {
            FRESH_TID();
            unsigned char* ws = WSP(); unsigned char* gs = ws + WS_GLA; const float* gg = P(9) + (size_t)l * 1024;
            for (int u = vcu; u < 512; u += G) gla::g3_unit(lds, (const bf16_t*)(ws + WS_UN), gs, gg, (bf16_t*)(ws + WS_MIX), u, tid, wave, lane);
            GRID_BAR(pb + 3);
        }
        if (IN(pb + 4)) REP(pb + 4) {
            unsigned char* ws = WSP(); unsigned char* wl = ws + WS_W0 + (size_t)l * W_LAYER;
            pg8::Gemm g; g.A[0] = (const bf16_t*)(ws + WS_MIX); g.Bt[0] = (const bf16_t*)(wl + OFF_WO); g.A[1] = g.A[0]; g.Bt[1] = g.Bt[0]; g.lda = D; g.ldb = D; g.K = D;
            pg8::Order2 S; S.nM0 = M / 256; S.nN0 = D / 256; S.nM1 = 0; S.nN1 = 1; S.G = G; S.c = bx;
            pg8::EpiBf16 E; E.O[0] = (bf16_t*)(ws + WS_Y); E.ldc[0] = D; E.O[1] = E.O[0]; E.ldc[1] = D;
            pg8::gemm_phase<pg8::EpiBf16, pg8::Order2, PG8_ALIGN, PG8_SP2>(lds, g, S, E);
            GRID_BAR(pb + 4);
        }
        if (IN(pb + 5)) {
            FRESH_TID();
            unsigned char* ws = WSP(); float* H = (float*)P(21); const bf16_t* Y = (const bf16_t*)(ws + WS_Y); const float* gp = P(18) + (size_t)l * D; const float* gn = P(19) + (size_t)l * D; bf16_t* HN = (bf16_t*)(ws + WS_HN);
            for (int m = gw; m < M; m += NGW) norm_row(nullptr, H, Y, gp, gn, HN, m, lane);
            GRID_BAR(pb + 5);
        }
        if (IN(pb + 6)) REP(pb + 6) {
            unsigned char* ws = WSP(); unsigned char* wl = ws + WS_W0 + (size_t)l * W_LAYER;
            pg8::Gemm g; g.A[0] = (const bf16_t*)(ws + WS_HN); g.Bt[0] = (const bf16_t*)(wl + OFF_WUP); g.A[1] = g.A[0]; g.Bt[1] = g.Bt[0]; g.lda = D; g.ldb = D; g.K = D;
            pg8::Order2 S; S.nM0 = M / 256; S.nN0 = NUP / 256; S.nM1 = 0; S.nN1 = 1; S.G = G; S.c = bx;
            pg8::EpiConvGlu E; E.F = (bf16_t*)(ws + WS_F); E.ZB = (float*)(ws + WS_ZB); E.wcv = P(14) + (size_t)l * 3 * NUP; E.bcv = P(15) + (size_t)l * NUP; E.halo = lds + 131072;
            pg8::gemm_phase<pg8::EpiConvGlu, pg8::Order2, PG8_ALIGN, PG8_SP2>(lds, g, S, E);
            GRID_BAR(pb + 6);
        }
        if (IN(pb + 7)) REP(pb + 7) {
            FRESH_TID();
            unsigned char* ws = WSP(); const float* wc = P(14) + (size_t)l * 3 * NUP; const float* bc = P(15) + (size_t)l * NUP;
            for (int it = vcu * 512 + tid; it < 30 * 2 * (DFF / 4); it += G * 512) fix_rows((const float*)(ws + WS_ZB), wc, bc, (bf16_t*)(ws + WS_F), it);
            GRID_BAR(pb + 7);
        }
        if (IN(pb + 8)) REP(pb + 8) {
            unsigned char* ws = WSP(); unsigned char* wl = ws + WS_W0 + (size_t)l * W_LAYER;
            pg8::Gemm g; g.A[0] = (const bf16_t*)(ws + WS_F); g.Bt[0] = (const bf16_t*)(wl + OFF_WDN); g.A[1] = g.A[0]; g.Bt[1] = g.Bt[0]; g.lda = DFF; g.ldb = DFF; g.K = DFF;
            pg8::Order2 S; S.nM0 = M / 256; S.nN0 = D / 256; S.nM1 = 0; S.nN1 = 1; S.G = G; S.c = bx;
            pg8::EpiBf16 E; E.O[0] = (bf16_t*)(ws + WS_Y); E.ldc[0] = D; E.O[1] = E.O[0]; E.ldc[1] = D;
            pg8::gemm_phase<pg8::EpiBf16, pg8::Order2, PG8_ALIGN, PG8_SP2>(lds, g, S, E);
            GRID_BAR(pb + 8);
        }
        if (IN(pb + 9)) {
            FRESH_TID();
            unsigned char* ws = WSP(); float* H = (float*)P(21); const bf16_t* Y = (const bf16_t*)(ws + WS_Y); const float* gp = P(20) + (size_t)l * D; const float* gn = l + 1 < DEPTH ? P(17) + (size_t)(l + 1) * D : nullptr; bf16_t* HN = (bf16_t*)(ws + WS_HN);
            for (int m = gw; m < M; m += NGW) norm_row(nullptr, H, Y, gp, gn, HN, m, lane);
            GRID_BAR(pb + 9);
        }
    }
#undef IN
#undef BOTH
#undef GRID_BAR
}

static int g_grid = 0;
template <int LO, int HI> static void launch_range(hipStream_t stream, const Args& a) {
    static bool attr = false;
    if (!attr) { if (hipFuncSetAttribute((const void*)fwd<LO, HI>, hipFuncAttributeMaxDynamicSharedMemorySize, LDS_BYTES) != hipSuccess) fprintf(stderr, "kernel_launch: hipFuncSetAttribute failed\n"); attr = true; }
    hipLaunchKernelGGL((fwd<LO, HI>), dim3(g_grid), dim3(512), LDS_BYTES, stream, a);
    const hipError_t le = hipPeekAtLastError();
    if (le != hipSuccess) fprintf(stderr, "kernel_launch: fwd launch [%d,%d) failed: %s\n", LO, HI, hipGetErrorName(le));
}
template <int P> static void launch_each(hipStream_t stream, const Args& a) { if constexpr (P < NPH) { launch_range<P, P + 1>(stream, a); launch_each<P + 1>(stream, a); } }
extern "C" void kernel_launch(void* const* d_in, const int* in_sizes, int n_in, void* d_out, int out_size, void* d_ws, size_t ws_size, hipStream_t stream) {
    if (n_in != 21 || ws_size < WS_END) { fprintf(stderr, "kernel_launch: unexpected n_in %d or ws %zu < %zu\n", n_in, ws_size, (size_t)WS_END); return; }
    if (g_grid == 0) {
        int dev = 0, cus = 0;
        if (hipGetDevice(&dev) != hipSuccess || hipDeviceGetAttribute(&cus, hipDeviceAttributeMultiprocessorCount, dev) != hipSuccess) { fprintf(stderr, "kernel_launch: device query failed\n"); g_grid = -1; return; }
        g_grid = cus;
    }
    if (g_grid < 0) return;
    (void)hipMemsetAsync((char*)d_ws + WS_CTL, 0, CTL_ZERO_BYTES, stream);
    Args a{};
    for (int i = 0; i < 21; ++i) a.in[i] = (const float*)d_in[i];
    a.out = (float*)d_out; a.ws = (unsigned char*)d_ws;
#if MK_ONE_LAUNCH
    launch_range<0, NPH>(stream, a);
#else
    launch_each<0>(stream, a);
#endif
}
```

```cpp
#ifndef MK_ONE_LAUNCH
#define MK_ONE_LAUNCH 1
#endif
#ifndef MK_DOUBLE_PHASE
#define MK_DOUBLE_PHASE (-1)
#endif
#include <hip/hip_runtime.h>
#include <stdint.h>
#include <stdio.h>

typedef unsigned short bf16_t;
typedef short bf16x8 __attribute__((ext_vector_type(8)));
typedef float f32x4 __attribute__((ext_vector_type(4)));
typedef float f32x16 __attribute__((ext_vector_type(16)));

constexpr int D = 4096, SEQ = 4096, M = 8192, DEPTH = 2;
constexpr int NIN = 10256, DFF = 11008, NUP = 22016;
constexpr int UNW = 7168, UTW = 3072;
constexpr float EPS = 1e-6f;
constexpr int UN_QA = 0, UN_KA = 2048, UN_QB = 4096, UN_KB = 4608, UN_GB = 5120, UN_UC = 6144;
constexpr int SRC_QA = 0, SRC_KA = 2048, SRC_VA = 4096, SRC_QB = 6144, SRC_KB = 6656, SRC_VB = 7168, SRC_GB = 8192, SRC_ZLR = 9216, SRC_UC = 9232;

constexpr size_t MiB = 1u << 20;
constexpr size_t WS_CTL = 0;
constexpr size_t WS_W0 = 1 * MiB;
constexpr size_t OFF_WN = 0, OFF_WT = 56 * MiB, OFF_WO = 80 * MiB, OFF_WUP = 112 * MiB, OFF_WDN = 284 * MiB, OFF_WP = 370 * MiB, W_LAYER = 371 * MiB;
constexpr size_t WS_HN = WS_W0 + 2 * W_LAYER;
constexpr size_t WS_UN = WS_HN + 64 * MiB;
constexpr size_t WS_UT = WS_UN + 112 * MiB;
constexpr size_t WS_ZLR = WS_UT + 48 * MiB;
constexpr size_t WS_MIX = WS_ZLR + 1 * MiB;
constexpr size_t WS_Y = WS_MIX + 64 * MiB;
constexpr size_t WS_Z = WS_Y + 128 * MiB;
constexpr size_t WS_F = WS_Z + 344 * MiB;
constexpr size_t WS_DP = WS_F + 172 * MiB;
constexpr size_t WS_END = WS_DP + 16 * MiB;

__device__ __forceinline__ bf16_t f2bf(float f) { unsigned u = __float_as_uint(f); u += 0x7fffu + ((u >> 16) & 1u); return (bf16_t)(u >> 16); }
__device__ __forceinline__ float bf2f(bf16_t b) { return __uint_as_float(((unsigned)b) << 16); }
__device__ __forceinline__ float wave_sum(float v) {
#pragma unroll
    for (int o = 1; o < 64; o <<= 1) v += __shfl_xor(v, o);
    return v;
}
__device__ __forceinline__ float wave_max(float v) {
#pragma unroll
    for (int o = 1; o < 64; o <<= 1) v = fmaxf(v, __shfl_xor(v, o));
    return v;
}

__global__ void k_cvt_t(const float* __restrict__ W, int ldw, int c0, bf16_t* __restrict__ Wt, int K, int r0) {
    __shared__ float t[64][65];
    const int nb = blockIdx.x, kb = blockIdx.y, tx = threadIdx.x & 63, ty = threadIdx.x >> 6;
    for (int i = ty; i < 64; i += 4) t[i][tx] = W[(size_t)(kb * 64 + i) * ldw + c0 + nb * 64 + tx];
    __syncthreads();
    for (int i = ty; i < 64; i += 4) Wt[(size_t)(r0 + nb * 64 + i) * K + kb * 64 + tx] = f2bf(t[tx][i]);
}

template <int OUTF32>
__global__ __launch_bounds__(256) void k_gemm(const bf16_t* __restrict__ A, int lda, const bf16_t* __restrict__ Bt, int ldb, void* C, int ldc, int K, const float* cscale) {
    const int wid = threadIdx.x >> 6, lane = threadIdx.x & 63, r = lane & 31, h = lane >> 5;
    const int m0 = blockIdx.y * 128 + (wid >> 1) * 64, n0 = blockIdx.x * 128 + (wid & 1) * 64;
    f32x16 acc[2][2];
#pragma unroll
    for (int i = 0; i < 2; ++i)
#pragma unroll
        for (int j = 0; j < 2; ++j)
#pragma unroll
            for (int e = 0; e < 16; ++e) acc[i][j][e] = 0.f;
    const bf16_t* a0 = A + (size_t)(m0 + r) * lda + 8 * h;
    const bf16_t* a1 = a0 + (size_t)32 * lda;
    const bf16_t* b0 = Bt + (size_t)(n0 + r) * ldb + 8 * h;
    const bf16_t* b1 = b0 + (size_t)32 * ldb;
    for (int k = 0; k < K; k += 16) {
        const bf16x8 fa0 = *(const bf16x8*)(a0 + k), fa1 = *(const bf16x8*)(a1 + k), fb0 = *(const bf16x8*)(b0 + k), fb1 = *(const bf16x8*)(b1 + k);
        acc[0][0] = __builtin_amdgcn_mfma_f32_32x32x16_bf16(fa0, fb0, acc[0][0], 0, 0, 0);
        acc[0][1] = __builtin_amdgcn_mfma_f32_32x32x16_bf16(fa0, fb1, acc[0][1], 0, 0, 0);
        acc[1][0] = __builtin_amdgcn_mfma_f32_32x32x16_bf16(fa1, fb0, acc[1][0], 0, 0, 0);
        acc[1][1] = __builtin_amdgcn_mfma_f32_32x32x16_bf16(fa1, fb1, acc[1][1], 0, 0, 0);
    }
#pragma unroll
    for (int i = 0; i < 2; ++i)
#pragma unroll
        for (int j = 0; j < 2; ++j)
#pragma unroll
            for (int e = 0; e < 16; ++e) {
                const int row = m0 + 32 * i + (e & 3) + 8 * (e >> 2) + 4 * h, col = n0 + 32 * j + r;
                float v = acc[i][j][e];
                if (OUTF32) ((float*)C)[(size_t)row * ldc + col] = v;
                else { if (cscale) v *= cscale[col]; ((bf16_t*)C)[(size_t)row * ldc + col] = f2bf(v); }
            }
}

__global__ __launch_bounds__(256) void k_norm(const float* X, float* H, const float* Y, const float* gpost, const float* gnext, bf16_t* HN) {
    const int row = blockIdx.x * 4 + (threadIdx.x >> 6), lane = threadIdx.x & 63;
    f32x4 hv[16];
    const f32x4* src = (const f32x4*)((X ? X : H) + (size_t)row * D) + lane;
#pragma unroll
    for (int j = 0; j < 16; ++j) hv[j] = src[64 * j];
    if (Y) {
        const f32x4* yp = (const f32x4*)(Y + (size_t)row * D) + lane;
        f32x4 yv[16]; float s = 0.f;
#pragma unroll
        for (int j = 0; j < 16; ++j) { yv[j] = yp[64 * j]; s += yv[j].x * yv[j].x + yv[j].y * yv[j].y + yv[j].z * yv[j].z + yv[j].w * yv[j].w; }
        const float rs = rsqrtf(wave_sum(s) * (1.f / D) + EPS);
#pragma unroll
        for (int j = 0; j < 16; ++j) { const f32x4 g = ((const f32x4*)gpost)[lane + 64 * j]; hv[j] += yv[j] * rs * g; }
    }
    if (X || Y) {
        f32x4* hp = (f32x4*)(H + (size_t)row * D) + lane;
#pragma unroll
        for (int j = 0; j < 16; ++j) hp[64 * j] = hv[j];
    }
    if (gnext) {
        float s = 0.f;
#pragma unroll
        for (int j = 0; j < 16; ++j) s += hv[j].x * hv[j].x + hv[j].y * hv[j].y + hv[j].z * hv[j].z + hv[j].w * hv[j].w;
        const float rs = rsqrtf(wave_sum(s) * (1.f / D) + EPS);
        uint2* op = (uint2*)(HN + (size_t)row * D) + lane;
#pragma unroll
        for (int j = 0; j < 16; ++j) { const f32x4 g = ((const f32x4*)gnext)[lane + 64 * j]; const f32x4 v = hv[j] * rs * g;
            uint2 o; o.x = (unsigned)f2bf(v.x) | ((unsigned)f2bf(v.y) << 16); o.y = (unsigned)f2bf(v.z) | ((unsigned)f2bf(v.w) << 16); op[64 * j] = o; }
    }
}

__global__ __launch_bounds__(256) void k_zlr(const bf16_t* HN, const float* w_in, float* ZLR) {
    const int row = blockIdx.x * 4 + (threadIdx.x >> 6), lane = threadIdx.x & 63;
    float acc[16];
#pragma unroll
    for (int j = 0; j < 16; ++j) acc[j] = 0.f;
    for (int k = lane; k < D; k += 64) {
        const float a = bf2f(HN[(size_t)row * D + k]);
        const f32x4* w = (const f32x4*)(w_in + (size_t)k * NIN + SRC_ZLR);
#pragma unroll
        for (int q = 0; q < 4; ++q) { const f32x4 wv = w[q]; acc[4 * q] += a * wv.x; acc[4 * q + 1] += a * wv.y; acc[4 * q + 2] += a * wv.z; acc[4 * q + 3] += a * wv.w; }
    }
#pragma unroll
    for (int j = 0; j < 16; ++j) acc[j] = wave_sum(acc[j]);
    if (lane == 0) {
#pragma unroll
        for (int j = 0; j < 16; ++j) ZLR[(size_t)row * 16 + j] = acc[j];
    }
}

__device__ __forceinline__ float lam_of(const float* q1, const float* k1, const float* q2, const float* k2, int lane, float lam_init) {
    float s1 = q1[lane] * k1[lane] + q1[lane + 64] * k1[lane + 64], s2 = q2[lane] * k2[lane] + q2[lane + 64] * k2[lane + 64];
    s1 = wave_sum(s1); s2 = wave_sum(s2);
    return expf(s1) - expf(s2) + lam_init;
}

__global__ __launch_bounds__(64) void k_attn_naive(const bf16_t* UN, const bf16_t* UT, bf16_t* MIX, const float* lq1, const float* lk1, const float* lq2, const float* lk2, const float* gsub, float lam_init) {
    __shared__ float sc[2][SEQ];
    __shared__ float qv[2][128];
    const int lane = threadIdx.x, q = blockIdx.x % SEQ, h = (blockIdx.x / SEQ) % 8, b = blockIdx.x / (SEQ * 8);
    const float lam = lam_of(lq1, lk1, lq2, lk2, lane, lam_init);
    const size_t tok = (size_t)b * SEQ + q;
    for (int i = lane; i < 256; i += 64) qv[i >> 7][i & 127] = bf2f(UN[tok * UNW + UN_QA + h * 256 + i]);
    __syncthreads();
    const int nk = (q / 64 + 1) * 64;
    const float slope = exp2f(-(float)(h + 1)), scale = 0.08838834764831845f;
    float mx[2] = {-INFINITY, -INFINITY};
    for (int j = lane; j < nk; j += 64) {
        const bf16_t* kp = UN + ((size_t)b * SEQ + j) * UNW + UN_KA + h * 256;
#pragma unroll
        for (int mp = 0; mp < 2; ++mp) {
            float d = 0.f;
            for (int c = 0; c < 128; c += 8) { const bf16x8 kv = *(const bf16x8*)(kp + mp * 128 + c);
#pragma unroll
                for (int e = 0; e < 8; ++e) d += qv[mp][c + e] * bf2f((bf16_t)kv[e]); }
            const float s = d * scale - slope * fabsf((float)(q - j));
            sc[mp][j] = s; mx[mp] = fmaxf(mx[mp], s);
        }
    }
    float l[2] = {0.f, 0.f};
#pragma unroll
    for (int mp = 0; mp < 2; ++mp) { mx[mp] = wave_max(mx[mp]); }
    for (int j = lane; j < nk; j += 64) {
#pragma unroll
        for (int mp = 0; mp < 2; ++mp) { const float p = expf(sc[mp][j] - mx[mp]); sc[mp][j] = p; l[mp] += p; }
    }
#pragma unroll
    for (int mp = 0; mp < 2; ++mp) l[mp] = wave_sum(l[mp]);
    const float i1 = 1.f / l[0], i2 = lam / l[1];
    for (int j = lane; j < nk; j += 64) sc[0][j] = sc[0][j] * i1 - sc[1][j] * i2;
    __syncthreads();
    float o[4] = {0.f, 0.f, 0.f, 0.f};
    for (int j = 0; j < nk; j += 8) {
#pragma unroll
        for (int i = 0; i < 4; ++i) {
            const bf16x8 vv = *(const bf16x8*)(UT + (size_t)(h * 256 + lane * 4 + i) * M + (size_t)b * SEQ + j);
#pragma unroll
            for (int e = 0; e < 8; ++e) o[i] += sc[0][j + e] * bf2f((bf16_t)vv[e]);
        }
    }
    float ss = o[0] * o[0] + o[1] * o[1] + o[2] * o[2] + o[3] * o[3];
    const float rs = rsqrtf(wave_sum(ss) * (1.f / 256.f) + EPS) * (1.f - lam_init);
#pragma unroll
    for (int i = 0; i < 4; ++i) MIX[tok * D + h * 256 + lane * 4 + i] = f2bf(o[i] * rs * gsub[lane * 4 + i]);
}

__global__ __launch_bounds__(256) void k_gla_naive(const bf16_t* UN, const bf16_t* UT, const float* ZLR, const float* w2, const float* bg, const float* ggla, bf16_t* MIX) {
    __shared__ float sa[128], sk[128], sq[128], red[4];
    const int e = threadIdx.x, h = blockIdx.x & 3, b = blockIdx.x >> 2;
    float S[128];
#pragma unroll
    for (int d = 0; d < 128; ++d) S[d] = 0.f;
    for (int t = 0; t < SEQ; ++t) {
        const size_t tok = (size_t)b * SEQ + t;
        if (e < 128) {
            float x = bg[h * 128 + e];
#pragma unroll
            for (int r = 0; r < 16; ++r) x += ZLR[tok * 16 + r] * w2[r * 512 + h * 128 + e];
            const float ls = fminf(x, 0.f) - log1pf(expf(-fabsf(x)));
            sa[e] = expf(ls * (1.f / 16.f));
            sk[e] = bf2f(UN[tok * UNW + UN_KB + h * 128 + e]);
            sq[e] = bf2f(UN[tok * UNW + UN_QB + h * 128 + e]) * 0.08838834764831845f;
        }
        __syncthreads();
        const float v = bf2f(UT[(size_t)(2048 + h * 256 + e) * M + tok]);
        float o = 0.f;
#pragma unroll
        for (int d = 0; d < 128; ++d) { S[d] = sa[d] * S[d] + sk[d] * v; o += sq[d] * S[d]; }
        const float ws = wave_sum(o * o);
        if ((e & 63) == 0) red[e >> 6] = ws;
        __syncthreads();
        const float ms = (red[0] + red[1] + red[2] + red[3]) * (1.f / 256.f);
        const float g = bf2f(UN[tok * UNW + UN_GB + h * 256 + e]);
        const float out = o * rsqrtf(ms + EPS) * ggla[h * 256 + e] * (g / (1.f + expf(-g)));
        MIX[tok * D + 2048 + h * 256 + e] = f2bf(out);
    }
}

__global__ void k_pool_d(const bf16_t* UN, bf16_t* DP) {
    const int idx = blockIdx.x * 256 + threadIdx.x, c = idx & 1023, tok = idx >> 10, t = tok & (SEQ - 1), g = c >> 8, w = 2 << g;
    const int lo = (t + 1 - w) > 0 ? (t + 1 - w) : 0;
    float s = 0.f;
    for (int j = lo; j <= t; ++j) s += bf2f(UN[(size_t)(tok - t + j) * UNW + UN_UC + c]);
    DP[(size_t)tok * 1024 + c] = f2bf(s / (float)(t + 1 - lo) - bf2f(UN[(size_t)tok * UNW + UN_UC + c]));
}

__device__ __forceinline__ float gelu_tanh(float x) { const float u = 0.7978845608028654f * (x + 0.044715f * x * x * x); return 0.5f * x * (1.f + tanhf(u)); }
__global__ void k_convglu(const bf16_t* Z, const float* wc, const float* bc, bf16_t* F) {
    const size_t idx = (size_t)blockIdx.x * 256 + threadIdx.x; const int c = (int)(idx % DFF); const size_t tok = idx / DFF; const int t = (int)(tok & (SEQ - 1));
    float gte = bc[c], val = bc[c + DFF];
#pragma unroll
    for (int j = 0; j < 3; ++j) { const int tt = t - 2 + j; if (tt >= 0) { const size_t r = (tok - 2 + j) * (size_t)NUP;
        gte += wc[j * NUP + c] * bf2f(Z[r + c]); val += wc[j * NUP + c + DFF] * bf2f(Z[r + c + DFF]); } }
    F[tok * DFF + c] = f2bf(gelu_tanh(gte) * val);
}


#define LAS __attribute__((address_space(3)))
#define GAS __attribute__((address_space(1)))
typedef unsigned u32x4 __attribute__((ext_vector_type(4)));
typedef unsigned u32x2 __attribute__((ext_vector_type(2)));
typedef float f32x2 __attribute__((ext_vector_type(2)));
typedef GAS unsigned gu32;
#define RLX_AGENT __ATOMIC_RELAXED, __HIP_MEMORY_SCOPE_AGENT
constexpr size_t WS_RS = WS_DP + 12 * MiB;
constexpr size_t WS_ZB = WS_DP;
constexpr size_t OFF_WZ = 370 * MiB + 512 * 1024;
constexpr int RING_BYTES = 141312, LDSCTL_OFF = RING_BYTES, MISC_OFF = LDSCTL_OFF + 320, LDS_BYTES = 147456;
constexpr int CW_BAR = 4096, CW_KMAX = 8192, CW_QUEUE = 12288;
constexpr size_t CTL_ZERO_BYTES = 64 * 1024;

__device__ __forceinline__ unsigned cvt_pk_bf16(float lo, float hi) { unsigned r; asm volatile("v_cvt_pk_bf16_f32 %0, %1, %2" : "=v"(r) : "v"(lo), "v"(hi)); return r; }

#define XB_TMO      128
#define XB_XCNT(j)  (256  + 64 * (j))
#define XB_XSUB(j)  (1280 + 64 * (j))
#define XB_XGEN(j)  (2304 + 64 * (j))
#define XB_TOP      3328
#define XB_TOPGEN   3392
#define XCD_BAR_WORDS 3456
#define XB_SPIN_CAP (1u << 18)
__device__ __forceinline__ unsigned xb_ld(unsigned* p)              { return __hip_atomic_load(p, __ATOMIC_RELAXED, __HIP_MEMORY_SCOPE_AGENT); }
__device__ __forceinline__ unsigned xb_add(unsigned* p, unsigned v) { return __hip_atomic_fetch_add(p, v, __ATOMIC_RELAXED, __HIP_MEMORY_SCOPE_AGENT); }
__device__ __forceinline__ unsigned xb_xcc_id() { return (unsigned)__builtin_amdgcn_s_getreg((3 << 11) | 20) & 0xFu; }
#define XB_SPIN(cond, bar) do { unsigned _sp = 0; while (cond) { __builtin_amdgcn_s_sleep(1); \
    if ((++_sp & 255u) == 0u) { if (xb_ld(&(bar)[XB_TMO])) break; if (_sp > XB_SPIN_CAP) { atomicAdd(&(bar)[XB_TMO], 1u); break; } } } } while (0)
struct XcdBarrier { unsigned* bar; unsigned x; volatile LAS unsigned* st; };
__device__ __forceinline__ XcdBarrier xcd_barrier_post(unsigned* bar, volatile LAS unsigned* st) {
    XcdBarrier b; b.bar = bar; b.x = xb_xcc_id(); b.st = st;
    if (threadIdx.x == 0) (void)xb_add(&bar[XB_XCNT(b.x)], 1u);
    return b;
}
__device__ __forceinline__ void xcd_barrier_complete(unsigned* bar, unsigned x, unsigned& nloc, unsigned& nx) {
    const unsigned G = gridDim.x * gridDim.y * gridDim.z;
    unsigned sum, cnt, mine, sp = 0u;
    for (;;) {
        sum = 0u; cnt = 0u; mine = 0u;
#pragma unroll
        for (unsigned j = 0; j < 16; ++j) { const unsigned c = xb_ld(&bar[XB_XCNT(j)]); sum += c; cnt += (c > 0u) ? 1u : 0u; mine = (j == x) ? c : mine; }
        if (sum == G) break;
        __builtin_amdgcn_s_sleep(1);
        if ((++sp & 255u) == 0u) { if (xb_ld(&bar[XB_TMO])) break; if (sp > XB_SPIN_CAP) { atomicAdd(&bar[XB_TMO], 1u); break; } }
    }
    nloc = mine > 0u ? mine : 1u; nx = cnt > 0u ? cnt : 1u;
}
__device__ __forceinline__ void xcd_barrier(const XcdBarrier& b) {
    asm volatile("s_waitcnt vmcnt(0)" ::: "memory");
    __syncthreads();
    if (threadIdx.x == 0) {
        unsigned* bar = b.bar;
        __builtin_amdgcn_s_waitcnt(0);
        unsigned nloc = b.st[0], nx = b.st[1];
        if (nloc == 0u) { xcd_barrier_complete(bar, b.x, nloc, nx); b.st[0] = nloc; b.st[1] = nx; }
        const unsigned old = xb_add(&bar[XB_XSUB(b.x)], 1u);
        const unsigned gen = old / nloc;
        if (old + 1u == (gen + 1u) * nloc) {
            __builtin_amdgcn_fence(__ATOMIC_RELEASE, "agent");
            asm volatile("s_waitcnt vmcnt(0)" ::: "memory");
            const unsigned og = xb_add(&bar[XB_TOP], 1u);
            const unsigned tg = og / nx;
            if (og + 1u == (tg + 1u) * nx) xb_add(&bar[XB_TOPGEN], 1u);
            else XB_SPIN(xb_ld(&bar[XB_TOPGEN]) == tg, bar);
            __builtin_amdgcn_fence(__ATOMIC_ACQUIRE, "agent");
            xb_add(&bar[XB_XGEN(b.x)], 1u);
            asm volatile("s_waitcnt vmcnt(0)" ::: "memory");
        } else {
            XB_SPIN(xb_ld(&bar[XB_XGEN(b.x)]) == gen, bar);
            __builtin_amdgcn_fence(__ATOMIC_ACQUIRE, "agent");
            asm volatile("s_waitcnt vmcnt(0)" ::: "memory");
        }
    }
    __syncthreads();
}

namespace pg8 {
constexpr int BM = 256, BK = 64, HALF = 128, HTB = HALF * BK * 2, STAGE_BYTES = 8 * HTB, NXCD = 8, WGM = 8;
__host__ __device__ __forceinline__ int lds_byte(int r, int c) { const int st = (r >> 4) * 2 + (c >> 5), rr = r & 15, cc = c & 31, ob = rr * 64 + cc * 2; return st * 1024 + (ob ^ (((ob >> 9) & 1) << 5)); }
__host__ __device__ __forceinline__ void stage_rc(int b, int& R, int& C) { const int st = b / 1024, sb = b % 1024, swz = sb ^ (((sb >> 9) & 1) << 5); R = (st >> 1) * 16 + swz / 64; C = (st & 1) * 32 + (swz % 64) / 2; }
__host__ __device__ __forceinline__ int perm32(int rho) { const int n = rho >> 4, i = rho & 15; return 8 * (i >> 2) + 4 * n + (i & 3); }

struct Unit { int pm, pn, kind; };
struct Gemm { const bf16_t* A[2]; const bf16_t* Bt[2]; int lda, ldb, K; };

__device__ __forceinline__ void tile_of(int wgid, int nM, int nN, int& pm, int& pn) {
    const int nwg = nM * nN; { const int q = nwg / NXCD, r = nwg % NXCD, xcd = wgid % NXCD, off = wgid / NXCD; wgid = (xcd < r ? xcd * (q + 1) : r * (q + 1) + (xcd - r) * q) + off; }
    const int nig = WGM * nN, gid = wgid / nig, fm = gid * WGM, gsz = (nM - fm) < WGM ? (nM - fm) : WGM;
    pm = fm + ((wgid % nig) % gsz); pn = (wgid % nig) / gsz;
}
struct Order2 {
    int nM0, nN0, nM1, nN1, G, c;
    __device__ __forceinline__ bool next(int i, Unit& u) const {
        const int L = i * G + c, n0 = nM0 * nN0;
        if (L < n0) { u.kind = 0; tile_of(L, nM0, nN0, u.pm, u.pn); return true; }
        if (L < n0 + nM1 * nN1) { u.kind = 1; tile_of(L - n0, nM1, nN1, u.pm, u.pn); return true; }
        return false;
    }
    __device__ __forceinline__ void a_ready(const Unit&) const {}
    __device__ __forceinline__ void done(const Unit&) const {}
};

struct EpiBf16 {
    static constexpr bool PERM = true;
    bf16_t* O[2]; int ldc[2]; const float* rs;
    __device__ __forceinline__ void operator()(const f32x4 (&acc)[2][2][4][2], const Unit& u, int wr, int wc, int fr, int fq) const {
        asm volatile("" : "+v"(fr), "+v"(fq));
        const int row0 = u.pm * BM + wr * 64 + fr, col0 = u.pn * BM + wc * 32 + 8 * fq;
        bf16_t* base = u.kind ? O[1] : O[0]; const int ld = u.kind ? ldc[1] : ldc[0];
        f32x4 cs[2][2];
#pragma unroll
        for (int bj = 0; bj < 2; ++bj)
#pragma unroll
            for (int n = 0; n < 2; ++n) cs[bj][n] = (rs && u.kind) ? *(const f32x4*)(rs + col0 + bj * HALF + 4 * n) : (f32x4){1.f, 1.f, 1.f, 1.f};
#pragma unroll
        for (int ai = 0; ai < 2; ++ai)
#pragma unroll
            for (int m = 0; m < 4; ++m) { const int row = row0 + ai * HALF + m * 16; bf16_t* rowp = base + (size_t)row * ld + col0;
                const float rsc = (rs && !u.kind) ? rs[row] : 1.f;
#pragma unroll
                for (int bj = 0; bj < 2; ++bj) { const f32x4 v0 = acc[ai][bj][m][0] * cs[bj][0] * rsc, v1 = acc[ai][bj][m][1] * cs[bj][1] * rsc;
                    u32x4 w; w.x = cvt_pk_bf16(v0[0], v0[1]); w.y = cvt_pk_bf16(v0[2], v0[3]); w.z = cvt_pk_bf16(v1[0], v1[1]); w.w = cvt_pk_bf16(v1[2], v1[3]);
                    *(u32x4*)(rowp + bj * HALF) = w; } }
    }
};
struct EpiF32 {
    static constexpr bool PERM = false;
    float* C; int ldc;
    __device__ __forceinline__ void operator()(const f32x4 (&acc)[2][2][4][2], const Unit& u, int wr, int wc, int fr, int fq) const {
        const int row0 = u.pm * BM + wr * 64 + fr, col0 = u.pn * BM + wc * 32 + 4 * fq;
#pragma unroll
        for (int ai = 0; ai < 2; ++ai)
#pragma unroll
            for (int m = 0; m < 4; ++m) { float* rowp = C + (size_t)(row0 + ai * HALF + m * 16) * ldc + col0;
#pragma unroll
                for (int bj = 0; bj < 2; ++bj)
#pragma unroll
                    for (int n = 0; n < 2; ++n) *(f32x4*)(rowp + bj * HALF + n * 16) = acc[ai][bj][m][n]; }
    }
};


__device__ __forceinline__ float dpp_ror1(float x) { return __int_as_float(__builtin_amdgcn_update_dpp(0, __float_as_int(x), 0x121, 0xf, 0xf, false)); }
__device__ __forceinline__ float dpp_ror2(float x) { return __int_as_float(__builtin_amdgcn_update_dpp(0, __float_as_int(x), 0x122, 0xf, 0xf, false)); }
__device__ __forceinline__ float gelu_tanh_e(float x) { const float u = 1.5957691216057308f * (x + 0.044715f * x * x * x); return x * __builtin_amdgcn_rcpf(1.f + __expf(-u)); }
struct EpiConvGlu {
    static constexpr bool PERM = true;
    bf16_t* F; float* ZB; const float* wcv; const float* bcv; const float* rs; LAS unsigned char* halo;
    __device__ __forceinline__ void operator()(const f32x4 (&acc)[2][2][4][2], const Unit& u, int wr, int wc, int fr, int fq) const {
        asm volatile("" : "+v"(fr), "+v"(fq));
        const int colt = wc * 32 + 8 * fq, ch = u.pn * 128 + colt;
        LAS float* HL = (LAS float*)halo;
        float rsr[2][4];
#pragma unroll
        for (int ai = 0; ai < 2; ++ai)
#pragma unroll
            for (int m = 0; m < 4; ++m) rsr[ai][m] = rs[u.pm * BM + ai * HALF + wr * 64 + m * 16 + fr];
        if (fr >= 14) {
#pragma unroll
            for (int ai = 0; ai < 2; ++ai) { const int blk = 2 * ai + wr;
#pragma unroll
                for (int bj = 0; bj < 2; ++bj)
#pragma unroll
                    for (int n = 0; n < 2; ++n) { const f32x4 v = acc[ai][bj][3][n] * rsr[ai][3];
                        if (blk < 3) *(LAS f32x4*)(HL + ((blk + 1) * 2 + (fr - 14)) * 256 + bj * 128 + colt + 4 * n) = v;
                        else *(f32x4*)(ZB + ((size_t)u.pm * 4 + 2 + (fr - 14)) * NUP + bj * DFF + ch + 4 * n) = v; } }
        }
        if (wr == 0 && fr < 2) {
#pragma unroll
            for (int bj = 0; bj < 2; ++bj)
#pragma unroll
                for (int n = 0; n < 2; ++n) *(f32x4*)(ZB + ((size_t)u.pm * 4 + fr) * NUP + bj * DFF + ch + 4 * n) = acc[0][bj][0][n] * rsr[0][0];
        }
        asm volatile("s_waitcnt lgkmcnt(0)" ::: "memory"); __builtin_amdgcn_s_barrier(); asm volatile("" ::: "memory");
#pragma unroll
        for (int n = 0; n < 2; ++n) {
            float wg[3][4], wv[3][4], bg[4], bv[4];
#pragma unroll
            for (int j = 0; j < 3; ++j) { const f32x4 a = *(const f32x4*)(wcv + (size_t)j * NUP + ch + 4 * n), b = *(const f32x4*)(wcv + (size_t)j * NUP + DFF + ch + 4 * n);
#pragma unroll
                for (int e = 0; e < 4; ++e) { wg[j][e] = a[e]; wv[j][e] = b[e]; } }
            { const f32x4 a = *(const f32x4*)(bcv + ch + 4 * n), b = *(const f32x4*)(bcv + DFF + ch + 4 * n);
#pragma unroll
              for (int e = 0; e < 4; ++e) { bg[e] = a[e]; bv[e] = b[e]; } }
#pragma unroll
            for (int ai = 0; ai < 2; ++ai) { const int blk = 2 * ai + wr;
                f32x4 pg = (f32x4){0.f, 0.f, 0.f, 0.f}, pv = (f32x4){0.f, 0.f, 0.f, 0.f};
                if (blk > 0 && fr >= 14) { pg = *(const LAS f32x4*)(HL + (blk * 2 + (fr - 14)) * 256 + colt + 4 * n); pv = *(const LAS f32x4*)(HL + (blk * 2 + (fr - 14)) * 256 + 128 + colt + 4 * n); }
#pragma unroll
                for (int m = 0; m < 4; ++m) { float o[4];
#pragma unroll
                    for (int j = 0; j < 4; ++j) {
                        const float g0 = acc[ai][0][m][n][j] * rsr[ai][m], v0 = acc[ai][1][m][n][j] * rsr[ai][m];
                        const float g1 = dpp_ror1(fr == 15 ? pg[j] : g0), g2 = dpp_ror2(fr >= 14 ? pg[j] : g0);
                        const float v1 = dpp_ror1(fr == 15 ? pv[j] : v0), v2 = dpp_ror2(fr >= 14 ? pv[j] : v0);
                        const float gt = bg[j] + wg[0][j] * g2 + wg[1][j] * g1 + wg[2][j] * g0, vl = bv[j] + wv[0][j] * v2 + wv[1][j] * v1 + wv[2][j] * v0;
                        o[j] = gelu_tanh_e(gt) * vl; }
                    u32x2 w; w.x = cvt_pk_bf16(o[0], o[1]); w.y = cvt_pk_bf16(o[2], o[3]);
                    *(u32x2*)(F + (size_t)(u.pm * BM + ai * HALF + wr * 64 + m * 16 + fr) * DFF + ch + 4 * n) = w;
                    pg = acc[ai][0][m][n] * rsr[ai][m]; pv = acc[ai][1][m][n] * rsr[ai][m]; }
            }
        }
    }
};

template <class Epi, class Sched, bool ALIGN_EPI, bool SP2>
__device__ __forceinline__ void gemm_phase(LAS unsigned char* lds, const Gemm g, const Sched& S, const Epi& E) {
    int tid = threadIdx.x; asm volatile("" : "+v"(tid));
    const int wid = __builtin_amdgcn_readfirstlane(tid >> 6), lane = tid & 63, wr = wid >> 2, wc = wid & 3, fr = lane & 15, fq = lane >> 4;
    const int K = g.K, nt = K / BK;
    unsigned voffA[2], voffB[2];
#pragma unroll
    for (int i = 0; i < 2; ++i) { int R, C; stage_rc(tid * 16 + i * 8192, R, C); const int Rb = Epi::PERM ? ((R & ~31) + perm32(R & 31)) : R;
        voffA[i] = (unsigned)(R * g.lda + C) * 2u; voffB[i] = (unsigned)(Rb * g.ldb + C) * 2u; }
    const size_t kstep = (size_t)(BK * 2);
    const size_t hstepA = (size_t)HALF * g.lda * 2, hstepB = (size_t)HALF * g.ldb * 2;
    const size_t tstepA = 2 * hstepA, tstepB = 2 * hstepB;
    const unsigned ldsw = (unsigned)wid * 1024u;
    const int aoff = lds_byte(wr * 64 + fr, fq * 8), boff = lds_byte(wc * 32 + fr, fq * 8);
#define PG8_SA(b, h) (((b) * 2 + (h)) * HTB)
#define PG8_SB(b, h) ((4 + (b) * 2 + (h)) * HTB)
#define PG8_STAGE(bufoff, gbase, voff) do { _Pragma("unroll") for (int _i = 0; _i < 2; ++_i) \
        __builtin_amdgcn_global_load_lds((const unsigned*)((const char*)(gbase) + (voff)[_i]), (LAS unsigned*)(lds + (bufoff) + ldsw + _i * 8192), 16, 0, 0); } while (0)
#define PG8_LDA(dst, b, h) do { _Pragma("unroll") for (int m = 0; m < 4; ++m) _Pragma("unroll") for (int k = 0; k < 2; ++k) dst[m][k] = *(const LAS bf16x8*)(lds + PG8_SA(b, h) + aoff + m * 2048 + k * 1024); } while (0)
#define PG8_LDB(dst, b, h) do { _Pragma("unroll") for (int n = 0; n < 2; ++n) _Pragma("unroll") for (int k = 0; k < 2; ++k) dst[n][k] = *(const LAS bf16x8*)(lds + PG8_SB(b, h) + boff + n * 2048 + k * 1024); } while (0)
#define PG8_MMA(ai, bj, At, Bt) do { __builtin_amdgcn_s_setprio(1); _Pragma("unroll") for (int m = 0; m < 4; ++m) _Pragma("unroll") for (int n = 0; n < 2; ++n) _Pragma("unroll") for (int k = 0; k < 2; ++k) \
        acc[ai][bj][m][n] = __builtin_amdgcn_mfma_f32_16x16x32_bf16(Bt[n][k], At[m][k], acc[ai][bj][m][n], 0, 0, 0); __builtin_amdgcn_s_setprio(0); } while (0)
#define PG8_WAIT_V(n) asm volatile("s_waitcnt vmcnt(" #n ")" ::: "memory")
#define PG8_WAIT_L(n) asm volatile("s_waitcnt lgkmcnt(" #n ")" ::: "memory")
#define PG8_BAR __builtin_amdgcn_s_barrier()
#define PG8_SCHED __builtin_amdgcn_sched_barrier(0)
    Unit cur, nxt; int ui = 0;
    if (!S.next(0, cur)) return;
    f32x4 acc[2][2][4][2];
#pragma unroll
    for (int a = 0; a < 2; ++a)
#pragma unroll
        for (int b = 0; b < 2; ++b)
#pragma unroll
            for (int m = 0; m < 4; ++m)
#pragma unroll
                for (int n = 0; n < 2; ++n) acc[a][b][m][n] = (f32x4){0.f, 0.f, 0.f, 0.f};
    bf16x8 At[4][2], B0[2][2], B1[2][2];
    const char* cA = (const char*)(cur.kind ? g.A[1] : g.A[0]) + (size_t)cur.pm * tstepA; const char* cB = (const char*)(cur.kind ? g.Bt[1] : g.Bt[0]) + (size_t)cur.pn * tstepB;
    S.a_ready(cur);
    if constexpr (SP2) {
        PG8_STAGE(PG8_SB(0, 0), cB, voffB); PG8_STAGE(PG8_SB(0, 1), cB + hstepB, voffB); PG8_STAGE(PG8_SA(0, 0), cA, voffA); PG8_STAGE(PG8_SA(0, 1), cA + hstepA, voffA);
        if (wr == 1) PG8_BAR;
        PG8_WAIT_V(2); PG8_BAR;
        PG8_STAGE(PG8_SB(1, 0), cB + kstep, voffB); PG8_STAGE(PG8_SA(1, 0), cA + kstep, voffA); PG8_STAGE(PG8_SB(1, 1), cB + hstepB + kstep, voffB);
        PG8_WAIT_V(6); PG8_BAR;
    } else {
        PG8_STAGE(PG8_SB(0, 0), cB, voffB); PG8_STAGE(PG8_SA(0, 0), cA, voffA); PG8_STAGE(PG8_SB(0, 1), cB + hstepB, voffB); PG8_STAGE(PG8_SA(0, 1), cA + hstepA, voffA);
        if (wr == 1) PG8_BAR;
        PG8_WAIT_V(4); PG8_BAR;
        PG8_STAGE(PG8_SB(1, 0), cB + kstep, voffB); PG8_STAGE(PG8_SA(1, 0), cA + kstep, voffA); PG8_STAGE(PG8_SB(1, 1), cB + hstepB + kstep, voffB);
        PG8_WAIT_V(6); PG8_BAR;
    }
    for (;;) {
        const bool has_next = S.next(ui + 1, nxt);
        const char* nA = has_next ? (const char*)(nxt.kind ? g.A[1] : g.A[0]) + (size_t)nxt.pm * tstepA : cA; const char* nB = has_next ? (const char*)(nxt.kind ? g.Bt[1] : g.Bt[0]) + (size_t)nxt.pn * tstepB : cB;
        for (int t = 0; t < nt; t += 2) {
            const bool last = (t == nt - 2);
            const char* a1 = cA + (size_t)(t + 1) * kstep;
            const char* a2 = last ? nA : cA + (size_t)(t + 2) * kstep; const char* b2 = last ? nB : cB + (size_t)(t + 2) * kstep;
            const char* a3 = a2 + kstep; const char* b3 = b2 + kstep;
            if (last && has_next) S.a_ready(nxt);
            if constexpr (SP2) {
            PG8_LDB(B0, 0, 0); PG8_LDB(B1, 0, 1); PG8_SCHED; PG8_LDA(At, 0, 0); PG8_STAGE(PG8_SA(1, 1), a1 + hstepA, voffA);
            PG8_WAIT_V(8); PG8_WAIT_L(0); PG8_BAR; PG8_MMA(0, 0, At, B0); PG8_MMA(0, 1, At, B1); PG8_BAR; PG8_SCHED;
            PG8_LDA(At, 0, 1); PG8_STAGE(PG8_SB(0, 0), b2, voffB); PG8_STAGE(PG8_SB(0, 1), b2 + hstepB, voffB); PG8_STAGE(PG8_SA(0, 0), a2, voffA);
            PG8_WAIT_V(8); PG8_WAIT_L(0); PG8_BAR; PG8_MMA(1, 0, At, B0); PG8_MMA(1, 1, At, B1); PG8_BAR; PG8_SCHED;
            PG8_LDB(B0, 1, 0); PG8_LDB(B1, 1, 1); PG8_SCHED; PG8_LDA(At, 1, 0); PG8_STAGE(PG8_SA(0, 1), a2 + hstepA, voffA);
            PG8_WAIT_V(8); PG8_WAIT_L(0); PG8_BAR; PG8_MMA(0, 0, At, B0); PG8_MMA(0, 1, At, B1); PG8_BAR; PG8_SCHED;
            PG8_LDA(At, 1, 1); PG8_STAGE(PG8_SB(1, 0), b3, voffB); PG8_STAGE(PG8_SB(1, 1), b3 + hstepB, voffB); PG8_STAGE(PG8_SA(1, 0), a3, voffA);
            PG8_WAIT_V(8); PG8_WAIT_L(0); PG8_BAR; PG8_MMA(1, 0, At, B0); PG8_MMA(1, 1, At, B1); PG8_BAR; PG8_SCHED;
            } else {
            PG8_LDB(B0, 0, 0); PG8_SCHED; PG8_LDA(At, 0, 0); PG8_STAGE(PG8_SA(1, 1), a1 + hstepA, voffA);
            PG8_WAIT_L(8); PG8_BAR; PG8_WAIT_L(0); PG8_MMA(0, 0, At, B0); PG8_BAR; PG8_SCHED;
            PG8_LDB(B1, 0, 1); PG8_STAGE(PG8_SB(0, 0), b2, voffB);
            PG8_BAR; PG8_WAIT_L(0); PG8_MMA(0, 1, At, B1); PG8_BAR;
            PG8_LDA(At, 0, 1); PG8_STAGE(PG8_SA(0, 0), a2, voffA);
            PG8_BAR; PG8_WAIT_L(0); PG8_MMA(1, 0, At, B0); PG8_BAR; PG8_SCHED;
            PG8_STAGE(PG8_SB(0, 1), b2 + hstepB, voffB);
            PG8_WAIT_V(6); PG8_BAR; PG8_MMA(1, 1, At, B1); PG8_BAR;
            PG8_LDB(B0, 1, 0); PG8_SCHED; PG8_LDA(At, 1, 0); PG8_STAGE(PG8_SA(0, 1), a2 + hstepA, voffA);
            PG8_WAIT_L(8); PG8_BAR; PG8_WAIT_L(0); PG8_MMA(0, 0, At, B0); PG8_BAR; PG8_SCHED;
            PG8_LDB(B1, 1, 1); PG8_STAGE(PG8_SB(1, 0), b3, voffB);
            PG8_BAR; PG8_WAIT_L(0); PG8_MMA(0, 1, At, B1); PG8_BAR;
            PG8_LDA(At, 1, 1); PG8_STAGE(PG8_SA(1, 0), a3, voffA);
            PG8_BAR; PG8_WAIT_L(0); PG8_MMA(1, 0, At, B0); PG8_BAR; PG8_SCHED;
            PG8_STAGE(PG8_SB(1, 1), b3 + hstepB, voffB);
            PG8_WAIT_V(6); PG8_BAR; PG8_MMA(1, 1, At, B1); PG8_BAR;
            }
        }
        if constexpr (ALIGN_EPI) { if (wr == 0) PG8_BAR; }
        E(acc, cur, wr, wc, fr, fq); S.done(cur);
        if (!has_next) break;
#pragma unroll
        for (int a = 0; a < 2; ++a)
#pragma unroll
            for (int b = 0; b < 2; ++b)
#pragma unroll
                for (int m = 0; m < 4; ++m)
#pragma unroll
                    for (int n = 0; n < 2; ++n) acc[a][b][m][n] = (f32x4){0.f, 0.f, 0.f, 0.f};
        cur = nxt; cA = nA; cB = nB; ++ui;
        if constexpr (ALIGN_EPI) { if (wr == 1) PG8_BAR; }
    }
    PG8_WAIT_V(0);
    if constexpr (!ALIGN_EPI) { if (wr == 0) PG8_BAR; }
    PG8_BAR;
#undef PG8_SA
#undef PG8_SB
#undef PG8_STAGE
#undef PG8_LDA
#undef PG8_LDB
#undef PG8_MMA
#undef PG8_WAIT_V
#undef PG8_WAIT_L
#undef PG8_BAR
#undef PG8_SCHED
}
}
#ifndef PG8_SP2
#define PG8_SP2 true
#endif
#ifndef PG8_ALIGN
#define PG8_ALIGN true
#endif

constexpr size_t WS_GLA = WS_Z;
constexpr size_t GLA_LT = 0, GLA_OI = 64 * MiB, GLA_ST = 96 * MiB, GLA_QT = 128 * MiB, GLA_DEC = 136 * MiB;
__device__ __forceinline__ int crow(int i, int hh) { return (i & 3) + 8 * (i >> 2) + 4 * hh; }
#define MFMA32(a, b, c) __builtin_amdgcn_mfma_f32_32x32x16_bf16((a), (b), (c), 0, 0, 0)
#define WG_BAR() do { asm volatile("s_waitcnt vmcnt(0) lgkmcnt(0)" ::: "memory"); __builtin_amdgcn_s_barrier(); asm volatile("" ::: "memory"); } while (0)

__device__ __forceinline__ f32x16 mma_lds(const LAS bf16_t* A, int pa, const LAS bf16_t* B, int pb, int K, f32x16 acc, int r, int hh) {
    const LAS bf16_t* ap = A + r * pa + 8 * hh; const LAS bf16_t* bp = B + r * pb + 8 * hh;
    for (int k = 0; k < K; k += 16) acc = MFMA32(*(const LAS bf16x8*)(ap + k), *(const LAS bf16x8*)(bp + k), acc);
    return acc;
}

namespace att {
constexpr float LOG2E = 1.4426950408889634f, C1 = 0.08838834764831845f * LOG2E, THRL = 8.f;
constexpr int KP = 528, VP = 144, VBYTES = 256 * VP, KBYTES = 64 * KP, ABUF = VBYTES + KBYTES, XP = 1040;
__device__ __forceinline__ void stage_tile(LAS unsigned char* buf, const char* kt, const char* vt, int wave, int lane) {
    asm volatile("" : "+v"(lane));
#pragma unroll
    for (int i = 0; i < 5; ++i) { const int iv = wave + 8 * i; if (iv < 36) { const unsigned q = iv * 64 + lane, row = q / 9u, cp = q - 9u * row, cc = cp < 8u ? cp : 7u;
        __builtin_amdgcn_global_load_lds((const GAS unsigned*)(vt + (row * (unsigned)(M * 2) + cc * 16u)), (LAS unsigned*)(buf + iv * 1024), 16, 0, 0); } }
#pragma unroll
    for (int i = 0; i < 5; ++i) { const int ik = wave + 8 * i; if (ik < 33) { const unsigned q = ik * 64 + lane, row = q / 33u, cp = q - 33u * row, cc = cp < 32u ? cp : 31u;
        __builtin_amdgcn_global_load_lds((const GAS unsigned*)(kt + (row * (unsigned)(UNW * 2) + cc * 16u)), (LAS unsigned*)(buf + VBYTES + ik * 1024), 16, 0, 0); } }
}
constexpr float TSKIP = 64.f;
__device__ __forceinline__ void unit(LAS unsigned char* lds, const bf16_t* UN, const bf16_t* UT, bf16_t* MIX, const unsigned* KMAX, int b, int h, int qb, float lam, const float* gsub, float post_scale, int wave, int lane) {
    const int mp = wave >> 2, wq = wave & 3, r = lane & 31, hh = lane >> 5;
    const int q0 = qb * 128 + wq * 32, qpos = q0 + r, cw = q0 >> 6;
    const float C2 = __uint_as_float((unsigned)(127 - (h + 1)) << 23) * LOG2E;
    const char* kt = (const char*)(UN + (size_t)(b * SEQ) * UNW + UN_KA + h * 256);
    const char* vt = (const char*)(UT + (size_t)(h * 256) * M + (size_t)b * SEQ);
    bf16x8 qf[8];
    { const bf16_t* qp = UN + (size_t)(b * SEQ + qpos) * UNW + UN_QA + h * 256 + mp * 128 + 8 * hh;
#pragma unroll
      for (int kk = 0; kk < 8; ++kk) qf[kk] = *(const bf16x8*)(qp + 16 * kk); }
    unsigned long long mask;
    { float qs = 0.f;
#pragma unroll
      for (int kk = 0; kk < 8; ++kk)
#pragma unroll
          for (int e = 0; e < 8; ++e) { const float x = bf2f((bf16_t)qf[kk][e]); qs += x * x; }
      { auto rr = __builtin_amdgcn_permlane32_swap(__float_as_uint(qs), __float_as_uint(qs), false, false); qs = __uint_as_float(rr[0]) + __uint_as_float(rr[1]); }
#pragma unroll
      for (int o = 1; o < 32; o <<= 1) qs = fmaxf(qs, __shfl_xor(qs, o));
      const float qn = sqrtf(qs) * 1.001f;
      const float km = __uint_as_float(__hip_atomic_load(KMAX + ((b * 8 + h) * 2 + mp) * 64 + lane, __ATOMIC_RELAXED, __HIP_MEMORY_SCOPE_AGENT)) * 1.001f;
      const float kcw = __uint_as_float(__builtin_amdgcn_readlane(__float_as_uint(km), cw));
      const int md = q0 - (64 * lane + 63);
      const bool need = (lane <= cw) && (C1 * qn * (km + kcw) - C2 * (float)(md > 0 ? md : 0) >= -TSKIP);
      mask = __ballot(need); }
    volatile LAS unsigned long long* masks = (volatile LAS unsigned long long*)(lds + LDSCTL_OFF + 512);
    if (lane == 0) masks[wave] = mask;
    f32x16 O[8];
#pragma unroll
    for (int eb = 0; eb < 8; ++eb)
#pragma unroll
        for (int i = 0; i < 16; ++i) O[eb][i] = 0.f;
    float m_ref = -INFINITY, l_acc = 0.f;
    WG_BAR();
    unsigned long long rem = 0ull;
#pragma unroll
    for (int w = 0; w < 8; ++w) { const unsigned long long mw = masks[w]; rem |= ((unsigned long long)__builtin_amdgcn_readfirstlane((unsigned)(mw >> 32)) << 32) | (unsigned long long)__builtin_amdgcn_readfirstlane((unsigned)mw); }
    int j = __builtin_ctzll(rem); rem &= rem - 1ull;
    stage_tile(lds, kt + (size_t)j * 64 * UNW * 2, vt + (size_t)j * 128, wave, lane);
    const int kbase = VBYTES + r * KP + mp * 256 + hh * 16, vbase = r * VP + hh * 16;
    for (int it = 0;; ++it) {
        WG_BAR();
        LAS unsigned char* buf = lds + (it & 1) * ABUF;
        const int jn = rem ? __builtin_ctzll(rem) : -1;
        if (jn >= 0) { rem &= rem - 1ull; stage_tile(lds + ((it + 1) & 1) * ABUF, kt + (size_t)jn * 64 * UNW * 2, vt + (size_t)jn * 128, wave, lane); }
        if ((mask >> j) & 1ull) {
            const LAS unsigned char* kp = buf + kbase; const LAS unsigned char* vp = buf + vbase;
#pragma unroll
            for (int hf = 0; hf < 2; ++hf) {
                f32x16 p0;
#pragma unroll
                for (int i = 0; i < 16; ++i) p0[i] = 0.f;
#pragma unroll
                for (int kk = 0; kk < 8; ++kk) p0 = MFMA32(*(const LAS bf16x8*)(kp + hf * 32 * KP + kk * 32), qf[kk], p0);
                const float base0 = (float)(qpos - 64 * j - 32 * hf - 4 * hh);
                float pmax = -INFINITY;
#pragma unroll
                for (int i = 0; i < 16; ++i) { const float off = (float)((i & 3) + 8 * (i >> 2));
                    p0[i] = fmaf(p0[i], C1, -C2 * fabsf(base0 - off)); pmax = fmaxf(pmax, p0[i]); }
                { auto rr = __builtin_amdgcn_permlane32_swap(__float_as_uint(pmax), __float_as_uint(pmax), false, false); pmax = fmaxf(__uint_as_float(rr[0]), __uint_as_float(rr[1])); }
                if (!__all(pmax - m_ref <= THRL)) {
                    const float mn = fmaxf(m_ref, pmax), alpha = __builtin_amdgcn_exp2f(m_ref - mn); m_ref = mn; l_acc *= alpha;
#pragma unroll
                    for (int eb = 0; eb < 8; ++eb)
#pragma unroll
                        for (int i = 0; i < 16; ++i) O[eb][i] *= alpha;
                }
                float ps = 0.f;
#pragma unroll
                for (int i = 0; i < 16; ++i) { p0[i] = __builtin_amdgcn_exp2f(p0[i] - m_ref); ps += p0[i]; }
                l_acc += ps;
                bf16x8 pf[2];
#define PK4(P, BASE, OUT) do { const unsigned a0 = cvt_pk_bf16(P[BASE + 0], P[BASE + 1]), a1 = cvt_pk_bf16(P[BASE + 2], P[BASE + 3]); \
    const unsigned b0 = cvt_pk_bf16(P[BASE + 4], P[BASE + 5]), b1 = cvt_pk_bf16(P[BASE + 6], P[BASE + 7]); \
    auto r0 = __builtin_amdgcn_permlane32_swap(a0, b0, false, false); auto r1 = __builtin_amdgcn_permlane32_swap(a1, b1, false, false); \
    u32x4 w = {r0[0], r1[0], r0[1], r1[1]}; OUT = *reinterpret_cast<bf16x8*>(&w); } while (0)
                PK4(p0, 0, pf[0]); PK4(p0, 8, pf[1]);
#undef PK4
#define LDV(EB, S2) (*(const LAS bf16x8*)(vp + (EB) * 32 * VP + (4 * hf + 2 * (S2)) * 16))
                { bf16x8 va[4] = {LDV(0, 0), LDV(0, 1), LDV(1, 0), LDV(1, 1)};
#pragma unroll
                  for (int eb = 0; eb < 8; eb += 2) { bf16x8 vn[4];
                      if (eb < 6) { vn[0] = LDV(eb + 2, 0); vn[1] = LDV(eb + 2, 1); vn[2] = LDV(eb + 3, 0); vn[3] = LDV(eb + 3, 1); }
                      O[eb] = MFMA32(va[0], pf[0], O[eb]); O[eb + 1] = MFMA32(va[2], pf[0], O[eb + 1]); O[eb] = MFMA32(va[1], pf[1], O[eb]); O[eb + 1] = MFMA32(va[3], pf[1], O[eb + 1]);
                      __builtin_amdgcn_sched_barrier(0);
                      if (eb < 6) { va[0] = vn[0]; va[1] = vn[1]; va[2] = vn[2]; va[3] = vn[3]; } } }
#undef LDV
            }
        }
        if (jn < 0) break;
        j = jn;
    }
    { auto rr = __builtin_amdgcn_permlane32_swap(__float_as_uint(l_acc), __float_as_uint(l_acc), false, false); l_acc = __uint_as_float(rr[0]) + __uint_as_float(rr[1]); }
    WG_BAR();
    LAS unsigned char* xp = lds + (wq * 32 + r) * XP + hh * 16;
    if (mp == 1) {
        const float inv = lam / l_acc;
#pragma unroll
        for (int eb = 0; eb < 8; ++eb)
#pragma unroll
            for (int g4 = 0; g4 < 4; ++g4) { const f32x4 v = {O[eb][4 * g4] * inv, O[eb][4 * g4 + 1] * inv, O[eb][4 * g4 + 2] * inv, O[eb][4 * g4 + 3] * inv};
                *(LAS f32x4*)(xp + (8 * eb + 2 * g4) * 16) = v; }
    }
    WG_BAR();
    if (mp == 0) {
        const float inv = 1.f / l_acc; float ss = 0.f;
#pragma unroll
        for (int eb = 0; eb < 8; ++eb) {
#pragma unroll
            for (int g4 = 0; g4 < 4; ++g4) { const f32x4 x = *(const LAS f32x4*)(xp + (8 * eb + 2 * g4) * 16);
#pragma unroll
                for (int e = 0; e < 4; ++e) { const float v = O[eb][4 * g4 + e] * inv - x[e]; O[eb][4 * g4 + e] = v; ss += v * v; } }
            asm volatile("" ::: "memory"); }
        { auto rr = __builtin_amdgcn_permlane32_swap(__float_as_uint(ss), __float_as_uint(ss), false, false); ss = __uint_as_float(rr[0]) + __uint_as_float(rr[1]); }
        const float rs = rsqrtf(ss * (1.f / 256.f) + EPS) * post_scale;
        bf16_t* op = MIX + (size_t)(b * SEQ + qpos) * D + h * 256 + 4 * hh; const float* gp = gsub + 4 * hh;
#pragma unroll
        for (int eb = 0; eb < 8; ++eb) {
#pragma unroll
            for (int g4 = 0; g4 < 4; ++g4) { const int e0 = 32 * eb + 8 * g4; const f32x4 g = *(const f32x4*)(gp + e0);
                u32x2 w; w.x = cvt_pk_bf16(O[eb][4 * g4] * rs * g[0], O[eb][4 * g4 + 1] * rs * g[1]); w.y = cvt_pk_bf16(O[eb][4 * g4 + 2] * rs * g[2], O[eb][4 * g4 + 3] * rs * g[3]);
                *(u32x2*)(op + e0) = w; }
            asm volatile("" ::: "memory"); }
    }
    WG_BAR();
}
}

namespace gla {
constexpr int O_LA = 0, O_ZL = 32768, O_QT = 36864, O_KT = 54272, O_KHT = 71680, O_VT = 90112, O_AM = 0;
constexpr int PQ = 136, PS = 72;
__device__ __forceinline__ void g1_unit(LAS unsigned char* lds, const bf16_t* UN, const bf16_t* UT, const float* ZLR, const float* w2, const float* bgate, unsigned char* gs, int u, int tid, int wave, int lane) {
    const int c = u & 63, h = (u >> 6) & 3, b = u >> 8; const size_t tok0 = (size_t)b * SEQ + c * 64;
    LAS float* LA = (LAS float*)(lds + O_LA); LAS float* ZL = (LAS float*)(lds + O_ZL);
    LAS bf16_t* QT = (LAS bf16_t*)(lds + O_QT); LAS bf16_t* KT = (LAS bf16_t*)(lds + O_KT); LAS bf16_t* KHT = (LAS bf16_t*)(lds + O_KHT); LAS bf16_t* VT = (LAS bf16_t*)(lds + O_VT); LAS bf16_t* AM = (LAS bf16_t*)(lds + O_AM);
    if (tid < 256) *(LAS f32x4*)(ZL + tid * 4) = *(const f32x4*)(ZLR + tok0 * 16 + tid * 4);
#pragma unroll
    for (int i = 0; i < 4; ++i) { const int id = tid + 512 * i, row = id >> 3, ch = id & 7;
        *(LAS u32x4*)(VT + row * PS + ch * 8) = *(const u32x4*)(UT + (size_t)(2048 + h * 256 + row) * M + tok0 + ch * 8); }
    WG_BAR();
    const int d = tid & 127, qd = tid >> 7;
    float bt[16];
    { float w[16];
#pragma unroll
      for (int rr = 0; rr < 16; ++rr) w[rr] = w2[rr * 512 + h * 128 + d];
      const float bias = bgate[h * 128 + d]; float run = 0.f;
#pragma unroll
      for (int i = 0; i < 16; ++i) { const int t = qd * 16 + i; float x = bias;
#pragma unroll
          for (int rr = 0; rr < 16; ++rr) x += ZL[t * 16 + rr] * w[rr];
          const float ls = fminf(x, 0.f) - log1pf(__expf(-fabsf(x)));
          run += ls * (1.f / 16.f); bt[i] = run; }
      WG_BAR();
      ZL[qd * 128 + d] = run; }
    WG_BAR();
    float off = 0.f, btot = 0.f;
#pragma unroll
    for (int q = 0; q < 4; ++q) { const float p = ZL[q * 128 + d]; btot += p; if (q < qd) off += p; }
    bf16_t* QTg = (bf16_t*)(gs + GLA_QT) + (size_t)u * 64 * 128;
#pragma unroll
    for (int i = 0; i < 16; ++i) { const int t = qd * 16 + i; const float bb = bt[i] + off;
        const float qv = bf2f(UN[(tok0 + t) * UNW + UN_QB + h * 128 + d]) * 0.08838834764831845f, kv = bf2f(UN[(tok0 + t) * UNW + UN_KB + h * 128 + d]);
        const bf16_t qt = f2bf(qv * __expf(bb));
        QT[t * PQ + d] = qt; QTg[t * 128 + d] = qt; KT[t * PQ + d] = f2bf(kv * __expf(-bb)); KHT[d * PS + t] = f2bf(kv * __expf(btot - bb)); }
    if (qd == 0) ((float*)(gs + GLA_DEC))[(size_t)u * 128 + d] = __expf(btot);
    WG_BAR();
    const int r = lane & 31, hh = lane >> 5;
    f32x16 zero;
#pragma unroll
    for (int i = 0; i < 16; ++i) zero[i] = 0.f;
    if (wave < 4) {
        const int mi = wave >> 1, ni = wave & 1;
        const f32x16 a = mma_lds(QT + 32 * mi * PQ, PQ, KT + 32 * ni * PQ, PQ, 128, zero, r, hh);
#pragma unroll
        for (int i = 0; i < 16; ++i) { const int t = 32 * mi + crow(i, hh), s = 32 * ni + r; AM[t * PS + s] = f2bf(s <= t ? a[i] : 0.f); }
    }
    { float* LT = (float*)(gs + GLA_LT) + (size_t)u * 256 * 128;
#pragma unroll
      for (int db = 0; db < 4; ++db) { const f32x16 a = mma_lds(VT + 32 * wave * PS, PS, KHT + 32 * db * PS, PS, 64, zero, r, hh);
#pragma unroll
          for (int i = 0; i < 16; ++i) LT[(size_t)(32 * wave + crow(i, hh)) * 128 + 32 * db + r] = a[i]; } }
    WG_BAR();
    { float* OI = (float*)(gs + GLA_OI) + (size_t)u * 64 * 256;
#pragma unroll
      for (int tb = 0; tb < 2; ++tb) { const f32x16 a = mma_lds(AM + 32 * tb * PS, PS, VT + 32 * wave * PS, PS, 64, zero, r, hh);
#pragma unroll
          for (int i = 0; i < 16; ++i) OI[(size_t)(32 * tb + crow(i, hh)) * 256 + 32 * wave + r] = a[i]; } }
    WG_BAR();
}
__device__ __forceinline__ void g2_scan(unsigned char* gs, int p) {
    const int bh = p >> 14, rem = p & 16383, e = rem >> 6, d2 = (rem & 63) * 2;
    const float* LT = (const float*)(gs + GLA_LT); const float* DEC = (const float*)(gs + GLA_DEC); bf16_t* ST = (bf16_t*)(gs + GLA_ST);
    float s0 = 0.f, s1 = 0.f;
#pragma unroll 8
    for (int c = 0; c < 64; ++c) { const size_t u = (size_t)bh * 64 + c;
        *(unsigned*)(ST + (u * 256 + e) * 128 + d2) = cvt_pk_bf16(s0, s1);
        const f32x2 dc = *(const f32x2*)(DEC + u * 128 + d2), lv = *(const f32x2*)(LT + (u * 256 + e) * 128 + d2);
        s0 = dc.x * s0 + lv.x; s1 = dc.y * s1 + lv.y; }
}
__device__ __forceinline__ void g3_unit(LAS unsigned char* lds, const bf16_t* UN, unsigned char* gs, const float* ggla, bf16_t* MIX, int u, int tid, int wave, int lane) {
    const int c = u & 63, h = (u >> 6) & 3, b = u >> 8; const size_t tok0 = (size_t)b * SEQ + c * 64;
    LAS bf16_t* QT = (LAS bf16_t*)lds; LAS bf16_t* STs = (LAS bf16_t*)(lds + 17408); LAS float* OT = (LAS float*)lds;
    const bf16_t* QTg = (const bf16_t*)(gs + GLA_QT) + (size_t)u * 64 * 128; const bf16_t* ST = (const bf16_t*)(gs + GLA_ST) + (size_t)u * 256 * 128;
#pragma unroll
    for (int i = 0; i < 2; ++i) { const int id = tid + 512 * i, row = id >> 4, ch = id & 15; *(LAS u32x4*)(QT + row * PQ + ch * 8) = *(const u32x4*)(QTg + row * 128 + ch * 8); }
#pragma unroll
    for (int i = 0; i < 8; ++i) { const int id = tid + 512 * i, row = id >> 4, ch = id & 15; *(LAS u32x4*)(STs + row * PQ + ch * 8) = *(const u32x4*)(ST + row * 128 + ch * 8); }
    const int r = lane & 31, hh = lane >> 5;
    const float* OI = (const float*)(gs + GLA_OI) + (size_t)u * 64 * 256;
    f32x16 acc[2];
#pragma unroll
    for (int tb = 0; tb < 2; ++tb)
#pragma unroll
        for (int i = 0; i < 16; ++i) acc[tb][i] = OI[(size_t)(32 * tb + crow(i, hh)) * 256 + 32 * wave + r];
    WG_BAR();
#pragma unroll
    for (int tb = 0; tb < 2; ++tb) acc[tb] = mma_lds(QT + 32 * tb * PQ, PQ, STs + 32 * wave * PQ, PQ, 128, acc[tb], r, hh);
    WG_BAR();
#pragma unroll
    for (int tb = 0; tb < 2; ++tb)
#pragma unroll
        for (int i = 0; i < 16; ++i) OT[(32 * tb + crow(i, hh)) * 260 + 32 * wave + r] = acc[tb][i];
    WG_BAR();
    { const int t = tid >> 3, part = tid & 7; const LAS float* op = OT + t * 260 + part * 32; float v[32]; float ss = 0.f;
#pragma unroll
      for (int q = 0; q < 8; ++q) { const f32x4 x = *(const LAS f32x4*)(op + 4 * q); v[4 * q] = x[0]; v[4 * q + 1] = x[1]; v[4 * q + 2] = x[2]; v[4 * q + 3] = x[3]; ss += x[0] * x[0] + x[1] * x[1] + x[2] * x[2] + x[3] * x[3]; }
      ss += __shfl_xor(ss, 1); ss += __shfl_xor(ss, 2); ss += __shfl_xor(ss, 4);
      const float rs = rsqrtf(ss * (1.f / 256.f) + EPS);
      const bf16_t* gbp = UN + (tok0 + t) * UNW + UN_GB + h * 256 + part * 32; const float* gg = ggla + h * 256 + part * 32;
      bf16_t* mp = MIX + (tok0 + t) * D + 2048 + h * 256 + part * 32;
#pragma unroll
      for (int q = 0; q < 4; ++q) { const bf16x8 gv = *(const bf16x8*)(gbp + 8 * q); float o[8];
#pragma unroll
          for (int e = 0; e < 8; ++e) { const float g = bf2f((bf16_t)gv[e]); o[e] = v[8 * q + e] * rs * gg[8 * q + e] * (g / (1.f + __expf(-g))); }
          u32x4 w; w.x = cvt_pk_bf16(o[0], o[1]); w.y = cvt_pk_bf16(o[2], o[3]); w.z = cvt_pk_bf16(o[4], o[5]); w.w = cvt_pk_bf16(o[6], o[7]);
          *(u32x4*)(mp + 8 * q) = w; } }
    WG_BAR();
}
}

__device__ __forceinline__ void pool_unit(LAS unsigned char* lds, const bf16_t* UN, const bf16_t* WP, const float* pscale, bf16_t* MIX, int pu, int tid, int wave, int lane) {
    const int g = pu & 3, rb = pu >> 2, w = 2 << g; const size_t tok0 = (size_t)rb * 128;
    LAS bf16_t* DT = (LAS bf16_t*)lds; constexpr int PD = 264;
    { const int c = tid & 255, half = tid >> 8, tf = (int)(tok0 & (SEQ - 1)) + 64 * half;
      const bf16_t* up = UN + (tok0 + 64 * half) * UNW + UN_UC + g * 256 + c;
      float s = 0.f;
      for (int j = 1; j < w; ++j) if (tf - j >= 0) s += bf2f(up[-(ptrdiff_t)j * UNW]);
      for (int i = 0; i < 64; ++i) { const int t = tf + i; const float ut = bf2f(up[(size_t)i * UNW]);
          s += ut; const int cnt = (t + 1 < w) ? t + 1 : w;
          DT[(64 * half + i) * PD + c] = f2bf(s / (float)cnt - ut);
          if (t + 1 - w >= 0) s -= bf2f(up[(ptrdiff_t)(i + 1 - w) * UNW]); } }
    WG_BAR();
    const int r = lane & 31, hh = lane >> 5;
    f32x16 acc[4];
#pragma unroll
    for (int mb = 0; mb < 4; ++mb)
#pragma unroll
        for (int i = 0; i < 16; ++i) acc[mb][i] = 0.f;
    const bf16_t* bp = WP + (size_t)g * 65536 + (size_t)(32 * wave + r) * 256 + 8 * hh;
#pragma unroll 4
    for (int ks = 0; ks < 16; ++ks) { const bf16x8 bf = *(const bf16x8*)(bp + 16 * ks);
#pragma unroll
        for (int mb = 0; mb < 4; ++mb) acc[mb] = MFMA32(*(const LAS bf16x8*)(DT + (32 * mb + r) * PD + 16 * ks + 8 * hh), bf, acc[mb]); }
    const int n = 32 * wave + r; const float sc = pscale[g * 256 + n];
#pragma unroll
    for (int mb = 0; mb < 4; ++mb)
#pragma unroll
        for (int i = 0; i < 16; ++i) MIX[(tok0 + 32 * mb + crow(i, hh)) * D + 3072 + g * 256 + n] = f2bf(acc[mb][i] * sc);
    WG_BAR();
}

#define LDS_WAIT() asm volatile("s_waitcnt lgkmcnt(0)" ::: "memory")
#define VM_WAIT() asm volatile("s_waitcnt vmcnt(0)" ::: "memory")
__device__ __forceinline__ unsigned pk2(float lo, float hi) { return (unsigned)f2bf(lo) | ((unsigned)f2bf(hi) << 16); }

__device__ __forceinline__ void cvt_item(const float* __restrict__ W, int ldw, int srccol, int nvalid, bf16_t* __restrict__ Wt, int K, int dstrow, int k0, LAS float* scr, int lane, const float* gk = nullptr) {
    const int c = lane & 31;
#pragma unroll 8
    for (int i = 0; i < 32; ++i) { const int kk = 2 * i + (lane >> 5); scr[kk * 33 + c] = (c < nvalid) ? W[(size_t)(k0 + kk) * ldw + srccol + c] : 0.f; }
    LDS_WAIT(); asm volatile("" ::: "memory");
    const int c8 = lane & 7;
    f32x4 ga = {1.f, 1.f, 1.f, 1.f}, gb = {1.f, 1.f, 1.f, 1.f};
    if (gk) { ga = *(const f32x4*)(gk + k0 + 8 * c8); gb = *(const f32x4*)(gk + k0 + 8 * c8 + 4); }
#pragma unroll
    for (int j = 0; j < 4; ++j) { const int n = (lane >> 3) + 8 * j; const LAS float* s = scr + (8 * c8) * 33 + n;
        u32x4 o; o.x = pk2(s[0 * 33] * ga[0], s[1 * 33] * ga[1]); o.y = pk2(s[2 * 33] * ga[2], s[3 * 33] * ga[3]); o.z = pk2(s[4 * 33] * gb[0], s[5 * 33] * gb[1]); o.w = pk2(s[6 * 33] * gb[2], s[7 * 33] * gb[3]);
        *(u32x4*)(Wt + (size_t)(dstrow + n) * K + k0 + 8 * c8) = o; }
    LDS_WAIT(); asm volatile("" ::: "memory");
}
__device__ __forceinline__ int win_src_col(int d) {
    if (d < 2048) return d + (SRC_QA - 0);
    if (d < 4096) return d + (SRC_KA - 2048);
    if (d < 4608) return d + (SRC_QB - 4096);
    if (d < 5120) return d + (SRC_KB - 4608);
    if (d < 6144) return d + (SRC_GB - 5120);
    if (d < 7168) return d + (SRC_UC - 6144);
    if (d < 9216) return d + (SRC_VA - 7168);
    return d + (SRC_VB - 9216);
}
constexpr int I_IN = 64 * 320, I_Z = 64, I_O = 64 * 128, I_UP = 64 * 688, I_DN = 172 * 128, I_P = 128, I_LAYER = I_IN + I_Z + I_O + I_UP + I_DN + I_P;

__device__ __forceinline__ void res_row(const float* X, bf16_t* Hb, const bf16_t* Y, const float* gpost, float* RS, float* OUT, int row, int lane) {
    f32x4 hv[16];
    if (X) { const f32x4* src = (const f32x4*)(X + (size_t)row * D) + lane;
#pragma unroll
        for (int j = 0; j < 16; ++j) hv[j] = src[64 * j];
    } else { const u32x2* src = (const u32x2*)(Hb + (size_t)row * D) + lane;
#pragma unroll
        for (int j = 0; j < 16; ++j) { const u32x2 w = src[64 * j]; hv[j] = (f32x4){__uint_as_float(w.x << 16), __uint_as_float(w.x & 0xffff0000u), __uint_as_float(w.y << 16), __uint_as_float(w.y & 0xffff0000u)}; } }
    if (Y) {
        const u32x2* yp = (const u32x2*)(Y + (size_t)row * D) + lane;
        f32x4 yv[16]; float s = 0.f;
#pragma unroll
        for (int j = 0; j < 16; ++j) { const u32x2 w = yp[64 * j]; yv[j] = (f32x4){__uint_as_float(w.x << 16), __uint_as_float(w.x & 0xffff0000u), __uint_as_float(w.y << 16), __uint_as_float(w.y & 0xffff0000u)}; s += yv[j].x * yv[j].x + yv[j].y * yv[j].y + yv[j].z * yv[j].z + yv[j].w * yv[j].w; }
        const float rs = rsqrtf(wave_sum(s) * (1.f / D) + EPS);
#pragma unroll
        for (int j = 0; j < 16; ++j) { const f32x4 g = ((const f32x4*)gpost)[lane + 64 * j]; hv[j] += yv[j] * rs * g; }
    }
    if (OUT) {
        f32x4* hp = (f32x4*)(OUT + (size_t)row * D) + lane;
#pragma unroll
        for (int j = 0; j < 16; ++j) hp[64 * j] = hv[j];
    } else {
        float s = 0.f;
#pragma unroll
        for (int j = 0; j < 16; ++j) s += hv[j].x * hv[j].x + hv[j].y * hv[j].y + hv[j].z * hv[j].z + hv[j].w * hv[j].w;
        const float rs = rsqrtf(wave_sum(s) * (1.f / D) + EPS);
        if (lane == 0) RS[row] = rs;
        u32x2* op = (u32x2*)(Hb + (size_t)row * D) + lane;
#pragma unroll
        for (int j = 0; j < 16; ++j) { u32x2 o; o.x = cvt_pk_bf16(hv[j].x, hv[j].y); o.y = cvt_pk_bf16(hv[j].z, hv[j].w); op[64 * j] = o; }
    }
}

__device__ __forceinline__ void zlr_rows(const bf16_t* HN, const bf16_t* WZ, const float* RS, float* ZLR, int rb, LAS unsigned char* lds, int tid, int wave, int lane) {
    const int r = lane & 31, h = lane >> 5;
    f32x16 acc;
#pragma unroll
    for (int e = 0; e < 16; ++e) acc[e] = 0.f;
    const bf16_t* ap = HN + (size_t)(rb * 32 + r) * D + wave * 512 + 8 * h;
    const bf16_t* bp = WZ + (size_t)r * D + wave * 512 + 8 * h;
#pragma unroll 8
    for (int k = 0; k < 512; k += 16) acc = __builtin_amdgcn_mfma_f32_32x32x16_bf16(*(const bf16x8*)(ap + k), *(const bf16x8*)(bp + k), acc, 0, 0, 0);
    LAS float* red = (LAS float*)lds;
    if (r < 16) {
#pragma unroll
        for (int e = 0; e < 16; ++e) red[(wave * 32 + (e & 3) + 8 * (e >> 2) + 4 * h) * 16 + r] = acc[e];
    }
    __syncthreads();
    { const int row = tid >> 4, n = tid & 15; float s = 0.f;
#pragma unroll
      for (int w = 0; w < 8; ++w) s += red[(w * 32 + row) * 16 + n];
      ZLR[(size_t)(rb * 32 + row) * 16 + n] = s * RS[rb * 32 + row]; }
    __syncthreads();
}


__device__ __forceinline__ void fix_rows(const float* ZB, const float* wc, const float* bc, bf16_t* F, int it) {
    const int c4 = it % (DFF / 4), rest = it / (DFF / 4), rr = rest & 1, ti = rest >> 1, pm = ti + 1 + ti / 15, c0 = c4 * 4;
    const float* zb = ZB + (size_t)pm * 4 * NUP; const float* zp = zb - (size_t)4 * NUP;
    const float* r0 = zb + (size_t)rr * NUP; const float* r1 = rr ? zb : zp + (size_t)3 * NUP; const float* r2 = rr ? zp + (size_t)3 * NUP : zp + (size_t)2 * NUP;
    const f32x4 g0 = *(const f32x4*)(r0 + c0), g1 = *(const f32x4*)(r1 + c0), g2 = *(const f32x4*)(r2 + c0), v0 = *(const f32x4*)(r0 + DFF + c0), v1 = *(const f32x4*)(r1 + DFF + c0), v2 = *(const f32x4*)(r2 + DFF + c0);
    const f32x4 wg0 = *(const f32x4*)(wc + c0), wg1 = *(const f32x4*)(wc + NUP + c0), wg2 = *(const f32x4*)(wc + 2 * NUP + c0), wv0 = *(const f32x4*)(wc + DFF + c0), wv1 = *(const f32x4*)(wc + NUP + DFF + c0), wv2 = *(const f32x4*)(wc + 2 * NUP + DFF + c0);
    const f32x4 gt = *(const f32x4*)(bc + c0) + wg0 * g2 + wg1 * g1 + wg2 * g0, vl = *(const f32x4*)(bc + DFF + c0) + wv0 * v2 + wv1 * v1 + wv2 * v0;
    u32x2 w; w.x = cvt_pk_bf16(pg8::gelu_tanh_e(gt[0]) * vl[0], pg8::gelu_tanh_e(gt[1]) * vl[1]); w.y = cvt_pk_bf16(pg8::gelu_tanh_e(gt[2]) * vl[2], pg8::gelu_tanh_e(gt[3]) * vl[3]);
    *(u32x2*)(F + (size_t)(pm * 256 + rr) * DFF + c0) = w;
}
__device__ __forceinline__ void knorm_rows(const bf16_t* UN, unsigned* KMAX, int rb, LAS unsigned char* lds, int tid) {
    const int row = tid >> 4, hm = tid & 15; const size_t tok = (size_t)rb * 32 + row;
    const bf16_t* kp = UN + tok * UNW + UN_KA + hm * 128; float s = 0.f;
#pragma unroll
    for (int c = 0; c < 16; ++c) { const bf16x8 v = *(const bf16x8*)(kp + 8 * c);
#pragma unroll
        for (int e = 0; e < 8; ++e) { const float x = bf2f((bf16_t)v[e]); s += x * x; } }
    LAS float* red = (LAS float*)lds;
    red[hm * 33 + row] = sqrtf(s);
    __syncthreads();
    if (tid < 16) { float m = 0.f;
#pragma unroll
        for (int r2 = 0; r2 < 32; ++r2) m = fmaxf(m, red[tid * 33 + r2]);
        const int b = (int)(((size_t)rb * 32) >> 12), tile = (int)((((size_t)rb * 32) & (SEQ - 1)) >> 6);
        __hip_atomic_fetch_max(KMAX + (b * 16 + tid) * 64 + tile, __float_as_uint(m), __ATOMIC_RELAXED, __HIP_MEMORY_SCOPE_AGENT); }
    __syncthreads();
}
__device__ __forceinline__ float gelu_tanh_fast(float x) { const float u = 1.5957691216057308f * (x + 0.044715f * x * x * x); return x / (1.f + __expf(-u)); }
__device__ __forceinline__ void conv_run(const bf16_t* Z, const float* wc, const float* bc, bf16_t* F, int run, int tid) {
    const size_t t0 = (size_t)run * 32; const bool first = ((run * 32) & (SEQ - 1)) == 0;
    for (int oc = tid; oc < DFF / 8; oc += 512) {
        const int c0 = oc * 8;
        float wg[3][8], wv[3][8], bg[8], bv[8];
#pragma unroll
        for (int j = 0; j < 3; ++j)
#pragma unroll
            for (int q = 0; q < 2; ++q) { const f32x4 a = *(const f32x4*)(wc + (size_t)j * NUP + c0 + 4 * q), b = *(const f32x4*)(wc + (size_t)j * NUP + DFF + c0 + 4 * q);
#pragma unroll
                for (int e = 0; e < 4; ++e) { wg[j][4 * q + e] = a[e]; wv[j][4 * q + e] = b[e]; } }
#pragma unroll
        for (int q = 0; q < 2; ++q) { const f32x4 a = *(const f32x4*)(bc + c0 + 4 * q), b = *(const f32x4*)(bc + DFF + c0 + 4 * q);
#pragma unroll
            for (int e = 0; e < 4; ++e) { bg[4 * q + e] = a[e]; bv[4 * q + e] = b[e]; } }
        float g2[8], g1[8], v2[8], v1[8];
        if (first) {
#pragma unroll
            for (int e = 0; e < 8; ++e) { g2[e] = 0.f; g1[e] = 0.f; v2[e] = 0.f; v1[e] = 0.f; }
        } else {
            const bf16x8 a2 = *(const bf16x8*)(Z + (t0 - 2) * NUP + c0), a1 = *(const bf16x8*)(Z + (t0 - 1) * NUP + c0), b2 = *(const bf16x8*)(Z + (t0 - 2) * NUP + DFF + c0), b1 = *(const bf16x8*)(Z + (t0 - 1) * NUP + DFF + c0);
#pragma unroll
            for (int e = 0; e < 8; ++e) { g2[e] = bf2f((bf16_t)a2[e]); g1[e] = bf2f((bf16_t)a1[e]); v2[e] = bf2f((bf16_t)b2[e]); v1[e] = bf2f((bf16_t)b1[e]); }
        }
#pragma unroll 4
        for (int r = 0; r < 32; ++r) {
            const bf16x8 a0 = *(const bf16x8*)(Z + (t0 + r) * NUP + c0), b0 = *(const bf16x8*)(Z + (t0 + r) * NUP + DFF + c0);
            float o[8];
#pragma unroll
            for (int e = 0; e < 8; ++e) { const float g0 = bf2f((bf16_t)a0[e]), v0 = bf2f((bf16_t)b0[e]);
                const float gt = bg[e] + wg[0][e] * g2[e] + wg[1][e] * g1[e] + wg[2][e] * g0, vl = bv[e] + wv[0][e] * v2[e] + wv[1][e] * v1[e] + wv[2][e] * v0;
                o[e] = gelu_tanh_fast(gt) * vl; g2[e] = g1[e]; g1[e] = g0; v2[e] = v1[e]; v1[e] = v0; }
            u32x4 w; w.x = cvt_pk_bf16(o[0], o[1]); w.y = cvt_pk_bf16(o[2], o[3]); w.z = cvt_pk_bf16(o[4], o[5]); w.w = cvt_pk_bf16(o[6], o[7]);
            *(u32x4*)(F + (t0 + r) * DFF + c0) = w;
        }
    }
}

constexpr int NPH = 21;
struct Args { const float* in[21]; float* out; unsigned char* ws; int ph_lo, ph_hi; };

__device__ __forceinline__ const void* lds_ptr(volatile LAS unsigned* A, int i) {
    const unsigned lo = __builtin_amdgcn_readfirstlane(A[2 * i]), hi = __builtin_amdgcn_readfirstlane(A[2 * i + 1]);
    return (const void*)(const GAS void*)(((unsigned long long)hi << 32) | (unsigned long long)lo);
}
constexpr int ARGS_OFF = RING_BYTES + 1024;
#define FRESH_TID() int tid = threadIdx.x; asm volatile("" : "+v"(tid)); const int lane = tid & 63
#define P(i) ((const float*)lds_ptr(AP, (i)))
#define WSP() ((unsigned char*)lds_ptr(AP, 22))
#define IN(k) (lo <= (k) && (k) < hi)
#define BOTH(k) (IN(k) && IN((k) + 1))
#define GRID_BAR(k) do { if (BOTH(k)) { XcdBarrier b_; b_.bar = (unsigned*)(WSP() + WS_CTL) + CW_BAR; b_.x = xb_xcc_id(); b_.st = MISC + 8; xcd_barrier(b_); } } while (0)
#define REP(k) _Pragma("unroll") for (int rep_ = 0; rep_ < ((k) == MK_DOUBLE_PHASE ? 2 : 1); ++rep_)
template <int l, int LO, int HI> __device__ __forceinline__ void layer_phases(LAS unsigned char* lds, volatile LAS unsigned* MISC, volatile LAS unsigned* AP, const int wave, const int G, const int bx, const int vcu, const int gw, const int NGW) {
    constexpr int lo = LO, hi = HI;

        const int pb = 1 + 10 * l;
        if (IN(pb + 0)) REP(pb + 0) {
            unsigned char* ws = WSP(); unsigned char* wl = ws + WS_W0 + (size_t)l * W_LAYER;
            const bf16_t* HN = (const bf16_t*)(ws + WS_HN);
            { pg8::Gemm g; g.A[0] = HN; g.Bt[0] = (const bf16_t*)(wl + OFF_WN); g.A[1] = (const bf16_t*)(wl + OFF_WT); g.Bt[1] = HN; g.lda = D; g.ldb = D; g.K = D;
              pg8::Order2 S; S.nM0 = M / 256; S.nN0 = UNW / 256; S.nM1 = UTW / 256; S.nN1 = M / 256; S.G = G; S.c = bx;
              pg8::EpiBf16 E; E.O[0] = (bf16_t*)(ws + WS_UN); E.ldc[0] = UNW; E.O[1] = (bf16_t*)(ws + WS_UT); E.ldc[1] = M; E.rs = (const float*)(ws + WS_RS);
              pg8::gemm_phase<pg8::EpiBf16, pg8::Order2, PG8_ALIGN, PG8_SP2>(lds, g, S, E); }
            FRESH_TID();
            for (int rb = bx; rb < M / 32; rb += G) zlr_rows(HN, (const bf16_t*)(wl + OFF_WZ), (const float*)(ws + WS_RS), (float*)(ws + WS_ZLR), rb, lds, tid, wave, lane);
            for (int rb = bx; rb < M / 32; rb += G) knorm_rows((const bf16_t*)(ws + WS_UN), (unsigned*)(ws + WS_CTL) + CW_KMAX + l * 2048, rb, lds, tid);
            GRID_BAR(pb + 0);
        }
        if (IN(pb + 1)) REP(pb + 1) {
            FRESH_TID();
            unsigned char* ws = WSP(); unsigned char* gs = ws + WS_GLA;
            const bf16_t* UN = (const bf16_t*)(ws + WS_UN); const bf16_t* UT = (const bf16_t*)(ws + WS_UT); bf16_t* MIX = (bf16_t*)(ws + WS_MIX);
            { const float* w2 = P(2) + (size_t)l * 16 * 512; const float* bgt = P(3) + (size_t)l * 512; const float* ZLR = (const float*)(ws + WS_ZLR);
              FRESH_TID();
              for (int u = vcu; u < 512; u += G) gla::g1_unit(lds, UN, UT, ZLR, w2, bgt, gs, u, tid, wave, lane); }
            { const bf16_t* WP = (const bf16_t*)(ws + WS_W0 + (size_t)l * W_LAYER + OFF_WP); const float* psc = P(11) + (size_t)l * 1024;
              FRESH_TID();
              for (int pu = vcu; pu < 256; pu += G) pool_unit(lds, UN, WP, psc, MIX, pu, tid, wave, lane); }
            { const float lam_init = 0.8f - 0.6f * expf(-0.3f * (float)l);
              float lam = lam_of(P(4) + l * 128, P(5) + l * 128, P(6) + l * 128, P(7) + l * 128, lane, lam_init);
              lam = __uint_as_float(__builtin_amdgcn_readfirstlane(__float_as_uint(lam)));
              const float* gsub = P(8) + l * 256;
              FRESH_TID();
              unsigned* ctl = (unsigned*)(ws + WS_CTL);
              for (;;) {
                  if (tid == 0) MISC[16] = __hip_atomic_fetch_add(ctl + CW_QUEUE + l * 64, 1u, __ATOMIC_RELAXED, __HIP_MEMORY_SCOPE_AGENT);
                  __syncthreads();
                  const int idx = __builtin_amdgcn_readfirstlane((int)MISC[16]);
                  __syncthreads();
                  if (idx >= 512) break;
                  att::unit(lds, UN, UT, MIX, ctl + CW_KMAX + l * 2048, idx & 1, 7 - ((idx >> 1) & 7), 31 - (idx >> 4), lam, gsub, 1.f - lam_init, wave, lane); } }
            GRID_BAR(pb + 1);
        }
        if (IN(pb + 2)) REP(pb + 2) {
            FRESH_TID();
            unsigned char* gs = WSP() + WS_GLA;
            for (int p = vcu * 512 + tid; p < 131072; p += G * 512) gla::g2_scan(gs, p);
            GRID_BAR(pb + 2);
        }
        if (IN(pb + 3)) REP(pb + 3) {
            FRESH_TID();
            unsigned char* ws = WSP(); unsigned char* gs = ws + WS_GLA; const float* gg = P(9) + (size_t)l * 1024;
            for (int u = vcu; u < 512; u += G) gla::g3_unit(lds, (const bf16_t*)(ws + WS_UN), gs, gg, (bf16_t*)(ws + WS_MIX), u, tid, wave, lane);
            GRID_BAR(pb + 3);
        }
        if (IN(pb + 4)) REP(pb + 4) {
            unsigned char* ws = WSP(); unsigned char* wl = ws + WS_W0 + (size_t)l * W_LAYER;
            pg8::Gemm g; g.A[0] = (const bf16_t*)(ws + WS_MIX); g.Bt[0] = (const bf16_t*)(wl + OFF_WO); g.A[1] = g.A[0]; g.Bt[1] = g.Bt[0]; g.lda = D; g.ldb = D; g.K = D;
            pg8::Order2 S; S.nM0 = M / 256; S.nN0 = D / 256; S.nM1 = 0; S.nN1 = 1; S.G = G; S.c = bx;
            pg8::EpiBf16 E; E.O[0] = (bf16_t*)(ws + WS_Y); E.ldc[0] = D; E.O[1] = E.O[0]; E.ldc[1] = D; E.rs = nullptr;
            pg8::gemm_phase<pg8::EpiBf16, pg8::Order2, PG8_ALIGN, PG8_SP2>(lds, g, S, E);
            GRID_BAR(pb + 4);
        }
        if (IN(pb + 5)) {
            FRESH_TID();
            unsigned char* ws = WSP(); const bf16_t* Y = (const bf16_t*)(ws + WS_Y); const float* gp = P(18) + (size_t)l * D; bf16_t* HN = (bf16_t*)(ws + WS_HN); float* RS = (float*)(ws + WS_RS);
            for (int m = gw; m < M; m += NGW) res_row(nullptr, HN, Y, gp, RS, nullptr, m, lane);
            GRID_BAR(pb + 5);
        }
        if (IN(pb + 6)) REP(pb + 6) {
            unsigned char* ws = WSP(); unsigned char* wl = ws + WS_W0 + (size_t)l * W_LAYER;
            pg8::Gemm g; g.A[0] = (const bf16_t*)(ws + WS_HN); g.Bt[0] = (const bf16_t*)(wl + OFF_WUP); g.A[1] = g.A[0]; g.Bt[1] = g.Bt[0]; g.lda = D; g.ldb = D; g.K = D;
            pg8::Order2 S; S.nM0 = M / 256; S.nN0 = NUP / 256; S.nM1 = 0; S.nN1 = 1; S.G = G; S.c = bx;
            pg8::EpiConvGlu E; E.F = (bf16_t*)(ws + WS_F); E.ZB = (float*)(ws + WS_ZB); E.wcv = P(14) + (size_t)l * 3 * NUP; E.bcv = P(15) + (size_t)l * NUP; E.rs = (const float*)(ws + WS_RS); E.halo = lds + 131072;
            pg8::gemm_phase<pg8::EpiConvGlu, pg8::Order2, PG8_ALIGN, PG8_SP2>(lds, g, S, E);
            GRID_BAR(pb + 6);
        }
        if (IN(pb + 7)) REP(pb + 7) {
            FRESH_TID();
            unsigned char* ws = WSP(); const float* wc = P(14) + (size_t)l * 3 * NUP; const float* bc = P(15) + (size_t)l * NUP;
            for (int it = vcu * 512 + tid; it < 30 * 2 * (DFF / 4); it += G * 512) fix_rows((const float*)(ws + WS_ZB), wc, bc, (bf16_t*)(ws + WS_F), it);
            GRID_BAR(pb + 7);
        }
        if (IN(pb + 8)) REP(pb + 8) {
            unsigned char* ws = WSP(); unsigned char* wl = ws + WS_W0 + (size_t)l * W_LAYER;
            pg8::Gemm g; g.A[0] = (const bf16_t*)(ws + WS_F); g.Bt[0] = (const bf16_t*)(wl + OFF_WDN); g.A[1] = g.A[0]; g.Bt[1] = g.Bt[0]; g.lda = DFF; g.ldb = DFF; g.K = DFF;
            pg8::Order2 S; S.nM0 = M / 256; S.nN0 = D / 256; S.nM1 = 0; S.nN1 = 1; S.G = G; S.c = bx;
            pg8::EpiBf16 E; E.O[0] = (bf16_t*)(ws + WS_Y); E.ldc[0] = D; E.O[1] = E.O[0]; E.ldc[1] = D; E.rs = nullptr;
            pg8::gemm_phase<pg8::EpiBf16, pg8::Order2, PG8_ALIGN, PG8_SP2>(lds, g, S, E);
            GRID_BAR(pb + 8);
        }
        if (IN(pb + 9)) {
            FRESH_TID();
            unsigned char* ws = WSP(); const bf16_t* Y = (const bf16_t*)(ws + WS_Y); const float* gp = P(20) + (size_t)l * D; bf16_t* HN = (bf16_t*)(ws + WS_HN); float* RS = (float*)(ws + WS_RS);
            float* OUT = l + 1 < DEPTH ? nullptr : (float*)P(21);
            for (int m = gw; m < M; m += NGW) res_row(nullptr, HN, Y, gp, RS, OUT, m, lane);
            GRID_BAR(pb + 9);
        }
    }
template <int LO, int HI> __global__ void __launch_bounds__(512, 2) fwd(Args args) {
    extern __shared__ __attribute__((aligned(16))) unsigned char lds_raw[];
    LAS unsigned char* lds = (LAS unsigned char*)lds_raw;
    volatile LAS unsigned* MISC = (volatile LAS unsigned*)(lds + MISC_OFF);
    volatile LAS unsigned* AP = (volatile LAS unsigned*)(lds + ARGS_OFF);
    const int wave = __builtin_amdgcn_readfirstlane((int)threadIdx.x >> 6);
    const int G = gridDim.x; const int bx = blockIdx.x; const int vcu = (G % 8 == 0) ? (bx % 8) * (G / 8) + bx / 8 : bx;
    constexpr int lo = LO, hi = HI;
    for (int u = threadIdx.x; u < (LDS_BYTES - LDSCTL_OFF) / 4; u += 512) ((LAS unsigned*)(lds + LDSCTL_OFF))[u] = 0u;
    __syncthreads();
    if (threadIdx.x == 0) {
        volatile LAS unsigned long long* A8 = (volatile LAS unsigned long long*)(lds + ARGS_OFF);
#pragma unroll
        for (int i = 0; i < 21; ++i) A8[i] = (unsigned long long)args.in[i];
        A8[21] = (unsigned long long)args.out; A8[22] = (unsigned long long)args.ws;
    }
    __syncthreads();
    if (hi - lo > 1) (void)xcd_barrier_post((unsigned*)(WSP() + WS_CTL) + CW_BAR, MISC + 8);
    const int gw = vcu * 8 + wave, NGW = G * 8;

    if (IN(0)) REP(0) {
        FRESH_TID();
        unsigned char* ws = WSP();
        LAS float* scr = (LAS float*)(lds + wave * 16384);
        for (int it = gw; it < 2 * I_LAYER; it += NGW) {
            const int l = it >= I_LAYER ? 1 : 0; int r = it - l * I_LAYER;
            unsigned char* wl = ws + WS_W0 + (size_t)l * W_LAYER;
            if (r < I_IN) { const int kb = r / 320, nb = r % 320, d0 = nb * 32; cvt_item(P(1) + (size_t)l * D * NIN, NIN, win_src_col(d0), 32, (bf16_t*)(wl + OFF_WN), D, d0, kb * 64, scr, lane, P(17) + (size_t)l * D); continue; } r -= I_IN;
            if (r < I_Z) { cvt_item(P(1) + (size_t)l * D * NIN, NIN, SRC_ZLR, 16, (bf16_t*)(wl + OFF_WZ), D, 0, r * 64, scr, lane, P(17) + (size_t)l * D); continue; } r -= I_Z;
            if (r < I_O) { const int kb = r / 128, nb = r % 128; cvt_item(P(12) + (size_t)l * D * D, D, nb * 32, 32, (bf16_t*)(wl + OFF_WO), D, nb * 32, kb * 64, scr, lane); continue; } r -= I_O;
            if (r < I_UP) { const int kb = r / 688, nb = r % 688, d0 = nb * 32, src = ((d0 >> 7) & 1) * DFF + 128 * (d0 >> 8) + (d0 & 127);
                cvt_item(P(13) + (size_t)l * D * NUP, NUP, src, 32, (bf16_t*)(wl + OFF_WUP), D, d0, kb * 64, scr, lane, P(19) + (size_t)l * D); continue; } r -= I_UP;
            if (r < I_DN) { const int kb = r / 128, nb = r % 128; cvt_item(P(16) + (size_t)l * DFF * D, D, nb * 32, 32, (bf16_t*)(wl + OFF_WDN), DFF, nb * 32, kb * 64, scr, lane); continue; } r -= I_DN;
            { const int g = r >> 5, kb = (r >> 3) & 3, nb = r & 7; cvt_item(P(10) + ((size_t)l * 4 + g) * 65536, 256, nb * 32, 32, (bf16_t*)(wl + OFF_WP) + (size_t)g * 65536, 256, nb * 32, kb * 64, scr, lane); }
        }
        { const float* x = P(0); bf16_t* HN = (bf16_t*)(ws + WS_HN); float* RS = (float*)(ws + WS_RS);
          for (int m = gw; m < M; m += NGW) res_row(x, HN, nullptr, nullptr, RS, nullptr, m, lane); }
        GRID_BAR(0);
    }

    layer_phases<0, LO, HI>(lds, MISC, AP, wave, G, bx, vcu, gw, NGW);
    layer_phases<1, LO, HI>(lds, MISC, AP, wave, G, bx, vcu, gw, NGW);
}

static int g_grid = 0;
template <int LO, int HI> static void launch_range(hipStream_t stream, const Args& a) {
    static bool attr = false;
    if (!attr) { if (hipFuncSetAttribute((const void*)fwd<LO, HI>, hipFuncAttributeMaxDynamicSharedMemorySize, LDS_BYTES) != hipSuccess) fprintf(stderr, "kernel_launch: hipFuncSetAttribute failed\n"); attr = true; }
    hipLaunchKernelGGL((fwd<LO, HI>), dim3(g_grid), dim3(512), LDS_BYTES, stream, a);
    const hipError_t le = hipPeekAtLastError();
    if (le != hipSuccess) fprintf(stderr, "kernel_launch: fwd launch [%d,%d) failed: %s\n", LO, HI, hipGetErrorName(le));
}
template <int P> static void launch_each(hipStream_t stream, const Args& a) { if constexpr (P < NPH) { launch_range<P, P + 1>(stream, a); launch_each<P + 1>(stream, a); } }
extern "C" void kernel_launch(void* const* d_in, const int* in_sizes, int n_in, void* d_out, int out_size, void* d_ws, size_t ws_size, hipStream_t stream) {
    if (n_in != 21 || ws_size < WS_END) { fprintf(stderr, "kernel_launch: unexpected n_in %d or ws %zu < %zu\n", n_in, ws_size, (size_t)WS_END); return; }
    if (g_grid == 0) {
        int dev = 0, cus = 0;
        if (hipGetDevice(&dev) != hipSuccess || hipDeviceGetAttribute(&cus, hipDeviceAttributeMultiprocessorCount, dev) != hipSuccess) { fprintf(stderr, "kernel_launch: device query failed\n"); g_grid = -1; return; }
        g_grid = cus;
    }
    if (g_grid < 0) return;
    (void)hipMemsetAsync((char*)d_ws + WS_CTL, 0, CTL_ZERO_BYTES, stream);
    Args a{};
    for (int i = 0; i < 21; ++i) a.in[i] = (const float*)d_in[i];
    a.out = (float*)d_out; a.ws = (unsigned char*)d_ws;
#if MK_ONE_LAUNCH
    launch_range<0, NPH>(stream, a);
#else
    launch_each<0>(stream, a);
#endif
}
```

```cpp
#include <hip/hip_runtime.h>
#include <stdint.h>
#include <stdio.h>

typedef unsigned short bf16_t;
typedef short bf16x8 __attribute__((ext_vector_type(8)));
typedef float f32x4 __attribute__((ext_vector_type(4)));
typedef float f32x16 __attribute__((ext_vector_type(16)));

constexpr int D = 4096, SEQ = 4096, M = 8192, DEPTH = 2;
constexpr int NIN = 10256, DFF = 11008, NUP = 22016;
constexpr int UNW = 7168, UTW = 3072;
constexpr float EPS = 1e-6f;
constexpr int UN_QA = 0, UN_KA = 2048, UN_QB = 4096, UN_KB = 4608, UN_GB = 5120, UN_UC = 6144;
constexpr int SRC_QA = 0, SRC_KA = 2048, SRC_VA = 4096, SRC_QB = 6144, SRC_KB = 6656, SRC_VB = 7168, SRC_GB = 8192, SRC_ZLR = 9216, SRC_UC = 9232;

constexpr size_t MiB = 1u << 20;
constexpr size_t WS_CTL = 0;
constexpr size_t WS_W0 = 1 * MiB;
constexpr size_t OFF_WN = 0, OFF_WT = 56 * MiB, OFF_WO = 80 * MiB, OFF_WUP = 112 * MiB, OFF_WDN = 284 * MiB, OFF_WP = 370 * MiB, W_LAYER = 371 * MiB;
constexpr size_t WS_HN = WS_W0 + 2 * W_LAYER;
constexpr size_t WS_UN = WS_HN + 64 * MiB;
constexpr size_t WS_UT = WS_UN + 112 * MiB;
constexpr size_t WS_ZLR = WS_UT + 48 * MiB;
constexpr size_t WS_MIX = WS_ZLR + 1 * MiB;
constexpr size_t WS_Y = WS_MIX + 64 * MiB;
constexpr size_t WS_Z = WS_Y + 128 * MiB;
constexpr size_t WS_F = WS_Z + 344 * MiB;
constexpr size_t WS_DP = WS_F + 172 * MiB;
constexpr size_t WS_END = WS_DP + 16 * MiB;

__device__ __forceinline__ bf16_t f2bf(float f) { unsigned u = __float_as_uint(f); u += 0x7fffu + ((u >> 16) & 1u); return (bf16_t)(u >> 16); }
__device__ __forceinline__ float bf2f(bf16_t b) { return __uint_as_float(((unsigned)b) << 16); }
#ifndef MK_ONE_LAUNCH
#define MK_ONE_LAUNCH 1
#endif
#ifndef MK_DOUBLE_PHASE
#define MK_DOUBLE_PHASE (-1)
#endif
#ifndef MK_SHADOW
#define MK_SHADOW 0
#endif

#define LAS __attribute__((address_space(3)))
#define GAS __attribute__((address_space(1)))
typedef unsigned u32x4 __attribute__((ext_vector_type(4)));
typedef unsigned u32x2 __attribute__((ext_vector_type(2)));
typedef float f32x2 __attribute__((ext_vector_type(2)));
typedef GAS unsigned gu32;
#define RLX_AGENT __ATOMIC_RELAXED, __HIP_MEMORY_SCOPE_AGENT
constexpr size_t WS_RS = WS_DP + 12 * MiB;
constexpr size_t WS_ZB = WS_DP;
constexpr size_t OFF_WZ = 370 * MiB + 512 * 1024;
constexpr int RING_BYTES = 141312, LDSCTL_OFF = RING_BYTES, MISC_OFF = LDSCTL_OFF + 320, LDS_BYTES = 147456;
constexpr int CW_BAR = 4096, CW_KMAX = 8192, CW_QUEUE = 12288;
constexpr int CW_CNT = 16384;
constexpr size_t CTL_SS = 128 * 1024;
constexpr size_t CTL_ZERO_BYTES = 128 * 1024;
constexpr size_t WS_X = WS_Z + 160 * MiB;

__device__ __forceinline__ int fresh_lane() { unsigned z = 0u; asm volatile("" : "+s"(z)); return (int)__builtin_amdgcn_mbcnt_hi(~0u, __builtin_amdgcn_mbcnt_lo(~0u, z)); }
__device__ __forceinline__ float shfl_xor_l(float v, int m, int lane) { return __int_as_float(__builtin_amdgcn_ds_bpermute((lane ^ m) << 2, __float_as_int(v))); }
__device__ __forceinline__ float wave_sum_l(float v, int lane) {
#pragma unroll
    for (int o = 1; o < 64; o <<= 1) v += shfl_xor_l(v, o, lane);
    return v;
}
__device__ __forceinline__ unsigned cvt_pk_bf16(float lo, float hi) { unsigned r; asm volatile("v_cvt_pk_bf16_f32 %0, %1, %2" : "=v"(r) : "v"(lo), "v"(hi)); return r; }

#define XB_TMO      128
#define XB_XCNT(j)  (256  + 64 * (j))
#define XB_XSUB(j)  (1280 + 64 * (j))
#define XB_XGEN(j)  (2304 + 64 * (j))
#define XB_TOP      3328
#define XB_TOPGEN   3392
#define XCD_BAR_WORDS 3456
#define XB_SPIN_CAP (1u << 18)
__device__ __forceinline__ unsigned xb_ld(unsigned* p)              { return __hip_atomic_load(p, __ATOMIC_RELAXED, __HIP_MEMORY_SCOPE_AGENT); }
__device__ __forceinline__ unsigned xb_add(unsigned* p, unsigned v) { return __hip_atomic_fetch_add(p, v, __ATOMIC_RELAXED, __HIP_MEMORY_SCOPE_AGENT); }
__device__ __forceinline__ unsigned xb_xcc_id() { return (unsigned)__builtin_amdgcn_s_getreg((3 << 11) | 20) & 0xFu; }
#define XB_SPIN(cond, bar) do { unsigned _sp = 0; while (cond) { __builtin_amdgcn_s_sleep(1); \
    if ((++_sp & 255u) == 0u) { if (xb_ld(&(bar)[XB_TMO])) break; if (_sp > XB_SPIN_CAP) { atomicAdd(&(bar)[XB_TMO], 1u); break; } } } } while (0)
struct XcdBarrier { unsigned* bar; unsigned x; volatile LAS unsigned* st; int wave; };
__device__ __forceinline__ XcdBarrier xcd_barrier_post(unsigned* bar, volatile LAS unsigned* st) {
    XcdBarrier b; b.bar = bar; b.x = xb_xcc_id(); b.st = st;
    if (threadIdx.x == 0) (void)xb_add(&bar[XB_XCNT(b.x)], 1u);
    return b;
}
__device__ __forceinline__ void xcd_barrier_complete(unsigned* bar, unsigned x, unsigned& nloc, unsigned& nx) {
    const unsigned G = gridDim.x * gridDim.y * gridDim.z;
    unsigned sum, cnt, mine, sp = 0u;
    for (;;) {
        sum = 0u; cnt = 0u; mine = 0u;
#pragma unroll
        for (unsigned j = 0; j < 16; ++j) { const unsigned c = xb_ld(&bar[XB_XCNT(j)]); sum += c; cnt += (c > 0u) ? 1u : 0u; mine = (j == x) ? c : mine; }
        if (sum == G) break;
        __builtin_amdgcn_s_sleep(1);
        if ((++sp & 255u) == 0u) { if (xb_ld(&bar[XB_TMO])) break; if (sp > XB_SPIN_CAP) { atomicAdd(&bar[XB_TMO], 1u); break; } }
    }
    nloc = mine > 0u ? mine : 1u; nx = cnt > 0u ? cnt : 1u;
}
__device__ __forceinline__ void xcd_barrier(const XcdBarrier& b) {
    asm volatile("s_waitcnt vmcnt(0)" ::: "memory");
    __syncthreads();
    if (b.wave == 0 && fresh_lane() == 0) {
        unsigned* bar = b.bar;
        __builtin_amdgcn_s_waitcnt(0);
        unsigned nloc = b.st[0], nx = b.st[1];
        if (nloc == 0u) { xcd_barrier_complete(bar, b.x, nloc, nx); b.st[0] = nloc; b.st[1] = nx; }
        const unsigned old = xb_add(&bar[XB_XSUB(b.x)], 1u);
        const unsigned gen = old / nloc;
        if (old + 1u == (gen + 1u) * nloc) {
            __builtin_amdgcn_fence(__ATOMIC_RELEASE, "agent");
            asm volatile("s_waitcnt vmcnt(0)" ::: "memory");
            const unsigned og = xb_add(&bar[XB_TOP], 1u);
            const unsigned tg = og / nx;
            if (og + 1u == (tg + 1u) * nx) xb_add(&bar[XB_TOPGEN], 1u);
            else XB_SPIN(xb_ld(&bar[XB_TOPGEN]) == tg, bar);
            __builtin_amdgcn_fence(__ATOMIC_ACQUIRE, "agent");
            xb_add(&bar[XB_XGEN(b.x)], 1u);
            asm volatile("s_waitcnt vmcnt(0)" ::: "memory");
        } else {
            XB_SPIN(xb_ld(&bar[XB_XGEN(b.x)]) == gen, bar);
            __builtin_amdgcn_fence(__ATOMIC_ACQUIRE, "agent");
            asm volatile("s_waitcnt vmcnt(0)" ::: "memory");
        }
    }
    __syncthreads();
}

namespace pg8 {
constexpr int BM = 256, BK = 64, HALF = 128, HTB = HALF * BK * 2, STAGE_BYTES = 8 * HTB, NXCD = 8, WGM = 8;
__host__ __device__ __forceinline__ int lds_byte(int r, int c) { const int st = (r >> 4) * 2 + (c >> 5), rr = r & 15, cc = c & 31, ob = rr * 64 + cc * 2; return st * 1024 + (ob ^ (((ob >> 9) & 1) << 5)); }
__host__ __device__ __forceinline__ void stage_rc(int b, int& R, int& C) { const int st = b / 1024, sb = b % 1024, swz = sb ^ (((sb >> 9) & 1) << 5); R = (st >> 1) * 16 + swz / 64; C = (st & 1) * 32 + (swz % 64) / 2; }
__host__ __device__ __forceinline__ int perm32(int rho) { const int n = rho >> 4, i = rho & 15; return 8 * (i >> 2) + 4 * n + (i & 3); }

struct Unit { int pm, pn, kind; };
struct Gemm { const bf16_t* A[2]; const bf16_t* Bt[2]; int lda, ldb, K; };

__device__ __forceinline__ void tile_of(int wgid, int nM, int nN, int& pm, int& pn) {
    const int nwg = nM * nN; { const int q = nwg / NXCD, r = nwg % NXCD, xcd = wgid % NXCD, off = wgid / NXCD; wgid = (xcd < r ? xcd * (q + 1) : r * (q + 1) + (xcd - r) * q) + off; }
    const int nig = WGM * nN, gid = wgid / nig, fm = gid * WGM, gsz = (nM - fm) < WGM ? (nM - fm) : WGM;
    pm = fm + ((wgid % nig) % gsz); pn = (wgid % nig) / gsz;
}
struct Order2 {
    int nM0, nN0, nM1, nN1, G, c;
    __device__ __forceinline__ bool next(int i, Unit& u) const {
        const int L = i * G + c, n0 = nM0 * nN0;
        if (L < n0) { u.kind = 0; tile_of(L, nM0, nN0, u.pm, u.pn); return true; }
        if (L < n0 + nM1 * nN1) { u.kind = 1; tile_of(L - n0, nM1, nN1, u.pm, u.pn); return true; }
        return false;
    }
    __device__ __forceinline__ void a_ready(const Unit&) const {}
    __device__ __forceinline__ void done(const Unit&) const {}
};

__device__ __forceinline__ float row_rstd(const float* X, int nslot, int row) { float s = X[row]; for (int k = 1; k < nslot; ++k) s += X[(size_t)k * 8192 + row];
    return rsqrtf(s * (1.f / 4096.f) + EPS); }
struct EpiBf16 {
    static constexpr bool PERM = true;
    int nostore = 0;
    bf16_t* O[2]; int ldc[2]; const float* rs; int nslot;
    unsigned* kmax = nullptr; LAS unsigned char* nrm = nullptr;
    __device__ __forceinline__ void operator()(const f32x4 (&acc)[2][2][4][2], const Unit& u, int wr, int wc, int fr, int fq) const {
        asm volatile("" : "+v"(fr), "+v"(fq));
        const bool kn = kmax != nullptr && u.kind == 0 && u.pn >= UN_KA / 256 && u.pn < UN_KA / 256 + 8;
        LAS float* NT = (LAS float*)nrm;
        const int row0 = u.pm * BM + wr * 64 + fr, col0 = u.pn * BM + wc * 32 + 8 * fq;
        bf16_t* base = u.kind ? O[1] : O[0]; const int ld = u.kind ? ldc[1] : ldc[0];
        f32x4 cs[2][2];
#pragma unroll
        for (int bj = 0; bj < 2; ++bj)
#pragma unroll
            for (int n = 0; n < 2; ++n) { cs[bj][n] = (f32x4){1.f, 1.f, 1.f, 1.f}; if (rs && u.kind) {
#pragma unroll
                for (int e = 0; e < 4; ++e) cs[bj][n][e] = row_rstd(rs, nslot, col0 + bj * HALF + 4 * n + e); } }
        float rsv[2][4];
#pragma unroll
        for (int ai = 0; ai < 2; ++ai)
#pragma unroll
            for (int m = 0; m < 4; ++m) rsv[ai][m] = (rs && !u.kind) ? row_rstd(rs, nslot, row0 + ai * HALF + m * 16) : 1.f;
#pragma unroll
        for (int ai = 0; ai < 2; ++ai)
#pragma unroll
            for (int m = 0; m < 4; ++m) { const int row = row0 + ai * HALF + m * 16; bf16_t* rowp = base + (size_t)row * ld + col0;
                const float rsc = rsv[ai][m];
#pragma unroll
                for (int bj = 0; bj < 2; ++bj) { const f32x4 v0 = acc[ai][bj][m][0] * cs[bj][0] * rsc, v1 = acc[ai][bj][m][1] * cs[bj][1] * rsc;
                    u32x4 w; w.x = cvt_pk_bf16(v0[0], v0[1]); w.y = cvt_pk_bf16(v0[2], v0[3]); w.z = cvt_pk_bf16(v1[0], v1[1]); w.w = cvt_pk_bf16(v1[2], v1[3]);
                    if (nostore) asm volatile("" :: "v"(w.x), "v"(w.y), "v"(w.z), "v"(w.w)); else *(u32x4*)(rowp + bj * HALF) = w;
                    if (kn) { float s = 0.f;
#pragma unroll
                        for (int e = 0; e < 4; ++e) { const unsigned q = e == 0 ? w.x : e == 1 ? w.y : e == 2 ? w.z : w.w; const float a = __uint_as_float(q << 16), b = __uint_as_float(q & 0xffff0000u); s += a * a + b * b; }
                        const int ln = fq * 16 + fr; s += shfl_xor_l(s, 16, ln); s += shfl_xor_l(s, 32, ln);
                        if (fq == 0) NT[((ai * HALF + wr * 64 + m * 16 + fr) * 4 + wc) * 2 + bj] = s; } } }
        if (kn) {
            asm volatile("s_waitcnt lgkmcnt(0)" ::: "memory"); __builtin_amdgcn_s_barrier(); asm volatile("" ::: "memory");
            const int wv = wr * 4 + wc, ln = fq * 16 + fr, t = wv * 64 + ln, rl = t >> 1, mp = t & 1;
            float nv = sqrtf((NT[(rl * 4 + 0) * 2 + mp] + NT[(rl * 4 + 1) * 2 + mp]) + (NT[(rl * 4 + 2) * 2 + mp] + NT[(rl * 4 + 3) * 2 + mp]));
#pragma unroll
            for (int o = 2; o < 64; o <<= 1) nv = fmaxf(nv, shfl_xor_l(nv, o, ln));
            if (ln < 2) __hip_atomic_fetch_max(kmax + (((u.pm >> 4) * 8 + (u.pn - UN_KA / 256)) * 2 + mp) * 64 + (u.pm & 15) * 4 + (wv >> 1), __float_as_uint(nv), __ATOMIC_RELAXED, __HIP_MEMORY_SCOPE_AGENT);
        }
    }
};
struct EpiF32 {
    static constexpr bool PERM = false;
    float* C; int ldc;
    __device__ __forceinline__ void operator()(const f32x4 (&acc)[2][2][4][2], const Unit& u, int wr, int wc, int fr, int fq) const {
        const int row0 = u.pm * BM + wr * 64 + fr, col0 = u.pn * BM + wc * 32 + 4 * fq;
#pragma unroll
        for (int ai = 0; ai < 2; ++ai)
#pragma unroll
            for (int m = 0; m < 4; ++m) { float* rowp = C + (size_t)(row0 + ai * HALF + m * 16) * ldc + col0;
#pragma unroll
                for (int bj = 0; bj < 2; ++bj)
#pragma unroll
                    for (int n = 0; n < 2; ++n) *(f32x4*)(rowp + bj * HALF + n * 16) = acc[ai][bj][m][n]; }
    }
};


__device__ __forceinline__ float dpp_ror1(float x) { return __int_as_float(__builtin_amdgcn_update_dpp(0, __float_as_int(x), 0x121, 0xf, 0xf, false)); }
__device__ __forceinline__ float dpp_ror2(float x) { return __int_as_float(__builtin_amdgcn_update_dpp(0, __float_as_int(x), 0x122, 0xf, 0xf, false)); }
__device__ __forceinline__ float gelu_tanh_e(float x) { const float u = x * __builtin_fmaf(x * x, -0.10294324f, -2.3022082f); return x * __builtin_amdgcn_rcpf(1.f + __builtin_amdgcn_exp2f(u)); }
__device__ __forceinline__ void conv_taps_dpp(float& gt, float& vl, float s1g, float s2g, float w1g, float w0g, float s1v, float s2v, float w1v, float w0v) {
    asm("s_nop 1\n\tv_fmac_f32_dpp %0, %2, %4 row_ror:1 row_mask:0xf bank_mask:0xf\n\tv_fmac_f32_dpp %1, %6, %8 row_ror:1 row_mask:0xf bank_mask:0xf\n\t"
        "v_fmac_f32_dpp %0, %3, %5 row_ror:2 row_mask:0xf bank_mask:0xf\n\tv_fmac_f32_dpp %1, %7, %9 row_ror:2 row_mask:0xf bank_mask:0xf"
        : "+v"(gt), "+v"(vl) : "v"(s1g), "v"(s2g), "v"(w1g), "v"(w0g), "v"(s1v), "v"(s2v), "v"(w1v), "v"(w0v));
}
struct EpiConvGlu {
    static constexpr bool PERM = true;
    bf16_t* F; float* ZB; const float* wcv; const float* bcv; const float* rs; int nslot; LAS unsigned char* halo;
    __device__ __forceinline__ void operator()(const f32x4 (&acc)[2][2][4][2], const Unit& u, int wr, int wc, int fr, int fq) const {
        asm volatile("" : "+v"(fr), "+v"(fq));
        const int colt = wc * 32 + 8 * fq, ch = u.pn * 128 + colt;
        LAS float* HL = (LAS float*)halo;
        float rsr[2][4];
#pragma unroll
        for (int ai = 0; ai < 2; ++ai)
#pragma unroll
            for (int m = 0; m < 4; ++m) rsr[ai][m] = row_rstd(rs, nslot, u.pm * BM + ai * HALF + wr * 64 + m * 16 + fr);
        if (fr >= 14) {
#pragma unroll
            for (int ai = 0; ai < 2; ++ai) { const int blk = 2 * ai + wr;
#pragma unroll
                for (int bj = 0; bj < 2; ++bj)
#pragma unroll
                    for (int n = 0; n < 2; ++n) { const f32x4 v = acc[ai][bj][3][n] * rsr[ai][3];
                        if (blk < 3) *(LAS f32x4*)(HL + ((blk + 1) * 2 + (fr - 14)) * 256 + bj * 128 + colt + 4 * n) = v;
                        else *(f32x4*)(ZB + ((size_t)u.pm * 4 + 2 + (fr - 14)) * NUP + bj * DFF + ch + 4 * n) = v; } }
        }
        if (wr == 0 && fr < 2) {
#pragma unroll
            for (int bj = 0; bj < 2; ++bj)
#pragma unroll
                for (int n = 0; n < 2; ++n) *(f32x4*)(ZB + ((size_t)u.pm * 4 + fr) * NUP + bj * DFF + ch + 4 * n) = acc[0][bj][0][n] * rsr[0][0];
        }
        asm volatile("s_waitcnt lgkmcnt(0)" ::: "memory"); __builtin_amdgcn_s_barrier(); asm volatile("" ::: "memory");
#pragma unroll
        for (int n = 0; n < 2; ++n) {
            float wg[3][4], wv[3][4], bg[4], bv[4];
#pragma unroll
            for (int j = 0; j < 3; ++j) { const f32x4 a = *(const f32x4*)(wcv + (size_t)j * NUP + ch + 4 * n), b = *(const f32x4*)(wcv + (size_t)j * NUP + DFF + ch + 4 * n);
#pragma unroll
                for (int e = 0; e < 4; ++e) { wg[j][e] = a[e]; wv[j][e] = b[e]; } }
            { const f32x4 a = *(const f32x4*)(bcv + ch + 4 * n), b = *(const f32x4*)(bcv + DFF + ch + 4 * n);
#pragma unroll
              for (int e = 0; e < 4; ++e) { bg[e] = a[e]; bv[e] = b[e]; } }
#pragma unroll
            for (int ai = 0; ai < 2; ++ai) { const int blk = 2 * ai + wr;
                f32x4 pg = (f32x4){0.f, 0.f, 0.f, 0.f}, pv = (f32x4){0.f, 0.f, 0.f, 0.f};
                if (blk > 0 && fr >= 14) { pg = *(const LAS f32x4*)(HL + (blk * 2 + (fr - 14)) * 256 + colt + 4 * n); pv = *(const LAS f32x4*)(HL + (blk * 2 + (fr - 14)) * 256 + 128 + colt + 4 * n); }
#pragma unroll
                for (int m = 0; m < 4; ++m) { float o[4];
                    const f32x4 gs = acc[ai][0][m][n] * rsr[ai][m], vs = acc[ai][1][m][n] * rsr[ai][m];
#pragma unroll
                    for (int j = 0; j < 4; ++j) {
                        const float g0 = gs[j], v0 = vs[j];
                        float gt = __builtin_fmaf(wg[2][j], g0, bg[j]), vl = __builtin_fmaf(wv[2][j], v0, bv[j]);
                        conv_taps_dpp(gt, vl, fr == 15 ? pg[j] : g0, fr >= 14 ? pg[j] : g0, wg[1][j], wg[0][j], fr == 15 ? pv[j] : v0, fr >= 14 ? pv[j] : v0, wv[1][j], wv[0][j]);
                        o[j] = gelu_tanh_e(gt) * vl; }
                    u32x2 w; w.x = cvt_pk_bf16(o[0], o[1]); w.y = cvt_pk_bf16(o[2], o[3]);
                    *(u32x2*)(F + (size_t)(u.pm * BM + ai * HALF + wr * 64 + m * 16 + fr) * DFF + ch + 4 * n) = w;
                    pg = gs; pv = vs; }
            }
        }
    }
};

struct EpiRes {
    static constexpr bool PERM = true;
    bf16_t* H; const float* gpost; float* X1; float* X2; unsigned* cnt; unsigned* tmo; float* OUT; LAS unsigned char* tab;
    __device__ __forceinline__ void operator()(const f32x4 (&acc)[2][2][4][2], const Unit& u, int wr, int wc, int fr, int fq) const {
        asm volatile("" : "+v"(fr), "+v"(fq));
        int tid = threadIdx.x; asm volatile("" : "+v"(tid));
        LAS float* Pt = (LAS float*)tab; LAS float* St = Pt + 1024; volatile LAS unsigned* flag = (volatile LAS unsigned*)(St + 256);
        const int rl0 = wr * 64 + fr, col0 = u.pn * BM + wc * 32 + 8 * fq;
#pragma unroll
        for (int ai = 0; ai < 2; ++ai)
#pragma unroll
            for (int m = 0; m < 4; ++m) { float s = 0.f;
#pragma unroll
                for (int bj = 0; bj < 2; ++bj)
#pragma unroll
                    for (int n = 0; n < 2; ++n) { const f32x4 v = acc[ai][bj][m][n]; s += (v[0] * v[0] + v[1] * v[1]) + (v[2] * v[2] + v[3] * v[3]); }
                s += __shfl_xor(s, 16); s += __shfl_xor(s, 32);
                if (fq == 0) Pt[(rl0 + ai * HALF + m * 16) * 4 + wc] = s; }
        asm volatile("s_waitcnt lgkmcnt(0)" ::: "memory"); __builtin_amdgcn_s_barrier(); asm volatile("" ::: "memory");
        if (tid < 256) { const float s = (Pt[tid * 4] + Pt[tid * 4 + 1]) + (Pt[tid * 4 + 2] + Pt[tid * 4 + 3]);
            __hip_atomic_store(X1 + (size_t)u.pn * 8192 + u.pm * BM + tid, s, __ATOMIC_RELAXED, __HIP_MEMORY_SCOPE_AGENT); }
        asm volatile("s_waitcnt vmcnt(0) lgkmcnt(0)" ::: "memory"); __builtin_amdgcn_s_barrier(); asm volatile("" ::: "memory");
        unsigned* cw = cnt + 64 * u.pm;
        if (tid == 0) __hip_atomic_fetch_add(cw, 1u, __ATOMIC_RELAXED, __HIP_MEMORY_SCOPE_AGENT);
        if (tid < 64) { unsigned dead = 0u; const unsigned long long t0 = __builtin_amdgcn_s_memrealtime(); unsigned polls = 0;
            while ((unsigned)__builtin_amdgcn_readfirstlane((int)__hip_atomic_load(cw, __ATOMIC_RELAXED, __HIP_MEMORY_SCOPE_AGENT)) < 16u) {
                if ((++polls & 63u) == 0u && (__builtin_amdgcn_s_memrealtime() - t0 > 4000000ull || __builtin_amdgcn_readfirstlane((int)__hip_atomic_load(tmo, __ATOMIC_RELAXED, __HIP_MEMORY_SCOPE_AGENT)) != 0)) {
                    if (tid == 0) __hip_atomic_store(tmo, 1u, __ATOMIC_RELAXED, __HIP_MEMORY_SCOPE_AGENT); dead = 1u; break; }
                __builtin_amdgcn_s_sleep(2); }
            if (tid == 0) flag[0] = dead; }
        asm volatile("s_waitcnt vmcnt(0) lgkmcnt(0)" ::: "memory"); __builtin_amdgcn_s_barrier(); asm volatile("" ::: "memory");
        if (tid < 256) { float tot = 0.f;
#pragma unroll
            for (int pn = 0; pn < 16; ++pn) tot += __hip_atomic_load(X1 + (size_t)pn * 8192 + u.pm * BM + tid, __ATOMIC_RELAXED, __HIP_MEMORY_SCOPE_AGENT);
            St[tid] = flag[0] ? __builtin_nanf("") : rsqrtf(tot * (1.f / 4096.f) + EPS); }
        asm volatile("s_waitcnt lgkmcnt(0)" ::: "memory"); __builtin_amdgcn_s_barrier(); asm volatile("" ::: "memory");
#pragma unroll
        for (int ai = 0; ai < 2; ++ai)
#pragma unroll
            for (int m = 0; m < 4; ++m) { const int rl = rl0 + ai * HALF + m * 16, row = u.pm * BM + rl; const float rsy = St[rl];
                float s2 = 0.f;
#pragma unroll
                for (int bj = 0; bj < 2; ++bj) { const int col = col0 + bj * HALF;
                    const u32x4 hw = *(const u32x4*)(H + (size_t)row * 4096 + col); const f32x4 g0 = *(const f32x4*)(gpost + col), g1 = *(const f32x4*)(gpost + col + 4);
                    const f32x4 a0 = acc[ai][bj][m][0], a1 = acc[ai][bj][m][1];
                    f32x4 h0, h1;
                    h0[0] = __uint_as_float(hw.x << 16) + a0[0] * rsy * g0[0]; h0[1] = __uint_as_float(hw.x & 0xffff0000u) + a0[1] * rsy * g0[1];
                    h0[2] = __uint_as_float(hw.y << 16) + a0[2] * rsy * g0[2]; h0[3] = __uint_as_float(hw.y & 0xffff0000u) + a0[3] * rsy * g0[3];
                    h1[0] = __uint_as_float(hw.z << 16) + a1[0] * rsy * g1[0]; h1[1] = __uint_as_float(hw.z & 0xffff0000u) + a1[1] * rsy * g1[1];
                    h1[2] = __uint_as_float(hw.w << 16) + a1[2] * rsy * g1[2]; h1[3] = __uint_as_float(hw.w & 0xffff0000u) + a1[3] * rsy * g1[3];
                    if (OUT) { float* op = OUT + (size_t)row * 4096 + col; *(f32x4*)op = h0; *(f32x4*)(op + 4) = h1; }
                    else { u32x4 w; w.x = cvt_pk_bf16(h0[0], h0[1]); w.y = cvt_pk_bf16(h0[2], h0[3]); w.z = cvt_pk_bf16(h1[0], h1[1]); w.w = cvt_pk_bf16(h1[2], h1[3]);
                        *(u32x4*)(H + (size_t)row * 4096 + col) = w;
                        s2 += (h0[0] * h0[0] + h0[1] * h0[1]) + (h0[2] * h0[2] + h0[3] * h0[3]) + (h1[0] * h1[0] + h1[1] * h1[1]) + (h1[2] * h1[2] + h1[3] * h1[3]); } }
                if (!OUT) { s2 += __shfl_xor(s2, 16); s2 += __shfl_xor(s2, 32); if (fq == 0) Pt[rl * 4 + wc] = s2; } }
        if (!OUT) {
            asm volatile("s_waitcnt lgkmcnt(0)" ::: "memory"); __builtin_amdgcn_s_barrier(); asm volatile("" ::: "memory");
            if (tid < 256) X2[(size_t)u.pn * 8192 + u.pm * BM + tid] = (Pt[tid * 4] + Pt[tid * 4 + 1]) + (Pt[tid * 4 + 2] + Pt[tid * 4 + 3]);
            asm volatile("s_waitcnt lgkmcnt(0)" ::: "memory"); __builtin_amdgcn_s_barrier(); asm volatile("" ::: "memory");
        }
    }
};
struct OrderPanel {
    int G, c;
    __device__ __forceinline__ bool next(int i, Unit& u) const {
        const int L = i * G + c; if (L >= 512) return false;
        const int round = L >> 8, idx = L & 255, xcd = idx & 7, k = idx >> 3;
        u.kind = 0; u.pm = 16 * round + 4 * (xcd >> 1) + (k >> 3); u.pn = 8 * (xcd & 1) + (k & 7); return true;
    }
    __device__ __forceinline__ void a_ready(const Unit&) const {}
    __device__ __forceinline__ void done(const Unit&) const {}
};

template <class Epi, class Sched, bool ALIGN_EPI, bool SP2>
__device__ __forceinline__ void gemm_phase(LAS unsigned char* lds, const Gemm g, const Sched& S, const Epi& E, const int wid) {
    const int lane = fresh_lane();
    const int tid = wid * 64 + lane, wr = wid >> 2, wc = wid & 3, fr = lane & 15, fq = lane >> 4;
    const int K = g.K, nt = K / BK;
    unsigned voffA[2], voffB[2];
#pragma unroll
    for (int i = 0; i < 2; ++i) { int R, C; stage_rc(tid * 16 + i * 8192, R, C); const int Rb = Epi::PERM ? ((R & ~31) + perm32(R & 31)) : R;
        voffA[i] = (unsigned)(R * g.lda + C) * 2u; voffB[i] = (unsigned)(Rb * g.ldb + C) * 2u; }
    const size_t kstep = (size_t)(BK * 2);
    const size_t hstepA = (size_t)HALF * g.lda * 2, hstepB = (size_t)HALF * g.ldb * 2;
    const size_t tstepA = 2 * hstepA, tstepB = 2 * hstepB;
    const unsigned ldsw = (unsigned)wid * 1024u;
    const int aoff = lds_byte(wr * 64 + fr, fq * 8), boff = lds_byte(wc * 32 + fr, fq * 8);
#define PG8_SA(b, h) (((b) * 2 + (h)) * HTB)
#define PG8_SB(b, h) ((4 + (b) * 2 + (h)) * HTB)
#define PG8_STAGE(bufoff, gbase, voff) do { _Pragma("unroll") for (int _i = 0; _i < 2; ++_i) \
        __builtin_amdgcn_global_load_lds((const unsigned*)((const char*)(gbase) + (voff)[_i]), (LAS unsigned*)(lds + (bufoff) + ldsw + _i * 8192), 16, 0, 0); } while (0)
#define PG8_LDA(dst, b, h) do { _Pragma("unroll") for (int m = 0; m < 4; ++m) _Pragma("unroll") for (int k = 0; k < 2; ++k) dst[m][k] = *(const LAS bf16x8*)(lds + PG8_SA(b, h) + aoff + m * 2048 + k * 1024); } while (0)
#define PG8_LDB(dst, b, h) do { _Pragma("unroll") for (int n = 0; n < 2; ++n) _Pragma("unroll") for (int k = 0; k < 2; ++k) dst[n][k] = *(const LAS bf16x8*)(lds + PG8_SB(b, h) + boff + n * 2048 + k * 1024); } while (0)
#define PG8_MMA(ai, bj, At, Bt) do { __builtin_amdgcn_s_setprio(1); _Pragma("unroll") for (int m = 0; m < 4; ++m) _Pragma("unroll") for (int n = 0; n < 2; ++n) _Pragma("unroll") for (int k = 0; k < 2; ++k) \
        acc[ai][bj][m][n] = __builtin_amdgcn_mfma_f32_16x16x32_bf16(Bt[n][k], At[m][k], acc[ai][bj][m][n], 0, 0, 0); __builtin_amdgcn_s_setprio(0); } while (0)
#define PG8_WAIT_V(n) asm volatile("s_waitcnt vmcnt(" #n ")" ::: "memory")
#define PG8_WAIT_L(n) asm volatile("s_waitcnt lgkmcnt(" #n ")" ::: "memory")
#define PG8_BAR __builtin_amdgcn_s_barrier()
#define PG8_SCHED __builtin_amdgcn_sched_barrier(0)
    Unit cur, nxt; int ui = 0;
    if (!S.next(0, cur)) return;
    f32x4 acc[2][2][4][2];
#pragma unroll
    for (int a = 0; a < 2; ++a)
#pragma unroll
        for (int b = 0; b < 2; ++b)
#pragma unroll
            for (int m = 0; m < 4; ++m)
#pragma unroll
                for (int n = 0; n < 2; ++n) acc[a][b][m][n] = (f32x4){0.f, 0.f, 0.f, 0.f};
    bf16x8 At[4][2], B0[2][2], B1[2][2];
    const char* cA = (const char*)(cur.kind ? g.A[1] : g.A[0]) + (size_t)cur.pm * tstepA; const char* cB = (const char*)(cur.kind ? g.Bt[1] : g.Bt[0]) + (size_t)cur.pn * tstepB;
    S.a_ready(cur);
    if constexpr (SP2) {
        PG8_STAGE(PG8_SB(0, 0), cB, voffB); PG8_STAGE(PG8_SB(0, 1), cB + hstepB, voffB); PG8_STAGE(PG8_SA(0, 0), cA, voffA); PG8_STAGE(PG8_SA(0, 1), cA + hstepA, voffA);
        if (wr == 1) PG8_BAR;
        PG8_WAIT_V(2); PG8_BAR;
        PG8_STAGE(PG8_SB(1, 0), cB + kstep, voffB); PG8_STAGE(PG8_SA(1, 0), cA + kstep, voffA); PG8_STAGE(PG8_SB(1, 1), cB + hstepB + kstep, voffB);
        PG8_WAIT_V(6); PG8_BAR;
    } else {
        PG8_STAGE(PG8_SB(0, 0), cB, voffB); PG8_STAGE(PG8_SA(0, 0), cA, voffA); PG8_STAGE(PG8_SB(0, 1), cB + hstepB, voffB); PG8_STAGE(PG8_SA(0, 1), cA + hstepA, voffA);
        if (wr == 1) PG8_BAR;
        PG8_WAIT_V(4); PG8_BAR;
        PG8_STAGE(PG8_SB(1, 0), cB + kstep, voffB); PG8_STAGE(PG8_SA(1, 0), cA + kstep, voffA); PG8_STAGE(PG8_SB(1, 1), cB + hstepB + kstep, voffB);
        PG8_WAIT_V(6); PG8_BAR;
    }
    for (;;) {
        const bool has_next = S.next(ui + 1, nxt);
        const char* nA = has_next ? (const char*)(nxt.kind ? g.A[1] : g.A[0]) + (size_t)nxt.pm * tstepA : cA; const char* nB = has_next ? (const char*)(nxt.kind ? g.Bt[1] : g.Bt[0]) + (size_t)nxt.pn * tstepB : cB;
        for (int t = 0; t < nt; t += 2) {
            const bool last = (t == nt - 2);
            const char* a1 = cA + (size_t)(t + 1) * kstep;
            const char* a2 = last ? nA : cA + (size_t)(t + 2) * kstep; const char* b2 = last ? nB : cB + (size_t)(t + 2) * kstep;
            const char* a3 = a2 + kstep; const char* b3 = b2 + kstep;
            if (last && has_next) S.a_ready(nxt);
            if constexpr (SP2) {
            PG8_LDB(B0, 0, 0); PG8_LDB(B1, 0, 1); PG8_SCHED; PG8_LDA(At, 0, 0); PG8_STAGE(PG8_SA(1, 1), a1 + hstepA, voffA);
            PG8_WAIT_V(8); PG8_WAIT_L(0); PG8_BAR; PG8_MMA(0, 0, At, B0); PG8_MMA(0, 1, At, B1); PG8_BAR; PG8_SCHED;
            PG8_LDA(At, 0, 1); PG8_STAGE(PG8_SB(0, 0), b2, voffB); PG8_STAGE(PG8_SB(0, 1), b2 + hstepB, voffB); PG8_STAGE(PG8_SA(0, 0), a2, voffA);
            PG8_WAIT_V(8); PG8_WAIT_L(0); PG8_BAR; PG8_MMA(1, 0, At, B0); PG8_MMA(1, 1, At, B1); PG8_BAR; PG8_SCHED;
            PG8_LDB(B0, 1, 0); PG8_LDB(B1, 1, 1); PG8_SCHED; PG8_LDA(At, 1, 0); PG8_STAGE(PG8_SA(0, 1), a2 + hstepA, voffA);
            PG8_WAIT_V(8); PG8_WAIT_L(0); PG8_BAR; PG8_MMA(0, 0, At, B0); PG8_MMA(0, 1, At, B1); PG8_BAR; PG8_SCHED;
            PG8_LDA(At, 1, 1); PG8_STAGE(PG8_SB(1, 0), b3, voffB); PG8_STAGE(PG8_SB(1, 1), b3 + hstepB, voffB); PG8_STAGE(PG8_SA(1, 0), a3, voffA);
            PG8_WAIT_V(8); PG8_WAIT_L(0); PG8_BAR; PG8_MMA(1, 0, At, B0); PG8_MMA(1, 1, At, B1); PG8_BAR; PG8_SCHED;
            } else {
            PG8_LDB(B0, 0, 0); PG8_SCHED; PG8_LDA(At, 0, 0); PG8_STAGE(PG8_SA(1, 1), a1 + hstepA, voffA);
            PG8_WAIT_L(8); PG8_BAR; PG8_WAIT_L(0); PG8_MMA(0, 0, At, B0); PG8_BAR; PG8_SCHED;
            PG8_LDB(B1, 0, 1); PG8_STAGE(PG8_SB(0, 0), b2, voffB);
            PG8_BAR; PG8_WAIT_L(0); PG8_MMA(0, 1, At, B1); PG8_BAR;
            PG8_LDA(At, 0, 1); PG8_STAGE(PG8_SA(0, 0), a2, voffA);
            PG8_BAR; PG8_WAIT_L(0); PG8_MMA(1, 0, At, B0); PG8_BAR; PG8_SCHED;
            PG8_STAGE(PG8_SB(0, 1), b2 + hstepB, voffB);
            PG8_WAIT_V(6); PG8_BAR; PG8_MMA(1, 1, At, B1); PG8_BAR;
            PG8_LDB(B0, 1, 0); PG8_SCHED; PG8_LDA(At, 1, 0); PG8_STAGE(PG8_SA(0, 1), a2 + hstepA, voffA);
            PG8_WAIT_L(8); PG8_BAR; PG8_WAIT_L(0); PG8_MMA(0, 0, At, B0); PG8_BAR; PG8_SCHED;
            PG8_LDB(B1, 1, 1); PG8_STAGE(PG8_SB(1, 0), b3, voffB);
            PG8_BAR; PG8_WAIT_L(0); PG8_MMA(0, 1, At, B1); PG8_BAR;
            PG8_LDA(At, 1, 1); PG8_STAGE(PG8_SA(1, 0), a3, voffA);
            PG8_BAR; PG8_WAIT_L(0); PG8_MMA(1, 0, At, B0); PG8_BAR; PG8_SCHED;
            PG8_STAGE(PG8_SB(1, 1), b3 + hstepB, voffB);
            PG8_WAIT_V(6); PG8_BAR; PG8_MMA(1, 1, At, B1); PG8_BAR;
            }
        }
        if constexpr (ALIGN_EPI) { if (wr == 0) PG8_BAR; }
        E(acc, cur, wr, wc, fr, fq); S.done(cur);
        if (!has_next) break;
#pragma unroll
        for (int a = 0; a < 2; ++a)
#pragma unroll
            for (int b = 0; b < 2; ++b)
#pragma unroll
                for (int m = 0; m < 4; ++m)
#pragma unroll
                    for (int n = 0; n < 2; ++n) acc[a][b][m][n] = (f32x4){0.f, 0.f, 0.f, 0.f};
        cur = nxt; cA = nA; cB = nB; ++ui;
        if constexpr (ALIGN_EPI) { if (wr == 1) PG8_BAR; }
    }
    PG8_WAIT_V(0);
    if constexpr (!ALIGN_EPI) { if (wr == 0) PG8_BAR; }
    PG8_BAR;
#undef PG8_SA
#undef PG8_SB
#undef PG8_STAGE
#undef PG8_LDA
#undef PG8_LDB
#undef PG8_MMA
#undef PG8_WAIT_V
#undef PG8_WAIT_L
#undef PG8_BAR
#undef PG8_SCHED
}
}
#ifndef PG8_SP2
#define PG8_SP2 true
#endif
#ifndef PG8_ALIGN
#define PG8_ALIGN true
#endif
static_assert(PG8_ALIGN, "EpiConvGlu has a workgroup barrier inside its epilogue: both half-workgroups must run their epilogues together (ALIGN_EPI)");

constexpr size_t WS_GLA = WS_Z;
constexpr size_t GLA_LT = 0, GLA_OI = 64 * MiB, GLA_ST = 96 * MiB, GLA_QT = 128 * MiB, GLA_DEC = 136 * MiB;
__device__ __forceinline__ int crow(int i, int hh) { return (i & 3) + 8 * (i >> 2) + 4 * hh; }
#define MFMA32(a, b, c) __builtin_amdgcn_mfma_f32_32x32x16_bf16((a), (b), (c), 0, 0, 0)
#define WG_BAR() do { asm volatile("s_waitcnt vmcnt(0) lgkmcnt(0)" ::: "memory"); __builtin_amdgcn_s_barrier(); asm volatile("" ::: "memory"); } while (0)

__device__ __forceinline__ f32x16 mma_lds(const LAS bf16_t* A, int pa, const LAS bf16_t* B, int pb, int K, f32x16 acc, int r, int hh) {
    const LAS bf16_t* ap = A + r * pa + 8 * hh; const LAS bf16_t* bp = B + r * pb + 8 * hh;
    for (int k = 0; k < K; k += 16) acc = MFMA32(*(const LAS bf16x8*)(ap + k), *(const LAS bf16x8*)(bp + k), acc);
    return acc;
}

namespace att {
constexpr float LOG2E = 1.4426950408889634f, C1 = 0.08838834764831845f * LOG2E, THRL = 8.f;
constexpr int GSUB_OFF = LDSCTL_OFF + 2048;
constexpr int KP = 528, VP = 144, VBYTES = 256 * VP, KBYTES = 64 * KP, ABUF = VBYTES + KBYTES, XP = 1040;
__device__ __forceinline__ void stage_tile(LAS unsigned char* buf, const char* kt, const char* vt, int wave, int lane) {
#pragma unroll
    for (int i = 0; i < 5; ++i) { const int iv = wave + 8 * i; if (iv < 36) { const unsigned q = iv * 64 + lane, row = q / 9u, cp = q - 9u * row, cc = cp < 8u ? cp : 7u;
        __builtin_amdgcn_global_load_lds((const GAS unsigned*)(vt + (row * (unsigned)(M * 2) + cc * 16u)), (LAS unsigned*)(buf + iv * 1024), 16, 0, 0); } }
#pragma unroll
    for (int i = 0; i < 5; ++i) { const int ik = wave + 8 * i; if (ik < 33) { const unsigned q = ik * 64 + lane, row = q / 33u, cp = q - 33u * row, cc = cp < 32u ? cp : 31u;
        __builtin_amdgcn_global_load_lds((const GAS unsigned*)(kt + (row * (unsigned)(UNW * 2) + cc * 16u)), (LAS unsigned*)(buf + VBYTES + ik * 1024), 16, 0, 0); } }
}
constexpr float TSKIP = 64.f;
__device__ __forceinline__ void unit(LAS unsigned char* lds, const bf16_t* UN, const bf16_t* UT, bf16_t* MIX, const unsigned* KMAX, int b, int h, int qb, float lam, const float* gsub, float post_scale, int wave, int lane, const int mode = 0) {
    const int mp = wave >> 2, wq = wave & 3, r = lane & 31, hh = lane >> 5;
    const int q0 = qb * 128 + wq * 32, qpos = q0 + r, cw = q0 >> 6;
    const float C2 = __uint_as_float((unsigned)(127 - (h + 1)) << 23) * LOG2E;
    const char* kt = (const char*)(UN + (size_t)(b * SEQ) * UNW + UN_KA + h * 256);
    const char* vt = (const char*)(UT + (size_t)(h * 256) * M + (size_t)b * SEQ);
    if (mode != 3) stage_tile(lds, kt + (size_t)(2 * qb + 1) * 64 * UNW * 2, vt + (size_t)(2 * qb + 1) * 128, wave, lane);
    const float km_raw = __uint_as_float(__hip_atomic_load(KMAX + ((b * 8 + h) * 2 + mp) * 64 + lane, __ATOMIC_RELAXED, __HIP_MEMORY_SCOPE_AGENT));
    bf16x8 qf[8];
    { const bf16_t* qp = UN + (size_t)(b * SEQ + qpos) * UNW + UN_QA + h * 256 + mp * 128 + 8 * hh;
#pragma unroll
      for (int kk = 0; kk < 8; ++kk) qf[kk] = *(const bf16x8*)(qp + 16 * kk); }
    unsigned long long mask;
    { float qs = 0.f;
#pragma unroll
      for (int kk = 0; kk < 8; ++kk)
#pragma unroll
          for (int e = 0; e < 8; ++e) { const float x = bf2f((bf16_t)qf[kk][e]); qs += x * x; }
      { auto rr = __builtin_amdgcn_permlane32_swap(__float_as_uint(qs), __float_as_uint(qs), false, false); qs = __uint_as_float(rr[0]) + __uint_as_float(rr[1]); }
#pragma unroll
      for (int o = 1; o < 32; o <<= 1) qs = fmaxf(qs, shfl_xor_l(qs, o, lane));
      const float qn = sqrtf(qs) * 1.001f;
      const float km = km_raw * 1.001f;
      const float kcw = __uint_as_float(__builtin_amdgcn_readlane(__float_as_uint(km), cw));
      const int md = q0 - (64 * lane + 63);
      const bool need = (lane <= cw) && (C1 * qn * (km + kcw) - C2 * (float)(md > 0 ? md : 0) >= -TSKIP);
      mask = __ballot(need); }
    volatile LAS unsigned long long* masks = (volatile LAS unsigned long long*)(lds + LDSCTL_OFF + 512);
    if (lane == 0) masks[wave] = mask;
    f32x16 O[8];
#pragma unroll
    for (int eb = 0; eb < 8; ++eb)
#pragma unroll
        for (int i = 0; i < 16; ++i) O[eb][i] = 0.f;
    float m_ref = -INFINITY, l_acc = 0.f;
    WG_BAR();
    unsigned long long rem = 0ull;
#pragma unroll
    for (int w = 0; w < 8; ++w) { const unsigned long long mw = masks[w]; rem |= ((unsigned long long)__builtin_amdgcn_readfirstlane((unsigned)(mw >> 32)) << 32) | (unsigned long long)__builtin_amdgcn_readfirstlane((unsigned)mw); }
    int j = 63 - __builtin_clzll(rem); rem &= ~(1ull << j);
    const int kbase = VBYTES + r * KP + mp * 256 + hh * 16, vbase = r * VP + hh * 16;
    for (int it = 0;; ++it) {
        WG_BAR();
        LAS unsigned char* buf = lds + (it & 1) * ABUF;
        const int jn = rem ? 63 - __builtin_clzll(rem) : -1;
        if (jn >= 0) { rem &= ~(1ull << jn); if (mode != 3) stage_tile(lds + ((it + 1) & 1) * ABUF, kt + (size_t)jn * 64 * UNW * 2, vt + (size_t)jn * 128, wave, lane); }
        if (((mask >> j) & 1ull) && mode != 1) {
            const LAS unsigned char* kp = buf + kbase; const LAS unsigned char* vp = buf + vbase;
#pragma unroll
            for (int hf = 1; hf >= 0; --hf) {
                f32x16 p0;
#pragma unroll
                for (int i = 0; i < 16; ++i) p0[i] = 0.f;
#define LDK(KK) (*(const LAS bf16x8*)(kp + hf * 32 * KP + (KK) * 32))
                { bf16x8 kf[8]; kf[0] = LDK(0); kf[1] = LDK(1); kf[2] = LDK(2); kf[3] = LDK(3);
                  __builtin_amdgcn_sched_barrier(0);
                  __builtin_amdgcn_s_setprio(1);
#pragma unroll
                  for (int kk = 0; kk < 8; ++kk) { if (kk + 4 < 8) kf[kk + 4] = LDK(kk + 4); p0 = MFMA32(kf[kk], qf[kk], p0); __builtin_amdgcn_sched_barrier(0); }
                  __builtin_amdgcn_s_setprio(0); }
#undef LDK
                const float base0 = (float)(qpos - 64 * j - 32 * hf - 4 * hh);
                float pmax = -INFINITY;
#pragma unroll
                for (int i = 0; i < 16; ++i) { const float off = (float)((i & 3) + 8 * (i >> 2));
                    p0[i] = fmaf(p0[i], C1, -C2 * fabsf(base0 - off)); pmax = fmaxf(pmax, p0[i]); }
                { auto rr = __builtin_amdgcn_permlane32_swap(__float_as_uint(pmax), __float_as_uint(pmax), false, false); pmax = fmaxf(__uint_as_float(rr[0]), __uint_as_float(rr[1])); }
                if (!__all(pmax - m_ref <= THRL)) {
                    const float mn = fmaxf(m_ref, pmax), alpha = __builtin_amdgcn_exp2f(m_ref - mn); m_ref = mn; l_acc *= alpha;
#pragma unroll
                    for (int eb = 0; eb < 8; ++eb)
#pragma unroll
                        for (int i = 0; i < 16; ++i) O[eb][i] *= alpha;
                }
                float ps = 0.f;
#pragma unroll
                for (int i = 0; i < 16; ++i) { p0[i] = __builtin_amdgcn_exp2f(p0[i] - m_ref); ps += p0[i]; }
                l_acc += ps;
                bf16x8 pf[2];
#define PK4(P, BASE, OUT) do { const unsigned a0 = cvt_pk_bf16(P[BASE + 0], P[BASE + 1]), a1 = cvt_pk_bf16(P[BASE + 2], P[BASE + 3]); \
    const unsigned b0 = cvt_pk_bf16(P[BASE + 4], P[BASE + 5]), b1 = cvt_pk_bf16(P[BASE + 6], P[BASE + 7]); \
    auto r0 = __builtin_amdgcn_permlane32_swap(a0, b0, false, false); auto r1 = __builtin_amdgcn_permlane32_swap(a1, b1, false, false); \
    u32x4 w = {r0[0], r1[0], r0[1], r1[1]}; OUT = *reinterpret_cast<bf16x8*>(&w); } while (0)
                PK4(p0, 0, pf[0]); PK4(p0, 8, pf[1]);
#undef PK4
#define LDV(EB, S2) (*(const LAS bf16x8*)(vp + (EB) * 32 * VP + (4 * hf + 2 * (S2)) * 16))
                { bf16x8 va[4] = {LDV(0, 0), LDV(0, 1), LDV(1, 0), LDV(1, 1)};
                  __builtin_amdgcn_s_setprio(1);
#pragma unroll
                  for (int eb = 0; eb < 8; eb += 2) { bf16x8 vn[4];
                      if (eb < 6) { vn[0] = LDV(eb + 2, 0); vn[1] = LDV(eb + 2, 1); vn[2] = LDV(eb + 3, 0); vn[3] = LDV(eb + 3, 1); }
                      O[eb] = MFMA32(va[0], pf[0], O[eb]); O[eb + 1] = MFMA32(va[2], pf[0], O[eb + 1]); O[eb] = MFMA32(va[1], pf[1], O[eb]); O[eb + 1] = MFMA32(va[3], pf[1], O[eb + 1]);
                      __builtin_amdgcn_sched_barrier(0);
                      if (eb < 6) { va[0] = vn[0]; va[1] = vn[1]; va[2] = vn[2]; va[3] = vn[3]; } }
                  __builtin_amdgcn_s_setprio(0); }
#undef LDV
            }
        }
        if (jn < 0) break;
        j = jn;
    }
    { auto rr = __builtin_amdgcn_permlane32_swap(__float_as_uint(l_acc), __float_as_uint(l_acc), false, false); l_acc = __uint_as_float(rr[0]) + __uint_as_float(rr[1]); }
    WG_BAR();
    LAS unsigned char* xp = lds + (wq * 32 + r) * XP + hh * 16;
    if (mp == 1) {
        const float inv = lam / l_acc;
#pragma unroll
        for (int eb = 0; eb < 8; ++eb)
#pragma unroll
            for (int g4 = 0; g4 < 4; ++g4) { const f32x4 v = {O[eb][4 * g4] * inv, O[eb][4 * g4 + 1] * inv, O[eb][4 * g4 + 2] * inv, O[eb][4 * g4 + 3] * inv};
                *(LAS f32x4*)(xp + (8 * eb + 2 * g4) * 16) = v; }
    }
    WG_BAR();
    if (mp == 0) {
        const float inv = 1.f / l_acc; float ss = 0.f;
#pragma unroll
        for (int eb = 0; eb < 8; ++eb) {
#pragma unroll
            for (int g4 = 0; g4 < 4; ++g4) { const f32x4 x = *(const LAS f32x4*)(xp + (8 * eb + 2 * g4) * 16);
#pragma unroll
                for (int e = 0; e < 4; ++e) { const float v = O[eb][4 * g4 + e] * inv - x[e]; O[eb][4 * g4 + e] = v; ss += v * v; } }
            asm volatile("" ::: "memory"); }
        { auto rr = __builtin_amdgcn_permlane32_swap(__float_as_uint(ss), __float_as_uint(ss), false, false); ss = __uint_as_float(rr[0]) + __uint_as_float(rr[1]); }
        const float rs = rsqrtf(ss * (1.f / 256.f) + EPS) * post_scale;
        bf16_t* op = MIX + (size_t)(b * SEQ + qpos) * D + h * 256 + 4 * hh; const LAS float* gp = (const LAS float*)(lds + GSUB_OFF) + 4 * hh;
#pragma unroll
        for (int eb = 0; eb < 8; ++eb) {
#pragma unroll
            for (int g4 = 0; g4 < 4; ++g4) { const int e0 = 32 * eb + 8 * g4; const f32x4 g = *(const LAS f32x4*)(gp + e0);
                u32x2 w; w.x = cvt_pk_bf16(O[eb][4 * g4] * rs * g[0], O[eb][4 * g4 + 1] * rs * g[1]); w.y = cvt_pk_bf16(O[eb][4 * g4 + 2] * rs * g[2], O[eb][4 * g4 + 3] * rs * g[3]);
                if (mode == 0) *(u32x2*)(op + e0) = w; else asm volatile("" :: "v"(w.x), "v"(w.y)); }
            asm volatile("" ::: "memory"); }
    }
    WG_BAR();
}
}

namespace gla {
constexpr int O_LA = 0, O_ZL = 32768, O_QT = 36864, O_KT = 54272, O_KHT = 71680, O_VT = 90112, O_AM = 0;
constexpr int PQ = 136, PS = 72;
__device__ __forceinline__ void g1_unit(LAS unsigned char* lds, const bf16_t* UN, const bf16_t* UT, const float* ZLR, const float* w2, const float* bgate, unsigned char* gs, int u, int tid, int wave, int lane) {
    const int c = u & 63, h = (u >> 6) & 3, b = u >> 8; const size_t tok0 = (size_t)b * SEQ + c * 64;
    LAS float* LA = (LAS float*)(lds + O_LA); LAS float* ZL = (LAS float*)(lds + O_ZL);
    LAS bf16_t* QT = (LAS bf16_t*)(lds + O_QT); LAS bf16_t* KT = (LAS bf16_t*)(lds + O_KT); LAS bf16_t* KHT = (LAS bf16_t*)(lds + O_KHT); LAS bf16_t* VT = (LAS bf16_t*)(lds + O_VT); LAS bf16_t* AM = (LAS bf16_t*)(lds + O_AM);
    const int d = tid & 127, qd = tid >> 7;
    float w[16]; bf16_t qr[16], kr[16];
#pragma unroll
    for (int rr = 0; rr < 16; ++rr) w[rr] = w2[rr * 512 + h * 128 + d];
    const float bias = bgate[h * 128 + d];
#pragma unroll
    for (int i = 0; i < 16; ++i) { const size_t t = tok0 + qd * 16 + i; qr[i] = UN[t * UNW + UN_QB + h * 128 + d]; kr[i] = UN[t * UNW + UN_KB + h * 128 + d]; }
    if (tid < 256) *(LAS f32x4*)(ZL + tid * 4) = *(const f32x4*)(ZLR + tok0 * 16 + tid * 4);
#pragma unroll
    for (int i = 0; i < 4; ++i) { const int id = tid + 512 * i, row = id >> 3, ch = id & 7;
        *(LAS u32x4*)(VT + row * PS + ch * 8) = *(const u32x4*)(UT + (size_t)(2048 + h * 256 + row) * M + tok0 + ch * 8); }
    WG_BAR();
    float bt[16];
    { float run = 0.f;
#pragma unroll
      for (int i = 0; i < 16; ++i) { const int t = qd * 16 + i; float x = bias;
#pragma unroll
          for (int rr = 0; rr < 16; ++rr) x += ZL[t * 16 + rr] * w[rr];
          const float ls = fminf(x, 0.f) - __logf(1.f + __expf(-fabsf(x)));
          run += ls * (1.f / 16.f); bt[i] = run; }
      WG_BAR();
      ZL[qd * 128 + d] = run; }
    WG_BAR();
    float off = 0.f, btot = 0.f;
#pragma unroll
    for (int q = 0; q < 4; ++q) { const float p = ZL[q * 128 + d]; btot += p; if (q < qd) off += p; }
    bf16_t* QTg = (bf16_t*)(gs + GLA_QT) + (size_t)u * 64 * 128;
#pragma unroll
    for (int i = 0; i < 16; ++i) { const int t = qd * 16 + i; const float bb = bt[i] + off;
        const float qv = bf2f(qr[i]) * 0.08838834764831845f, kv = bf2f(kr[i]);
        const bf16_t qt = f2bf(qv * __expf(bb));
        QT[t * PQ + d] = qt; QTg[t * 128 + d] = qt; KT[t * PQ + d] = f2bf(kv * __expf(-bb)); KHT[d * PS + t] = f2bf(kv * __expf(btot - bb)); }
    if (qd == 0) ((float*)(gs + GLA_DEC))[(size_t)u * 128 + d] = __expf(btot);
    WG_BAR();
    const int r = lane & 31, hh = lane >> 5;
    f32x16 zero;
#pragma unroll
    for (int i = 0; i < 16; ++i) zero[i] = 0.f;
    if (wave < 4) {
        const int mi = wave >> 1, ni = wave & 1;
        const f32x16 a = mma_lds(QT + 32 * mi * PQ, PQ, KT + 32 * ni * PQ, PQ, 128, zero, r, hh);
#pragma unroll
        for (int i = 0; i < 16; ++i) { const int t = 32 * mi + crow(i, hh), s = 32 * ni + r; AM[t * PS + s] = f2bf(s <= t ? a[i] : 0.f); }
    }
    { float* LT = (float*)(gs + GLA_LT) + (size_t)u * 256 * 128;
#pragma unroll
      for (int db = 0; db < 4; ++db) { const f32x16 a = mma_lds(VT + 32 * wave * PS, PS, KHT + 32 * db * PS, PS, 64, zero, r, hh);
#pragma unroll
          for (int i = 0; i < 16; ++i) LT[(size_t)(32 * wave + crow(i, hh)) * 128 + 32 * db + r] = a[i]; } }
    WG_BAR();
    { float* OI = (float*)(gs + GLA_OI) + (size_t)u * 64 * 256;
#pragma unroll
      for (int tb = 0; tb < 2; ++tb) { const f32x16 a = mma_lds(AM + 32 * tb * PS, PS, VT + 32 * wave * PS, PS, 64, zero, r, hh);
#pragma unroll
          for (int i = 0; i < 16; ++i) OI[(size_t)(32 * tb + crow(i, hh)) * 256 + 32 * wave + r] = a[i]; } }
    WG_BAR();
}
__device__ __forceinline__ void g2_scan(unsigned char* gs, int p) {
    const int bh = p >> 14, rem = p & 16383, e = rem >> 6, d2 = (rem & 63) * 2;
    const float* LT = (const float*)(gs + GLA_LT); const float* DEC = (const float*)(gs + GLA_DEC); bf16_t* ST = (bf16_t*)(gs + GLA_ST);
    float s0 = 0.f, s1 = 0.f;
    for (int c0 = 0; c0 < 64; c0 += 16) {
        f32x2 dc[16], lv[16];
#pragma unroll
        for (int i = 0; i < 16; ++i) { const size_t u = (size_t)bh * 64 + c0 + i; dc[i] = *(const f32x2*)(DEC + u * 128 + d2); lv[i] = *(const f32x2*)(LT + (u * 256 + e) * 128 + d2); }
#pragma unroll
        for (int i = 0; i < 16; ++i) { const size_t u = (size_t)bh * 64 + c0 + i;
            *(unsigned*)(ST + (u * 256 + e) * 128 + d2) = cvt_pk_bf16(s0, s1);
            s0 = dc[i].x * s0 + lv[i].x; s1 = dc[i].y * s1 + lv[i].y; }
    }
}
__device__ __forceinline__ void g3_unit(LAS unsigned char* lds, const bf16_t* UN, unsigned char* gs, const float* ggla, bf16_t* MIX, int u, int tid, int wave, int lane) {
    const int c = u & 63, h = (u >> 6) & 3, b = u >> 8; const size_t tok0 = (size_t)b * SEQ + c * 64;
    LAS bf16_t* QT = (LAS bf16_t*)lds; LAS bf16_t* STs = (LAS bf16_t*)(lds + 17408); LAS float* OT = (LAS float*)lds;
    const bf16_t* QTg = (const bf16_t*)(gs + GLA_QT) + (size_t)u * 64 * 128; const bf16_t* ST = (const bf16_t*)(gs + GLA_ST) + (size_t)u * 256 * 128;
#pragma unroll
    for (int i = 0; i < 2; ++i) { const int id = tid + 512 * i, row = id >> 4, ch = id & 15; *(LAS u32x4*)(QT + row * PQ + ch * 8) = *(const u32x4*)(QTg + row * 128 + ch * 8); }
#pragma unroll
    for (int i = 0; i < 8; ++i) { const int id = tid + 512 * i, row = id >> 4, ch = id & 15; *(LAS u32x4*)(STs + row * PQ + ch * 8) = *(const u32x4*)(ST + row * 128 + ch * 8); }
    const int r = lane & 31, hh = lane >> 5;
    const float* OI = (const float*)(gs + GLA_OI) + (size_t)u * 64 * 256;
    bf16x8 gvv[4]; f32x4 ggv[8];
    { const int t = tid >> 3, part = tid & 7; const bf16_t* gbp = UN + (tok0 + t) * UNW + UN_GB + h * 256 + part * 32; const float* gg = ggla + h * 256 + part * 32;
#pragma unroll
      for (int q = 0; q < 4; ++q) gvv[q] = *(const bf16x8*)(gbp + 8 * q);
#pragma unroll
      for (int q = 0; q < 8; ++q) ggv[q] = *(const f32x4*)(gg + 4 * q); }
    f32x16 acc[2];
#pragma unroll
    for (int tb = 0; tb < 2; ++tb)
#pragma unroll
        for (int i = 0; i < 16; ++i) acc[tb][i] = OI[(size_t)(32 * tb + crow(i, hh)) * 256 + 32 * wave + r];
    WG_BAR();
#pragma unroll
    for (int tb = 0; tb < 2; ++tb) acc[tb] = mma_lds(QT + 32 * tb * PQ, PQ, STs + 32 * wave * PQ, PQ, 128, acc[tb], r, hh);
    WG_BAR();
#pragma unroll
    for (int tb = 0; tb < 2; ++tb)
#pragma unroll
        for (int i = 0; i < 16; ++i) OT[(32 * tb + crow(i, hh)) * 260 + 32 * wave + r] = acc[tb][i];
    WG_BAR();
    { const int t = tid >> 3, part = tid & 7; const LAS float* op = OT + t * 260 + part * 32; float v[32]; float ss = 0.f;
#pragma unroll
      for (int q = 0; q < 8; ++q) { const f32x4 x = *(const LAS f32x4*)(op + 4 * q); v[4 * q] = x[0]; v[4 * q + 1] = x[1]; v[4 * q + 2] = x[2]; v[4 * q + 3] = x[3]; ss += x[0] * x[0] + x[1] * x[1] + x[2] * x[2] + x[3] * x[3]; }
      ss += shfl_xor_l(ss, 1, lane); ss += shfl_xor_l(ss, 2, lane); ss += shfl_xor_l(ss, 4, lane);
      const float rs = rsqrtf(ss * (1.f / 256.f) + EPS);
      bf16_t* mp = MIX + (tok0 + t) * D + 2048 + h * 256 + part * 32;
#pragma unroll
      for (int q = 0; q < 4; ++q) { const bf16x8 gv = gvv[q]; float o[8];
#pragma unroll
          for (int e = 0; e < 8; ++e) { const float g = bf2f((bf16_t)gv[e]); o[e] = v[8 * q + e] * rs * ggv[2 * q + (e >> 2)][e & 3] * (g / (1.f + __expf(-g))); }
          u32x4 w; w.x = cvt_pk_bf16(o[0], o[1]); w.y = cvt_pk_bf16(o[2], o[3]); w.z = cvt_pk_bf16(o[4], o[5]); w.w = cvt_pk_bf16(o[6], o[7]);
          *(u32x4*)(mp + 8 * q) = w; } }
    WG_BAR();
}
}

template <int W> __device__ __forceinline__ void pool_window(LAS bf16_t* DT, const bf16_t* UN, size_t tok0, int g, int tid) {
    constexpr int PD = 264, NR = W - 1 + 8;
    const int cg = tid & 31, seg = tid >> 5, tf = (int)(tok0 & (SEQ - 1)) + 8 * seg;
    const bf16_t* up = UN + (tok0 + 8 * seg) * UNW + UN_UC + g * 256 + 8 * cg;
    bf16x8 x[NR];
#pragma unroll
    for (int k = 0; k < NR; ++k) { const int rel = k - (W - 1); bf16x8 z;
#pragma unroll
        for (int e = 0; e < 8; ++e) z[e] = 0;
        x[k] = (tf + rel >= 0) ? *(const bf16x8*)(up + (ptrdiff_t)rel * UNW) : z; }
    float s[8];
#pragma unroll
    for (int e = 0; e < 8; ++e) s[e] = 0.f;
#pragma unroll
    for (int k = 0; k < W - 1; ++k)
#pragma unroll
        for (int e = 0; e < 8; ++e) s[e] += bf2f((bf16_t)x[k][e]);
#pragma unroll
    for (int i = 0; i < 8; ++i) { const int t = tf + i; const float rc = __builtin_amdgcn_rcpf((float)((t + 1 < W) ? t + 1 : W)); float o[8];
#pragma unroll
        for (int e = 0; e < 8; ++e) { const float ut = bf2f((bf16_t)x[W - 1 + i][e]); s[e] += ut; o[e] = s[e] * rc - ut; s[e] -= bf2f((bf16_t)x[i][e]); }
        u32x4 wv; wv.x = cvt_pk_bf16(o[0], o[1]); wv.y = cvt_pk_bf16(o[2], o[3]); wv.z = cvt_pk_bf16(o[4], o[5]); wv.w = cvt_pk_bf16(o[6], o[7]);
        *(LAS u32x4*)(DT + (8 * seg + i) * PD + 8 * cg) = wv; }
}
__device__ __forceinline__ void pool_unit(LAS unsigned char* lds, const bf16_t* UN, const bf16_t* WP, const float* pscale, bf16_t* MIX, int pu, int tid, int wave, int lane) {
    const int g = pu & 3, rb = pu >> 2; const size_t tok0 = (size_t)rb * 128;
    LAS bf16_t* DT = (LAS bf16_t*)lds; constexpr int PD = 264;
    const bf16_t* bp = WP + (size_t)g * 65536 + (size_t)(32 * wave + (lane & 31)) * 256 + 8 * (lane >> 5);
    bf16x8 bfr[16];
#pragma unroll
    for (int ks = 0; ks < 16; ++ks) bfr[ks] = *(const bf16x8*)(bp + 16 * ks);
    const float sc = pscale[g * 256 + 32 * wave + (lane & 31)];
    if (g == 0) pool_window<2>(DT, UN, tok0, g, tid); else if (g == 1) pool_window<4>(DT, UN, tok0, g, tid); else if (g == 2) pool_window<8>(DT, UN, tok0, g, tid); else pool_window<16>(DT, UN, tok0, g, tid);
    WG_BAR();
    const int r = lane & 31, hh = lane >> 5;
    f32x16 acc[4];
#pragma unroll
    for (int mb = 0; mb < 4; ++mb)
#pragma unroll
        for (int i = 0; i < 16; ++i) acc[mb][i] = 0.f;
#pragma unroll
    for (int ks = 0; ks < 16; ++ks) {
#pragma unroll
        for (int mb = 0; mb < 4; ++mb) acc[mb] = MFMA32(*(const LAS bf16x8*)(DT + (32 * mb + r) * PD + 16 * ks + 8 * hh), bfr[ks], acc[mb]); }
    const int n = 32 * wave + r;
#pragma unroll
    for (int mb = 0; mb < 4; ++mb)
#pragma unroll
        for (int i = 0; i < 16; ++i) MIX[(tok0 + 32 * mb + crow(i, hh)) * D + 3072 + g * 256 + n] = f2bf(acc[mb][i] * sc);
    WG_BAR();
}

#define LDS_WAIT() asm volatile("s_waitcnt lgkmcnt(0)" ::: "memory")
#define VM_WAIT() asm volatile("s_waitcnt vmcnt(0)" ::: "memory")
__device__ __forceinline__ unsigned pk2(float lo, float hi) { return (unsigned)f2bf(lo) | ((unsigned)f2bf(hi) << 16); }

struct CvtItem { const float* W; bf16_t* Wt; const float* gk; int ldw, srccol, nvalid, K, dstrow, k0, hasg; };
__device__ __forceinline__ void cvt_load(const CvtItem& d, f32x4 (&v)[8], f32x4 (&g)[2], int lane) {
    const int n4 = lane & 7, kr = lane >> 3;
    { const float* gp = d.gk + (d.hasg ? d.k0 : (d.k0 & 4095)) + 8 * (lane & 7);
      g[0] = *(const f32x4*)gp; g[1] = *(const f32x4*)(gp + 4); }
    const int c4 = 4 * n4 < d.nvalid ? 4 * n4 : d.nvalid - 4;
    const float* p = d.W + (size_t)(d.k0 + kr) * d.ldw + d.srccol + c4;
#pragma unroll
    for (int i = 0; i < 8; ++i) v[i] = *(const f32x4*)(p + (size_t)(8 * i) * d.ldw);
}
__device__ __forceinline__ void cvt_store(const CvtItem& d, const f32x4 (&v)[8], const f32x4 (&g)[2], LAS float* scr, int lane) {
    { const int n4 = lane & 7, kr = lane >> 3;
#pragma unroll
      for (int i = 0; i < 8; ++i)
#pragma unroll
          for (int e = 0; e < 4; ++e) scr[(kr + 8 * i) * 33 + 4 * n4 + e] = v[i][e]; }
    LDS_WAIT(); asm volatile("" ::: "memory");
    const int c8 = lane & 7; const int k0 = d.k0;
#pragma unroll
    for (int j = 0; j < 4; ++j) { const int n = (lane >> 3) + 8 * j; const LAS float* s = scr + (8 * c8) * 33 + n;
        const float z = n < d.nvalid ? 1.f : 0.f; const f32x4 one4 = {1.f, 1.f, 1.f, 1.f}; const f32x4 ga = (d.hasg ? g[0] : one4) * z, gb = (d.hasg ? g[1] : one4) * z;
        u32x4 o; o.x = cvt_pk_bf16(s[0 * 33] * ga[0], s[1 * 33] * ga[1]); o.y = cvt_pk_bf16(s[2 * 33] * ga[2], s[3 * 33] * ga[3]); o.z = cvt_pk_bf16(s[4 * 33] * gb[0], s[5 * 33] * gb[1]); o.w = cvt_pk_bf16(s[6 * 33] * gb[2], s[7 * 33] * gb[3]);
        *(u32x4*)(d.Wt + (size_t)(d.dstrow + n) * d.K + k0 + 8 * c8) = o; }
    LDS_WAIT(); asm volatile("" ::: "memory");
}
__device__ __forceinline__ int win_src_col(int d) {
    if (d < 2048) return d + (SRC_QA - 0);
    if (d < 4096) return d + (SRC_KA - 2048);
    if (d < 4608) return d + (SRC_QB - 4096);
    if (d < 5120) return d + (SRC_KB - 4608);
    if (d < 6144) return d + (SRC_GB - 5120);
    if (d < 7168) return d + (SRC_UC - 6144);
    if (d < 9216) return d + (SRC_VA - 7168);
    return d + (SRC_VB - 9216);
}
constexpr int I_IN = 64 * 320, I_Z = 64, I_O = 64 * 128, I_UP = 64 * 688, I_DN = 172 * 128, I_P = 128, I_LAYER = I_IN + I_Z + I_O + I_UP + I_DN + I_P;

__device__ __forceinline__ void res_row(const float* X, bf16_t* Hb, const bf16_t* Y, const f32x4 (&gv)[16], float* RS, float* OUT, int row, int lane) {
    f32x4 hv[16];
    if (X) { const f32x4* src = (const f32x4*)(X + (size_t)row * D) + lane;
#pragma unroll
        for (int j = 0; j < 16; ++j) hv[j] = src[64 * j];
    } else { const u32x2* src = (const u32x2*)(Hb + (size_t)row * D) + lane;
#pragma unroll
        for (int j = 0; j < 16; ++j) { const u32x2 w = src[64 * j]; hv[j] = (f32x4){__uint_as_float(w.x << 16), __uint_as_float(w.x & 0xffff0000u), __uint_as_float(w.y << 16), __uint_as_float(w.y & 0xffff0000u)}; } }
    if (Y) {
        const u32x2* yp = (const u32x2*)(Y + (size_t)row * D) + lane;
        f32x4 yv[16]; float s = 0.f;
#pragma unroll
        for (int j = 0; j < 16; ++j) { const u32x2 w = yp[64 * j]; yv[j] = (f32x4){__uint_as_float(w.x << 16), __uint_as_float(w.x & 0xffff0000u), __uint_as_float(w.y << 16), __uint_as_float(w.y & 0xffff0000u)}; s += yv[j].x * yv[j].x + yv[j].y * yv[j].y + yv[j].z * yv[j].z + yv[j].w * yv[j].w; }
        const float rs = rsqrtf(wave_sum_l(s, lane) * (1.f / D) + EPS);
#pragma unroll
        for (int j = 0; j < 16; ++j) hv[j] += yv[j] * rs * gv[j];
    }
    if (OUT) {
        f32x4* hp = (f32x4*)(OUT + (size_t)row * D) + lane;
#pragma unroll
        for (int j = 0; j < 16; ++j) hp[64 * j] = hv[j];
    } else {
        float s = 0.f;
#pragma unroll
        for (int j = 0; j < 16; ++j) s += hv[j].x * hv[j].x + hv[j].y * hv[j].y + hv[j].z * hv[j].z + hv[j].w * hv[j].w;
        const float sst = wave_sum_l(s, lane);
        if (lane == 0) RS[row] = sst;
        u32x2* op = (u32x2*)(Hb + (size_t)row * D) + lane;
#pragma unroll
        for (int j = 0; j < 16; ++j) { u32x2 o; o.x = cvt_pk_bf16(hv[j].x, hv[j].y); o.y = cvt_pk_bf16(hv[j].z, hv[j].w); op[64 * j] = o; }
    }
}

__device__ __forceinline__ void zlr_rows(const bf16_t* HN, const bf16_t* WZ, const float* RS, int nslot, float* ZLR, int rb, LAS unsigned char* lds, int tid, int wave, int lane) {
    const int r = lane & 31, h = lane >> 5;
    f32x16 acc;
#pragma unroll
    for (int e = 0; e < 16; ++e) acc[e] = 0.f;
    const bf16_t* ap = HN + (size_t)(rb * 32 + r) * D + wave * 512 + 8 * h;
    const bf16_t* bp = WZ + (size_t)r * D + wave * 512 + 8 * h;
    const float rst = pg8::row_rstd(RS, nslot, rb * 32 + (tid >> 4));
#pragma unroll 16
    for (int k = 0; k < 512; k += 16) acc = __builtin_amdgcn_mfma_f32_32x32x16_bf16(*(const bf16x8*)(ap + k), *(const bf16x8*)(bp + k), acc, 0, 0, 0);
    LAS float* red = (LAS float*)lds;
    if (r < 16) {
#pragma unroll
        for (int e = 0; e < 16; ++e) red[(wave * 32 + (e & 3) + 8 * (e >> 2) + 4 * h) * 16 + r] = acc[e];
    }
    __syncthreads();
    { const int row = tid >> 4, n = tid & 15; float s = 0.f;
#pragma unroll
      for (int w = 0; w < 8; ++w) s += red[(w * 32 + row) * 16 + n];
      ZLR[(size_t)(rb * 32 + row) * 16 + n] = s * rst; }
    __syncthreads();
}


__device__ __forceinline__ void fix_rows(const float* ZB, const float* wc, const float* bc, bf16_t* F, int it) {
    const int c4 = it % (DFF / 4), rest = it / (DFF / 4), rr = rest & 1, ti = rest >> 1, pm = ti + 1 + ti / 15, c0 = c4 * 4;
    const float* zb = ZB + (size_t)pm * 4 * NUP; const float* zp = zb - (size_t)4 * NUP;
    const float* r0 = zb + (size_t)rr * NUP; const float* r1 = rr ? zb : zp + (size_t)3 * NUP; const float* r2 = rr ? zp + (size_t)3 * NUP : zp + (size_t)2 * NUP;
    const f32x4 g0 = *(const f32x4*)(r0 + c0), g1 = *(const f32x4*)(r1 + c0), g2 = *(const f32x4*)(r2 + c0), v0 = *(const f32x4*)(r0 + DFF + c0), v1 = *(const f32x4*)(r1 + DFF + c0), v2 = *(const f32x4*)(r2 + DFF + c0);
    const f32x4 wg0 = *(const f32x4*)(wc + c0), wg1 = *(const f32x4*)(wc + NUP + c0), wg2 = *(const f32x4*)(wc + 2 * NUP + c0), wv0 = *(const f32x4*)(wc + DFF + c0), wv1 = *(const f32x4*)(wc + NUP + DFF + c0), wv2 = *(const f32x4*)(wc + 2 * NUP + DFF + c0);
    const f32x4 gt = *(const f32x4*)(bc + c0) + wg0 * g2 + wg1 * g1 + wg2 * g0, vl = *(const f32x4*)(bc + DFF + c0) + wv0 * v2 + wv1 * v1 + wv2 * v0;
    u32x2 w; w.x = cvt_pk_bf16(pg8::gelu_tanh_e(gt[0]) * vl[0], pg8::gelu_tanh_e(gt[1]) * vl[1]); w.y = cvt_pk_bf16(pg8::gelu_tanh_e(gt[2]) * vl[2], pg8::gelu_tanh_e(gt[3]) * vl[3]);
    *(u32x2*)(F + (size_t)(pm * 256 + rr) * DFF + c0) = w;
}
__device__ __forceinline__ float gelu_tanh_fast(float x) { const float u = 1.5957691216057308f * (x + 0.044715f * x * x * x); return x / (1.f + __expf(-u)); }
__device__ __forceinline__ void conv_run(const bf16_t* Z, const float* wc, const float* bc, bf16_t* F, int run, int tid) {
    const size_t t0 = (size_t)run * 32; const bool first = ((run * 32) & (SEQ - 1)) == 0;
    for (int oc = tid; oc < DFF / 8; oc += 512) {
        const int c0 = oc * 8;
        float wg[3][8], wv[3][8], bg[8], bv[8];
#pragma unroll
        for (int j = 0; j < 3; ++j)
#pragma unroll
            for (int q = 0; q < 2; ++q) { const f32x4 a = *(const f32x4*)(wc + (size_t)j * NUP + c0 + 4 * q), b = *(const f32x4*)(wc + (size_t)j * NUP + DFF + c0 + 4 * q);
#pragma unroll
                for (int e = 0; e < 4; ++e) { wg[j][4 * q + e] = a[e]; wv[j][4 * q + e] = b[e]; } }
#pragma unroll
        for (int q = 0; q < 2; ++q) { const f32x4 a = *(const f32x4*)(bc + c0 + 4 * q), b = *(const f32x4*)(bc + DFF + c0 + 4 * q);
#pragma unroll
            for (int e = 0; e < 4; ++e) { bg[4 * q + e] = a[e]; bv[4 * q + e] = b[e]; } }
        float g2[8], g1[8], v2[8], v1[8];
        if (first) {
#pragma unroll
            for (int e = 0; e < 8; ++e) { g2[e] = 0.f; g1[e] = 0.f; v2[e] = 0.f; v1[e] = 0.f; }
        } else {
            const bf16x8 a2 = *(const bf16x8*)(Z + (t0 - 2) * NUP + c0), a1 = *(const bf16x8*)(Z + (t0 - 1) * NUP + c0), b2 = *(const bf16x8*)(Z + (t0 - 2) * NUP + DFF + c0), b1 = *(const bf16x8*)(Z + (t0 - 1) * NUP + DFF + c0);
#pragma unroll
            for (int e = 0; e < 8; ++e) { g2[e] = bf2f((bf16_t)a2[e]); g1[e] = bf2f((bf16_t)a1[e]); v2[e] = bf2f((bf16_t)b2[e]); v1[e] = bf2f((bf16_t)b1[e]); }
        }
#pragma unroll 4
        for (int r = 0; r < 32; ++r) {
            const bf16x8 a0 = *(const bf16x8*)(Z + (t0 + r) * NUP + c0), b0 = *(const bf16x8*)(Z + (t0 + r) * NUP + DFF + c0);
            float o[8];
#pragma unroll
            for (int e = 0; e < 8; ++e) { const float g0 = bf2f((bf16_t)a0[e]), v0 = bf2f((bf16_t)b0[e]);
                const float gt = bg[e] + wg[0][e] * g2[e] + wg[1][e] * g1[e] + wg[2][e] * g0, vl = bv[e] + wv[0][e] * v2[e] + wv[1][e] * v1[e] + wv[2][e] * v0;
                o[e] = gelu_tanh_fast(gt) * vl; g2[e] = g1[e]; g1[e] = g0; v2[e] = v1[e]; v1[e] = v0; }
            u32x4 w; w.x = cvt_pk_bf16(o[0], o[1]); w.y = cvt_pk_bf16(o[2], o[3]); w.z = cvt_pk_bf16(o[4], o[5]); w.w = cvt_pk_bf16(o[6], o[7]);
            *(u32x4*)(F + (t0 + r) * DFF + c0) = w;
        }
    }
}

constexpr int NPH = 21;
struct Args { const float* in[21]; float* out; unsigned char* ws; int ph_lo, ph_hi; };

__device__ __forceinline__ const void* lds_ptr(volatile LAS unsigned* A, int i) {
    const unsigned lo = __builtin_amdgcn_readfirstlane(A[2 * i]), hi = __builtin_amdgcn_readfirstlane(A[2 * i + 1]);
    return (const void*)(const GAS void*)(((unsigned long long)hi << 32) | (unsigned long long)lo);
}
constexpr int ARGS_OFF = RING_BYTES + 1024;
#define FRESH_TID() int lane = fresh_lane(); const int tid = wave * 64 + lane
#define P(i) ((const float*)lds_ptr(AP, (i)))
#define WSP() ((unsigned char*)lds_ptr(AP, 22))
#define IN(k) (lo <= (k) && (k) < hi)
#define BOTH(k) (IN(k) && IN((k) + 1))
#define GRID_BAR(k) do { if (BOTH(k)) { XcdBarrier b_; b_.bar = (unsigned*)(WSP() + WS_CTL) + CW_BAR; b_.x = xb_xcc_id(); b_.st = MISC + 8; b_.wave = wave; xcd_barrier(b_); } } while (0)
#define REP(k) _Pragma("unroll") for (int rep_ = 0; rep_ < ((k) == MK_DOUBLE_PHASE ? 2 : 1); ++rep_)
__device__ __forceinline__ CvtItem cvt_decode(int it, unsigned char* ws, volatile LAS unsigned* AP) {
    CvtItem d; d.gk = nullptr; d.nvalid = 32; d.hasg = 1;
    const int l = it >= I_LAYER ? 1 : 0; int r = it - l * I_LAYER;
    unsigned char* wl = ws + WS_W0 + (size_t)l * W_LAYER;
    if (r < I_IN) { const int kb = r / 320, nb = r % 320, d0 = nb * 32; d.W = P(1) + (size_t)l * D * NIN; d.ldw = NIN; d.srccol = win_src_col(d0); d.Wt = (bf16_t*)(wl + OFF_WN); d.K = D; d.dstrow = d0; d.k0 = kb * 64; d.gk = P(17) + (size_t)l * D; if (!d.gk) { d.gk = P(17); d.hasg = 0; } return d; } r -= I_IN;
    if (r < I_Z) { d.W = P(1) + (size_t)l * D * NIN; d.ldw = NIN; d.srccol = SRC_ZLR; d.nvalid = 16; d.Wt = (bf16_t*)(wl + OFF_WZ); d.K = D; d.dstrow = 0; d.k0 = r * 64; d.gk = P(17) + (size_t)l * D; if (!d.gk) { d.gk = P(17); d.hasg = 0; } return d; } r -= I_Z;
    if (r < I_O) { const int kb = r / 128, nb = r % 128; d.W = P(12) + (size_t)l * D * D; d.ldw = D; d.srccol = nb * 32; d.Wt = (bf16_t*)(wl + OFF_WO); d.K = D; d.dstrow = nb * 32; d.k0 = kb * 64; if (!d.gk) { d.gk = P(17); d.hasg = 0; } return d; } r -= I_O;
    if (r < I_UP) { const int kb = r / 688, nb = r % 688, d0 = nb * 32;
        d.W = P(13) + (size_t)l * D * NUP; d.ldw = NUP; d.srccol = ((d0 >> 7) & 1) * DFF + 128 * (d0 >> 8) + (d0 & 127); d.Wt = (bf16_t*)(wl + OFF_WUP); d.K = D; d.dstrow = d0; d.k0 = kb * 64; d.gk = P(19) + (size_t)l * D; if (!d.gk) { d.gk = P(17); d.hasg = 0; } return d; } r -= I_UP;
    if (r < I_DN) { const int kb = r / 128, nb = r % 128; d.W = P(16) + (size_t)l * DFF * D; d.ldw = D; d.srccol = nb * 32; d.Wt = (bf16_t*)(wl + OFF_WDN); d.K = DFF; d.dstrow = nb * 32; d.k0 = kb * 64; if (!d.gk) { d.gk = P(17); d.hasg = 0; } return d; } r -= I_DN;
    { const int g = r >> 5, kb = (r >> 3) & 3, nb = r & 7; d.W = P(10) + ((size_t)l * 4 + g) * 65536; d.ldw = 256; d.srccol = nb * 32; d.Wt = (bf16_t*)(wl + OFF_WP) + (size_t)g * 65536; d.K = 256; d.dstrow = nb * 32; d.k0 = kb * 64; }
    if (!d.gk) { d.gk = P(17); d.hasg = 0; }
    return d;
}
constexpr int I_EARLY = I_IN + I_Z + I_P, I_LATE = I_O + I_UP + I_DN, I_TAIL = 16384;
template <int SLOT> __device__ __forceinline__ int cvt_slot_item(int t) {
    if (SLOT == 0) return t < I_IN + I_Z ? t : t + I_LATE;
    if (SLOT == 1) { if (t < I_LATE) return I_IN + I_Z + t; const int u = t - I_LATE; return I_LAYER + (u < I_IN + I_Z ? u : u + I_LATE); }
    return I_LAYER + I_IN + I_Z + t;
}
template <int SLOT> __device__ __forceinline__ void cvt_stream(int first, int stride, int n, unsigned char* ws, volatile LAS unsigned* AP, LAS float* scr, int lane) {
    if (n <= 0) return;
    CvtItem dA = cvt_decode(cvt_slot_item<SLOT>(first), ws, AP), dB = dA; f32x4 vA[8], gA[2], vB[8], gB[2];
    cvt_load(dA, vA, gA, lane);
    for (int k = 0; k < n; k += 2) {
        const int iB = k + 1 < n ? k + 1 : n - 1;
        dB = cvt_decode(cvt_slot_item<SLOT>(first + iB * stride), ws, AP); cvt_load(dB, vB, gB, lane);
        cvt_store(dA, vA, gA, scr, lane);
        if (k + 1 >= n) break;
        const int iA = k + 2 < n ? k + 2 : n - 1;
        dA = cvt_decode(cvt_slot_item<SLOT>(first + iA * stride), ws, AP); cvt_load(dA, vA, gA, lane);
        cvt_store(dB, vB, gB, scr, lane);
    }
}
template <int l, int LO, int HI> __device__ __forceinline__ void layer_phases(LAS unsigned char* lds, volatile LAS unsigned* MISC, volatile LAS unsigned* AP, const int wave, const int G, const int bx, const int vcu, const int gw, const int NGW) {
    constexpr int lo = LO, hi = HI;

        const int pb = 1 + 10 * l;
        if (IN(pb + 0)) REP(pb + 0) {
            unsigned char* ws = WSP(); unsigned char* wl = ws + WS_W0 + (size_t)l * W_LAYER;
            const bf16_t* HN = (const bf16_t*)(ws + WS_HN);
            { pg8::Gemm g; g.A[0] = HN; g.Bt[0] = (const bf16_t*)(wl + OFF_WN); g.A[1] = (const bf16_t*)(wl + OFF_WT); g.Bt[1] = HN; g.lda = D; g.ldb = D; g.K = D;
              pg8::Order2 S; S.nM0 = M / 256; S.nN0 = UNW / 256; S.nM1 = UTW / 256; S.nN1 = M / 256; S.G = G; S.c = bx;
              pg8::EpiBf16 E; E.O[0] = (bf16_t*)(ws + WS_UN); E.ldc[0] = UNW; E.O[1] = (bf16_t*)(ws + WS_UT); E.ldc[1] = M; E.rs = (const float*)(ws + WS_RS); E.nslot = 1; E.nostore = MK_SHADOW ? rep_ : 0;
              E.kmax = (unsigned*)(ws + WS_CTL) + CW_KMAX + l * 2048; E.nrm = lds + pg8::STAGE_BYTES;
              pg8::gemm_phase<pg8::EpiBf16, pg8::Order2, PG8_ALIGN, PG8_SP2>(lds, g, S, E, wave); }
            FRESH_TID();
            for (int rb = bx; rb < M / 32; rb += G) zlr_rows(HN, (const bf16_t*)(wl + OFF_WZ), (const float*)(ws + WS_RS), 1, (float*)(ws + WS_ZLR), rb, lds, tid, wave, lane);
            GRID_BAR(pb + 0);
        }
        if (IN(pb + 1)) REP(pb + 1) {
            FRESH_TID();
            unsigned char* ws = WSP(); unsigned char* gs = ws + WS_GLA;
            const bf16_t* UN = (const bf16_t*)(ws + WS_UN); const bf16_t* UT = (const bf16_t*)(ws + WS_UT); bf16_t* MIX = (bf16_t*)(ws + WS_MIX);
            { const float* w2 = P(2) + (size_t)l * 16 * 512; const float* bgt = P(3) + (size_t)l * 512; const float* ZLR = (const float*)(ws + WS_ZLR);
              FRESH_TID();
              for (int u = vcu; u < 512; u += G) gla::g1_unit(lds, UN, UT, ZLR, w2, bgt, gs, u, tid, wave, lane); }
            { const bf16_t* WP = (const bf16_t*)(ws + WS_W0 + (size_t)l * W_LAYER + OFF_WP); const float* psc = P(11) + (size_t)l * 1024;
              FRESH_TID();
              for (int pu = vcu; pu < 256; pu += G) pool_unit(lds, UN, WP, psc, MIX, pu, tid, wave, lane); }
            { const float lam_init = 0.8f - 0.6f * expf(-0.3f * (float)l);
              float lam; { const float* q1 = P(4) + l * 128; const float* k1 = P(5) + l * 128; const float* q2 = P(6) + l * 128; const float* k2 = P(7) + l * 128;
                const float s1 = wave_sum_l(q1[lane] * k1[lane] + q1[lane + 64] * k1[lane + 64], lane), s2 = wave_sum_l(q2[lane] * k2[lane] + q2[lane + 64] * k2[lane + 64], lane);
                lam = expf(s1) - expf(s2) + lam_init; }
              lam = __uint_as_float(__builtin_amdgcn_readfirstlane(__float_as_uint(lam)));
              const float* gsub = P(8) + l * 256;
              FRESH_TID();
              unsigned* ctl = (unsigned*)(ws + WS_CTL);
              if (tid < 256) ((LAS float*)(lds + att::GSUB_OFF))[tid] = gsub[tid];
              for (;;) {
                  if (tid == 0) MISC[16] = __hip_atomic_fetch_add(ctl + CW_QUEUE + l * 64 + 32 * rep_, 1u, __ATOMIC_RELAXED, __HIP_MEMORY_SCOPE_AGENT);
                  __syncthreads();
                  const int idx = __builtin_amdgcn_readfirstlane((int)MISC[16]);
                  __syncthreads();
                  constexpr int NSLOT = ((l == 0) ? I_LAYER : I_LATE) - I_TAIL, NCH = (NSLOT + 127) / 128, NQ = 512 + NCH;
                  if (idx >= NQ) break;
                  int a0, a1;
                  if (idx < 256) { a0 = idx; a1 = idx + 1; }
                  else { const int p_ = idx - 256; constexpr int NQ2 = 256 + NCH; a0 = 256 + (int)(((long long)p_ * 256) / NQ2); a1 = 256 + (int)(((long long)(p_ + 1) * 256) / NQ2); }
                  if (a1 > a0) att::unit(lds, UN, UT, MIX, ctl + CW_KMAX + l * 2048, a0 & 1, 7 - ((a0 >> 1) & 7), 31 - (a0 >> 4), lam, nullptr, 1.f - lam_init, wave, lane, MK_SHADOW * rep_);
                  else { if (rep_ == 0) { FRESH_TID(); const int f_ = (idx - a0) * 128 + wave, r_ = (NSLOT - f_ + 7) / 8;     cvt_stream<l == 0 ? 1 : 2>(f_, 8, f_ < NSLOT ? (r_ < 16 ? r_ : 16) : 0, ws, AP, (LAS float*)(lds + wave * 16384), lane); }
                         __syncthreads(); } } }
            GRID_BAR(pb + 1);
        }
        if (IN(pb + 2)) REP(pb + 2) {
            FRESH_TID();
            unsigned char* gs = WSP() + WS_GLA;
            for (int p = vcu * 512 + tid; p < 131072; p += G * 512) gla::g2_scan(gs, p);
            GRID_BAR(pb + 2);
        }
        if (IN(pb + 3)) REP(pb + 3) {
            FRESH_TID();
            unsigned char* ws = WSP(); unsigned char* gs = ws + WS_GLA; const float* gg = P(9) + (size_t)l * 1024;
            for (int u = vcu; u < 512; u += G) gla::g3_unit(lds, (const bf16_t*)(ws + WS_UN), gs, gg, (bf16_t*)(ws + WS_MIX), u, tid, wave, lane);
            GRID_BAR(pb + 3);
        }
        if (IN(pb + 4)) {
            unsigned char* ws = WSP(); unsigned char* wl = ws + WS_W0 + (size_t)l * W_LAYER;
            pg8::Gemm g; g.A[0] = (const bf16_t*)(ws + WS_MIX); g.Bt[0] = (const bf16_t*)(wl + OFF_WO); g.A[1] = g.A[0]; g.Bt[1] = g.Bt[0]; g.lda = D; g.ldb = D; g.K = D;
            pg8::Order2 S; S.nM0 = M / 256; S.nN0 = D / 256; S.nM1 = 0; S.nN1 = 1; S.G = G; S.c = bx;
            pg8::EpiBf16 E; E.O[0] = (bf16_t*)(ws + WS_Y); E.ldc[0] = D; E.O[1] = E.O[0]; E.ldc[1] = D; E.rs = nullptr; E.nslot = 0;
            pg8::gemm_phase<pg8::EpiBf16, pg8::Order2, PG8_ALIGN, PG8_SP2>(lds, g, S, E, wave);
            GRID_BAR(pb + 4);
        }
        if (IN(pb + 5)) {
            FRESH_TID();
            unsigned char* ws = WSP(); const bf16_t* Y = (const bf16_t*)(ws + WS_Y); const float* gp = P(18) + (size_t)l * D; bf16_t* HN = (bf16_t*)(ws + WS_HN); float* RS = (float*)(ws + WS_RS);
            f32x4 gv[16];
#pragma unroll
            for (int j = 0; j < 16; ++j) gv[j] = ((const f32x4*)gp)[lane + 64 * j];
            for (int m = gw; m < M; m += NGW) res_row(nullptr, HN, Y, gv, RS, nullptr, m, lane);
            GRID_BAR(pb + 5);
        }
        if (IN(pb + 6)) REP(pb + 6) {
            unsigned char* ws = WSP(); unsigned char* wl = ws + WS_W0 + (size_t)l * W_LAYER;
            pg8::Gemm g; g.A[0] = (const bf16_t*)(ws + WS_HN); g.Bt[0] = (const bf16_t*)(wl + OFF_WUP); g.A[1] = g.A[0]; g.Bt[1] = g.Bt[0]; g.lda = D; g.ldb = D; g.K = D;
            pg8::Order2 S; S.nM0 = M / 256; S.nN0 = NUP / 256; S.nM1 = 0; S.nN1 = 1; S.G = G; S.c = bx;
            pg8::EpiConvGlu E; E.F = (bf16_t*)(ws + WS_F); E.ZB = (float*)(ws + WS_ZB); E.wcv = P(14) + (size_t)l * 3 * NUP; E.bcv = P(15) + (size_t)l * NUP; E.rs = (const float*)(ws + WS_RS); E.nslot = 1; E.halo = lds + 131072;
            pg8::gemm_phase<pg8::EpiConvGlu, pg8::Order2, PG8_ALIGN, PG8_SP2>(lds, g, S, E, wave);
            if (rep_ == 0) { const int nwg_ = G < 64 ? G : 64;
                if (bx >= G - nwg_) { FRESH_TID(); const int w_ = (bx - (G - nwg_)) * 8 + wave, nw_ = nwg_ * 8;
                    cvt_stream<l == 0 ? 1 : 2>(((l == 0) ? I_LAYER : I_LATE) - I_TAIL + w_, nw_, (I_TAIL - w_ + nw_ - 1) / nw_, ws, AP, (LAS float*)(lds + wave * 16384), lane); } }
            GRID_BAR(pb + 6);
        }
        if (IN(pb + 7)) REP(pb + 7) {
            FRESH_TID();
            unsigned char* ws = WSP(); const float* wc = P(14) + (size_t)l * 3 * NUP; const float* bc = P(15) + (size_t)l * NUP;
            for (int it = vcu * 512 + tid; it < 30 * 2 * (DFF / 4); it += G * 512) fix_rows((const float*)(ws + WS_ZB), wc, bc, (bf16_t*)(ws + WS_F), it);
            GRID_BAR(pb + 7);
        }
        if (IN(pb + 8)) {
            unsigned char* ws = WSP(); unsigned char* wl = ws + WS_W0 + (size_t)l * W_LAYER;
            pg8::Gemm g; g.A[0] = (const bf16_t*)(ws + WS_F); g.Bt[0] = (const bf16_t*)(wl + OFF_WDN); g.A[1] = g.A[0]; g.Bt[1] = g.Bt[0]; g.lda = DFF; g.ldb = DFF; g.K = DFF;
            pg8::Order2 S; S.nM0 = M / 256; S.nN0 = D / 256; S.nM1 = 0; S.nN1 = 1; S.G = G; S.c = bx;
            pg8::EpiBf16 E; E.O[0] = (bf16_t*)(ws + WS_Y); E.ldc[0] = D; E.O[1] = E.O[0]; E.ldc[1] = D; E.rs = nullptr; E.nslot = 0;
            pg8::gemm_phase<pg8::EpiBf16, pg8::Order2, PG8_ALIGN, PG8_SP2>(lds, g, S, E, wave);
            GRID_BAR(pb + 8);
        }
        if (IN(pb + 9)) {
            FRESH_TID();
            unsigned char* ws = WSP(); const bf16_t* Y = (const bf16_t*)(ws + WS_Y); const float* gp = P(20) + (size_t)l * D; bf16_t* HN = (bf16_t*)(ws + WS_HN); float* RS = (float*)(ws + WS_RS);
            float* OUT = l + 1 < DEPTH ? nullptr : (float*)P(21);
            f32x4 gv[16];
#pragma unroll
            for (int j = 0; j < 16; ++j) gv[j] = ((const f32x4*)gp)[lane + 64 * j];
            for (int m = gw; m < M; m += NGW) res_row(nullptr, HN, Y, gv, RS, OUT, m, lane);
            GRID_BAR(pb + 9);
        }
}
template <int LO, int HI> __global__ void __launch_bounds__(512, 2) fwd(Args args) {
    extern __shared__ __attribute__((aligned(16))) unsigned char lds_raw[];
    LAS unsigned char* lds = (LAS unsigned char*)lds_raw;
    volatile LAS unsigned* MISC = (volatile LAS unsigned*)(lds + MISC_OFF);
    volatile LAS unsigned* AP = (volatile LAS unsigned*)(lds + ARGS_OFF);
    const int wave = __builtin_amdgcn_readfirstlane((int)threadIdx.x >> 6);
    const int G = gridDim.x; const int bx = blockIdx.x; const int vcu = (G % 8 == 0) ? (bx % 8) * (G / 8) + bx / 8 : bx;
    constexpr int lo = LO, hi = HI;
    for (int u = threadIdx.x; u < (LDS_BYTES - LDSCTL_OFF) / 4; u += 512) ((LAS unsigned*)(lds + LDSCTL_OFF))[u] = 0u;
    __syncthreads();
    if (threadIdx.x == 0) {
        volatile LAS unsigned long long* A8 = (volatile LAS unsigned long long*)(lds + ARGS_OFF);
#pragma unroll
        for (int i = 0; i < 21; ++i) A8[i] = (unsigned long long)args.in[i];
        A8[21] = (unsigned long long)args.out; A8[22] = (unsigned long long)args.ws;
    }
    __syncthreads();
    if (hi - lo > 1) (void)xcd_barrier_post((unsigned*)(WSP() + WS_CTL) + CW_BAR, MISC + 8);
    const int gw = vcu * 8 + wave, NGW = G * 8;

    if (IN(0)) REP(0) {
        FRESH_TID();
        unsigned char* ws = WSP();
        LAS float* scr = (LAS float*)(lds + wave * 16384);
        cvt_stream<0>(gw, NGW, gw < I_EARLY ? (I_EARLY - gw + NGW - 1) / NGW : 0, ws, AP, scr, lane);
        { const float* x = P(0); bf16_t* HN = (bf16_t*)(ws + WS_HN); float* RS = (float*)(ws + WS_RS);
          f32x4 gv[16];
#pragma unroll
          for (int j = 0; j < 16; ++j) gv[j] = (f32x4){0.f, 0.f, 0.f, 0.f};
          for (int m = gw; m < M; m += NGW) res_row(x, HN, nullptr, gv, RS, nullptr, m, lane); }
        GRID_BAR(0);
    }

    layer_phases<0, LO, HI>(lds, MISC, AP, wave, G, bx, vcu, gw, NGW);
    layer_phases<1, LO, HI>(lds, MISC, AP, wave, G, bx, vcu, gw, NGW);
}

static int g_grid = 0;
template <int LO, int HI> static void launch_range(hipStream_t stream, const Args& a) {
    static bool attr = false;
    if (!attr) { if (hipFuncSetAttribute((const void*)fwd<LO, HI>, hipFuncAttributeMaxDynamicSharedMemorySize, LDS_BYTES) != hipSuccess) fprintf(stderr, "kernel_launch: hipFuncSetAttribute failed\n"); attr = true; }
    hipLaunchKernelGGL((fwd<LO, HI>), dim3(g_grid), dim3(512), LDS_BYTES, stream, a);
    const hipError_t le = hipPeekAtLastError();
    if (le != hipSuccess) fprintf(stderr, "kernel_launch: fwd launch [%d,%d) failed: %s\n", LO, HI, hipGetErrorName(le));
}
template <int P> static void launch_each(hipStream_t stream, const Args& a) { if constexpr (P < NPH) { launch_range<P, P + 1>(stream, a); launch_each<P + 1>(stream, a); } }
extern "C" void kernel_launch(void* const* d_in, const int* in_sizes, int n_in, void* d_out, int out_size, void* d_ws, size_t ws_size, hipStream_t stream) {
    if (n_in != 21 || ws_size < WS_END) { fprintf(stderr, "kernel_launch: unexpected n_in %d or ws %zu < %zu\n", n_in, ws_size, (size_t)WS_END); return; }
    if (g_grid == 0) {
        int dev = 0, cus = 0;
        if (hipGetDevice(&dev) != hipSuccess || hipDeviceGetAttribute(&cus, hipDeviceAttributeMultiprocessorCount, dev) != hipSuccess) { fprintf(stderr, "kernel_launch: device query failed\n"); g_grid = -1; return; }
        int per_cu = 0;
        (void)hipFuncSetAttribute((const void*)fwd<0, NPH>, hipFuncAttributeMaxDynamicSharedMemorySize, LDS_BYTES);
        if (hipOccupancyMaxActiveBlocksPerMultiprocessor(&per_cu, (const void*)fwd<0, NPH>, 512, LDS_BYTES) != hipSuccess || per_cu < 1)
            fprintf(stderr, "kernel_launch: occupancy query reports %d workgroups per CU for 512 threads + %d B LDS; launching one per CU anyway\n", per_cu, LDS_BYTES);
        (void)hipGetLastError();
        g_grid = cus;
    }
    if (g_grid < 0) return;
    (void)hipMemsetAsync((char*)d_ws + WS_CTL, 0, CTL_ZERO_BYTES, stream);
    Args a{};
    for (int i = 0; i < 21; ++i) a.in[i] = (const float*)d_in[i];
    a.out = (float*)d_out; a.ws = (unsigned char*)d_ws;
#if MK_ONE_LAUNCH
    launch_range<0, NPH>(stream, a);
#else
    launch_each<0>(stream, a);
#endif
}
```

```cpp
#include <hip/hip_runtime.h>
#include <stdint.h>
#include <stdio.h>

typedef unsigned short bf16_t;
typedef short bf16x8 __attribute__((ext_vector_type(8)));
typedef float f32x4 __attribute__((ext_vector_type(4)));
typedef float f32x16 __attribute__((ext_vector_type(16)));

constexpr int D = 4096, SEQ = 4096, M = 8192, DEPTH = 2;
constexpr int NIN = 10256, DFF = 11008, NUP = 22016;
constexpr int UNW = 7168, UTW = 3072;
constexpr float EPS = 1e-6f;
constexpr int UN_QA = 0, UN_KA = 2048, UN_QB = 4096, UN_KB = 4608, UN_GB = 5120, UN_UC = 6144;
constexpr int SRC_QA = 0, SRC_KA = 2048, SRC_VA = 4096, SRC_QB = 6144, SRC_KB = 6656, SRC_VB = 7168, SRC_GB = 8192, SRC_ZLR = 9216, SRC_UC = 9232;

constexpr size_t MiB = 1u << 20;
constexpr size_t WS_CTL = 0;
constexpr size_t WS_W0 = 1 * MiB;
constexpr size_t OFF_WN = 0, OFF_WT = 56 * MiB, OFF_WO = 80 * MiB, OFF_WUP = 112 * MiB, OFF_WDN = 284 * MiB, OFF_WP = 370 * MiB, W_LAYER = 371 * MiB;
constexpr size_t WS_HN = WS_W0 + 2 * W_LAYER;
constexpr size_t WS_UN = WS_HN + 64 * MiB;
constexpr size_t WS_UT = WS_UN + 112 * MiB;
constexpr size_t WS_ZLR = WS_UT + 48 * MiB;
constexpr size_t WS_MIX = WS_ZLR + 1 * MiB;
constexpr size_t WS_Y = WS_MIX + 64 * MiB;
constexpr size_t WS_Z = WS_Y + 128 * MiB;
constexpr size_t WS_F = WS_Z + 344 * MiB;
constexpr size_t WS_DP = WS_F + 172 * MiB;
constexpr size_t WS_END = WS_DP + 16 * MiB;

__device__ __forceinline__ bf16_t f2bf(float f) { unsigned u = __float_as_uint(f); u += 0x7fffu + ((u >> 16) & 1u); return (bf16_t)(u >> 16); }
__device__ __forceinline__ float bf2f(bf16_t b) { return __uint_as_float(((unsigned)b) << 16); }
#ifndef MK_ONE_LAUNCH
#define MK_ONE_LAUNCH 1
#endif
#ifndef MK_DOUBLE_PHASE
#define MK_DOUBLE_PHASE (-1)
#endif
#ifndef MK_SHADOW
#define MK_SHADOW 0
#endif

#define LAS __attribute__((address_space(3)))
#define GAS __attribute__((address_space(1)))
typedef unsigned u32x4 __attribute__((ext_vector_type(4)));
typedef unsigned u32x2 __attribute__((ext_vector_type(2)));
typedef float f32x2 __attribute__((ext_vector_type(2)));
typedef GAS unsigned gu32;
#define RLX_AGENT __ATOMIC_RELAXED, __HIP_MEMORY_SCOPE_AGENT
constexpr size_t WS_RS = WS_DP + 12 * MiB;
constexpr size_t WS_ZB = WS_DP;
constexpr size_t OFF_WZ = 370 * MiB + 512 * 1024;
constexpr int RING_BYTES = 141312, LDSCTL_OFF = RING_BYTES, MISC_OFF = LDSCTL_OFF + 320, LDS_BYTES = 147456;
constexpr int CW_BAR = 4096, CW_KMAX = 8192, CW_QUEUE = 12288;
constexpr int CW_CNT = 16384;
constexpr size_t CTL_SS = 128 * 1024;
constexpr size_t CTL_ZERO_BYTES = 128 * 1024;
constexpr size_t WS_X = WS_Z + 160 * MiB;

__device__ __forceinline__ int fresh_lane() { unsigned z = 0u; asm volatile("" : "+s"(z)); return (int)__builtin_amdgcn_mbcnt_hi(~0u, __builtin_amdgcn_mbcnt_lo(~0u, z)); }
__device__ __forceinline__ float shfl_xor_l(float v, int m, int lane) { return __int_as_float(__builtin_amdgcn_ds_bpermute((lane ^ m) << 2, __float_as_int(v))); }
__device__ __forceinline__ float wave_sum_l(float v, int lane) {
#pragma unroll
    for (int o = 1; o < 64; o <<= 1) v += shfl_xor_l(v, o, lane);
    return v;
}
__device__ __forceinline__ unsigned cvt_pk_bf16(float lo, float hi) { unsigned r; asm volatile("v_cvt_pk_bf16_f32 %0, %1, %2" : "=v"(r) : "v"(lo), "v"(hi)); return r; }

#define XB_TMO      128
#define XB_XCNT(j)  (256  + 64 * (j))
#define XB_XSUB(j)  (1280 + 64 * (j))
#define XB_XGEN(j)  (2304 + 64 * (j))
#define XB_TOP      3328
#define XB_TOPGEN   3392
#define XCD_BAR_WORDS 3456
#define XB_SPIN_CAP (1u << 18)
__device__ __forceinline__ unsigned xb_ld(unsigned* p)              { return __hip_atomic_load(p, __ATOMIC_RELAXED, __HIP_MEMORY_SCOPE_AGENT); }
__device__ __forceinline__ unsigned xb_add(unsigned* p, unsigned v) { return __hip_atomic_fetch_add(p, v, __ATOMIC_RELAXED, __HIP_MEMORY_SCOPE_AGENT); }
__device__ __forceinline__ unsigned xb_xcc_id() { return (unsigned)__builtin_amdgcn_s_getreg((3 << 11) | 20) & 0xFu; }
#define XB_SPIN(cond, bar) do { unsigned _sp = 0; while (cond) { __builtin_amdgcn_s_sleep(1); \
    if ((++_sp & 255u) == 0u) { if (xb_ld(&(bar)[XB_TMO])) break; if (_sp > XB_SPIN_CAP) { atomicAdd(&(bar)[XB_TMO], 1u); break; } } } } while (0)
struct XcdBarrier { unsigned* bar; unsigned x; volatile LAS unsigned* st; int wave; };
__device__ __forceinline__ XcdBarrier xcd_barrier_post(unsigned* bar, volatile LAS unsigned* st) {
    XcdBarrier b; b.bar = bar; b.x = xb_xcc_id(); b.st = st;
    if (threadIdx.x == 0) (void)xb_add(&bar[XB_XCNT(b.x)], 1u);
    return b;
}
__device__ __forceinline__ void xcd_barrier_complete(unsigned* bar, unsigned x, unsigned& nloc, unsigned& nx) {
    const unsigned G = gridDim.x * gridDim.y * gridDim.z;
    unsigned sum, cnt, mine, sp = 0u;
    for (;;) {
        sum = 0u; cnt = 0u; mine = 0u;
#pragma unroll
        for (unsigned j = 0; j < 16; ++j) { const unsigned c = xb_ld(&bar[XB_XCNT(j)]); sum += c; cnt += (c > 0u) ? 1u : 0u; mine = (j == x) ? c : mine; }
        if (sum == G) break;
        __builtin_amdgcn_s_sleep(1);
        if ((++sp & 255u) == 0u) { if (xb_ld(&bar[XB_TMO])) break; if (sp > XB_SPIN_CAP) { atomicAdd(&bar[XB_TMO], 1u); break; } }
    }
    nloc = mine > 0u ? mine : 1u; nx = cnt > 0u ? cnt : 1u;
}
__device__ __forceinline__ void xcd_barrier(const XcdBarrier& b) {
    asm volatile("s_waitcnt vmcnt(0)" ::: "memory");
    __syncthreads();
    if (b.wave == 0 && fresh_lane() == 0) {
        unsigned* bar = b.bar;
        __builtin_amdgcn_s_waitcnt(0);
        unsigned nloc = b.st[0], nx = b.st[1];
        if (nloc == 0u) { xcd_barrier_complete(bar, b.x, nloc, nx); b.st[0] = nloc; b.st[1] = nx; }
        const unsigned old = xb_add(&bar[XB_XSUB(b.x)], 1u);
        const unsigned gen = old / nloc;
        if (old + 1u == (gen + 1u) * nloc) {
            __builtin_amdgcn_fence(__ATOMIC_RELEASE, "agent");
            asm volatile("s_waitcnt vmcnt(0)" ::: "memory");
            const unsigned og = xb_add(&bar[XB_TOP], 1u);
            const unsigned tg = og / nx;
            if (og + 1u == (tg + 1u) * nx) xb_add(&bar[XB_TOPGEN], 1u);
            else XB_SPIN(xb_ld(&bar[XB_TOPGEN]) == tg, bar);
            __builtin_amdgcn_fence(__ATOMIC_ACQUIRE, "agent");
            xb_add(&bar[XB_XGEN(b.x)], 1u);
            asm volatile("s_waitcnt vmcnt(0)" ::: "memory");
        } else {
            XB_SPIN(xb_ld(&bar[XB_XGEN(b.x)]) == gen, bar);
            __builtin_amdgcn_fence(__ATOMIC_ACQUIRE, "agent");
            asm volatile("s_waitcnt vmcnt(0)" ::: "memory");
        }
    }
    __syncthreads();
}

namespace pg8 {
constexpr int BM = 256, BK = 64, HALF = 128, HTB = HALF * BK * 2, STAGE_BYTES = 8 * HTB, NXCD = 8, WGM = 8;
__host__ __device__ __forceinline__ int lds_byte(int r, int c) { const int st = (r >> 4) * 2 + (c >> 5), rr = r & 15, cc = c & 31, ob = rr * 64 + cc * 2; return st * 1024 + (ob ^ (((ob >> 9) & 1) << 5)); }
__host__ __device__ __forceinline__ void stage_rc(int b, int& R, int& C) { const int st = b / 1024, sb = b % 1024, swz = sb ^ (((sb >> 9) & 1) << 5); R = (st >> 1) * 16 + swz / 64; C = (st & 1) * 32 + (swz % 64) / 2; }
__host__ __device__ __forceinline__ int perm32(int rho) { const int n = rho >> 4, i = rho & 15; return 8 * (i >> 2) + 4 * n + (i & 3); }

struct Unit { int pm, pn, kind; };
struct Gemm { const bf16_t* A[2]; const bf16_t* Bt[2]; int lda, ldb, K; };

__device__ __forceinline__ void tile_of(int wgid, int nM, int nN, int& pm, int& pn) {
    const int nwg = nM * nN; { const int q = nwg / NXCD, r = nwg % NXCD, xcd = wgid % NXCD, off = wgid / NXCD; wgid = (xcd < r ? xcd * (q + 1) : r * (q + 1) + (xcd - r) * q) + off; }
    const int nig = WGM * nN, gid = wgid / nig, fm = gid * WGM, gsz = (nM - fm) < WGM ? (nM - fm) : WGM;
    pm = fm + ((wgid % nig) % gsz); pn = (wgid % nig) / gsz;
}
struct Order2 {
    int nM0, nN0, nM1, nN1, G, c;
    __device__ __forceinline__ bool next(int i, Unit& u) const {
        const int L = i * G + c, n0 = nM0 * nN0;
        if (L < n0) { u.kind = 0; tile_of(L, nM0, nN0, u.pm, u.pn); return true; }
        if (L < n0 + nM1 * nN1) { u.kind = 1; tile_of(L - n0, nM1, nN1, u.pm, u.pn); return true; }
        return false;
    }
    __device__ __forceinline__ void a_ready(const Unit&) const {}
    __device__ __forceinline__ void done(const Unit&) const {}
};

__device__ __forceinline__ float row_rstd(const float* X, int nslot, int row) { float s = X[row]; for (int k = 1; k < nslot; ++k) s += X[(size_t)k * 8192 + row];
    return rsqrtf(s * (1.f / 4096.f) + EPS); }
struct EpiBf16 {
    static constexpr bool PERM = true;
    int nostore = 0;
    bf16_t* O[2]; int ldc[2]; const float* rs; int nslot;
    unsigned* kmax = nullptr; LAS unsigned char* nrm = nullptr;
    __device__ __forceinline__ void operator()(const f32x4 (&acc)[2][2][4][2], const Unit& u, int wr, int wc, int fr, int fq) const {
        asm volatile("" : "+v"(fr), "+v"(fq));
        const bool kn = kmax != nullptr && u.kind == 0 && u.pn >= UN_KA / 256 && u.pn < UN_KA / 256 + 8;
        LAS float* NT = (LAS float*)nrm;
        const int row0 = u.pm * BM + wr * 64 + fr, col0 = u.pn * BM + wc * 32 + 8 * fq;
        bf16_t* base = u.kind ? O[1] : O[0]; const int ld = u.kind ? ldc[1] : ldc[0];
        f32x4 cs[2][2];
#pragma unroll
        for (int bj = 0; bj < 2; ++bj)
#pragma unroll
            for (int n = 0; n < 2; ++n) { cs[bj][n] = (f32x4){1.f, 1.f, 1.f, 1.f}; if (rs && u.kind) {
#pragma unroll
                for (int e = 0; e < 4; ++e) cs[bj][n][e] = row_rstd(rs, nslot, col0 + bj * HALF + 4 * n + e); } }
        float rsv[2][4];
#pragma unroll
        for (int ai = 0; ai < 2; ++ai)
#pragma unroll
            for (int m = 0; m < 4; ++m) rsv[ai][m] = (rs && !u.kind) ? row_rstd(rs, nslot, row0 + ai * HALF + m * 16) : 1.f;
#pragma unroll
        for (int ai = 0; ai < 2; ++ai)
#pragma unroll
            for (int m = 0; m < 4; ++m) { const int row = row0 + ai * HALF + m * 16; bf16_t* rowp = base + (size_t)row * ld + col0;
                const float rsc = rsv[ai][m];
#pragma unroll
                for (int bj = 0; bj < 2; ++bj) { const f32x4 v0 = acc[ai][bj][m][0] * cs[bj][0] * rsc, v1 = acc[ai][bj][m][1] * cs[bj][1] * rsc;
                    u32x4 w; w.x = cvt_pk_bf16(v0[0], v0[1]); w.y = cvt_pk_bf16(v0[2], v0[3]); w.z = cvt_pk_bf16(v1[0], v1[1]); w.w = cvt_pk_bf16(v1[2], v1[3]);
                    if (nostore) asm volatile("" :: "v"(w.x), "v"(w.y), "v"(w.z), "v"(w.w)); else *(u32x4*)(rowp + bj * HALF) = w;
                    if (kn) { float s = 0.f;
#pragma unroll
                        for (int e = 0; e < 4; ++e) { const unsigned q = e == 0 ? w.x : e == 1 ? w.y : e == 2 ? w.z : w.w; const float a = __uint_as_float(q << 16), b = __uint_as_float(q & 0xffff0000u); s += a * a + b * b; }
                        const int ln = fq * 16 + fr; s += shfl_xor_l(s, 16, ln); s += shfl_xor_l(s, 32, ln);
                        if (fq == 0) NT[((ai * HALF + wr * 64 + m * 16 + fr) * 4 + wc) * 2 + bj] = s; } } }
        if (kn) {
            asm volatile("s_waitcnt lgkmcnt(0)" ::: "memory"); __builtin_amdgcn_s_barrier(); asm volatile("" ::: "memory");
            const int wv = wr * 4 + wc, ln = fq * 16 + fr, t = wv * 64 + ln, rl = t >> 1, mp = t & 1;
            float nv = sqrtf((NT[(rl * 4 + 0) * 2 + mp] + NT[(rl * 4 + 1) * 2 + mp]) + (NT[(rl * 4 + 2) * 2 + mp] + NT[(rl * 4 + 3) * 2 + mp]));
#pragma unroll
            for (int o = 2; o < 64; o <<= 1) nv = fmaxf(nv, shfl_xor_l(nv, o, ln));
            if (ln < 2) __hip_atomic_fetch_max(kmax + (((u.pm >> 4) * 8 + (u.pn - UN_KA / 256)) * 2 + mp) * 64 + (u.pm & 15) * 4 + (wv >> 1), __float_as_uint(nv), __ATOMIC_RELAXED, __HIP_MEMORY_SCOPE_AGENT);
        }
    }
};
struct EpiF32 {
    static constexpr bool PERM = false;
    float* C; int ldc;
    __device__ __forceinline__ void operator()(const f32x4 (&acc)[2][2][4][2], const Unit& u, int wr, int wc, int fr, int fq) const {
        const int row0 = u.pm * BM + wr * 64 + fr, col0 = u.pn * BM + wc * 32 + 4 * fq;
#pragma unroll
        for (int ai = 0; ai < 2; ++ai)
#pragma unroll
            for (int m = 0; m < 4; ++m) { float* rowp = C + (size_t)(row0 + ai * HALF + m * 16) * ldc + col0;
#pragma unroll
                for (int bj = 0; bj < 2; ++bj)
#pragma unroll
                    for (int n = 0; n < 2; ++n) *(f32x4*)(rowp + bj * HALF + n * 16) = acc[ai][bj][m][n]; }
    }
};


__device__ __forceinline__ float dpp_ror1(float x) { return __int_as_float(__builtin_amdgcn_update_dpp(0, __float_as_int(x), 0x121, 0xf, 0xf, false)); }
__device__ __forceinline__ float dpp_ror2(float x) { return __int_as_float(__builtin_amdgcn_update_dpp(0, __float_as_int(x), 0x122, 0xf, 0xf, false)); }
__device__ __forceinline__ float gelu_tanh_e(float x) { const float u = x * __builtin_fmaf(x * x, -0.10294324f, -2.3022082f); return x * __builtin_amdgcn_rcpf(1.f + __builtin_amdgcn_exp2f(u)); }
__device__ __forceinline__ void conv_taps_dpp(float& gt, float& vl, float s1g, float s2g, float w1g, float w0g, float s1v, float s2v, float w1v, float w0v) {
    asm("s_nop 1\n\tv_fmac_f32_dpp %0, %2, %4 row_ror:1 row_mask:0xf bank_mask:0xf\n\tv_fmac_f32_dpp %1, %6, %8 row_ror:1 row_mask:0xf bank_mask:0xf\n\t"
        "v_fmac_f32_dpp %0, %3, %5 row_ror:2 row_mask:0xf bank_mask:0xf\n\tv_fmac_f32_dpp %1, %7, %9 row_ror:2 row_mask:0xf bank_mask:0xf"
        : "+v"(gt), "+v"(vl) : "v"(s1g), "v"(s2g), "v"(w1g), "v"(w0g), "v"(s1v), "v"(s2v), "v"(w1v), "v"(w0v));
}
struct EpiConvGlu {
    static constexpr bool PERM = true;
    bf16_t* F; float* ZB; const float* wcv; const float* bcv; const float* rs; int nslot; LAS unsigned char* halo;
    __device__ __forceinline__ void operator()(const f32x4 (&acc)[2][2][4][2], const Unit& u, int wr, int wc, int fr, int fq) const {
        asm volatile("" : "+v"(fr), "+v"(fq));
        const int colt = wc * 32 + 8 * fq, ch = u.pn * 128 + colt;
        LAS float* HL = (LAS float*)halo;
        float rsr[2][4];
#pragma unroll
        for (int ai = 0; ai < 2; ++ai)
#pragma unroll
            for (int m = 0; m < 4; ++m) rsr[ai][m] = row_rstd(rs, nslot, u.pm * BM + ai * HALF + wr * 64 + m * 16 + fr);
        if (fr >= 14) {
#pragma unroll
            for (int ai = 0; ai < 2; ++ai) { const int blk = 2 * ai + wr;
#pragma unroll
                for (int bj = 0; bj < 2; ++bj)
#pragma unroll
                    for (int n = 0; n < 2; ++n) { const f32x4 v = acc[ai][bj][3][n] * rsr[ai][3];
                        if (blk < 3) *(LAS f32x4*)(HL + ((blk + 1) * 2 + (fr - 14)) * 256 + bj * 128 + colt + 4 * n) = v;
                        else *(f32x4*)(ZB + ((size_t)u.pm * 4 + 2 + (fr - 14)) * NUP + bj * DFF + ch + 4 * n) = v; } }
        }
        if (wr == 0 && fr < 2) {
#pragma unroll
            for (int bj = 0; bj < 2; ++bj)
#pragma unroll
                for (int n = 0; n < 2; ++n) *(f32x4*)(ZB + ((size_t)u.pm * 4 + fr) * NUP + bj * DFF + ch + 4 * n) = acc[0][bj][0][n] * rsr[0][0];
        }
        asm volatile("s_waitcnt lgkmcnt(0)" ::: "memory"); __builtin_amdgcn_s_barrier(); asm volatile("" ::: "memory");
#pragma unroll
        for (int n = 0; n < 2; ++n) {
            float wg[3][4], wv[3][4], bg[4], bv[4];
#pragma unroll
            for (int j = 0; j < 3; ++j) { const f32x4 a = *(const f32x4*)(wcv + (size_t)j * NUP + ch + 4 * n), b = *(const f32x4*)(wcv + (size_t)j * NUP + DFF + ch + 4 * n);
#pragma unroll
                for (int e = 0; e < 4; ++e) { wg[j][e] = a[e]; wv[j][e] = b[e]; } }
            { const f32x4 a = *(const f32x4*)(bcv + ch + 4 * n), b = *(const f32x4*)(bcv + DFF + ch + 4 * n);
#pragma unroll
              for (int e = 0; e < 4; ++e) { bg[e] = a[e]; bv[e] = b[e]; } }
#pragma unroll
            for (int ai = 0; ai < 2; ++ai) { const int blk = 2 * ai + wr;
                f32x4 pg = (f32x4){0.f, 0.f, 0.f, 0.f}, pv = (f32x4){0.f, 0.f, 0.f, 0.f};
                if (blk > 0 && fr >= 14) { pg = *(const LAS f32x4*)(HL + (blk * 2 + (fr - 14)) * 256 + colt + 4 * n); pv = *(const LAS f32x4*)(HL + (blk * 2 + (fr - 14)) * 256 + 128 + colt + 4 * n); }
#pragma unroll
                for (int m = 0; m < 4; ++m) { float o[4];
                    const f32x4 gs = acc[ai][0][m][n] * rsr[ai][m], vs = acc[ai][1][m][n] * rsr[ai][m];
#pragma unroll
                    for (int j = 0; j < 4; ++j) {
                        const float g0 = gs[j], v0 = vs[j];
                        float gt = __builtin_fmaf(wg[2][j], g0, bg[j]), vl = __builtin_fmaf(wv[2][j], v0, bv[j]);
                        conv_taps_dpp(gt, vl, fr == 15 ? pg[j] : g0, fr >= 14 ? pg[j] : g0, wg[1][j], wg[0][j], fr == 15 ? pv[j] : v0, fr >= 14 ? pv[j] : v0, wv[1][j], wv[0][j]);
                        o[j] = gelu_tanh_e(gt) * vl; }
                    u32x2 w; w.x = cvt_pk_bf16(o[0], o[1]); w.y = cvt_pk_bf16(o[2], o[3]);
                    *(u32x2*)(F + (size_t)(u.pm * BM + ai * HALF + wr * 64 + m * 16 + fr) * DFF + ch + 4 * n) = w;
                    pg = gs; pv = vs; }
            }
        }
    }
};

struct EpiRes {
    static constexpr bool PERM = true;
    bf16_t* H; const float* gpost; float* X1; float* X2; unsigned* cnt; unsigned* tmo; float* OUT; LAS unsigned char* tab;
    __device__ __forceinline__ void operator()(const f32x4 (&acc)[2][2][4][2], const Unit& u, int wr, int wc, int fr, int fq) const {
        asm volatile("" : "+v"(fr), "+v"(fq));
        int tid = threadIdx.x; asm volatile("" : "+v"(tid));
        LAS float* Pt = (LAS float*)tab; LAS float* St = Pt + 1024; volatile LAS unsigned* flag = (volatile LAS unsigned*)(St + 256);
        const int rl0 = wr * 64 + fr, col0 = u.pn * BM + wc * 32 + 8 * fq;
#pragma unroll
        for (int ai = 0; ai < 2; ++ai)
#pragma unroll
            for (int m = 0; m < 4; ++m) { float s = 0.f;
#pragma unroll
                for (int bj = 0; bj < 2; ++bj)
#pragma unroll
                    for (int n = 0; n < 2; ++n) { const f32x4 v = acc[ai][bj][m][n]; s += (v[0] * v[0] + v[1] * v[1]) + (v[2] * v[2] + v[3] * v[3]); }
                s += __shfl_xor(s, 16); s += __shfl_xor(s, 32);
                if (fq == 0) Pt[(rl0 + ai * HALF + m * 16) * 4 + wc] = s; }
        asm volatile("s_waitcnt lgkmcnt(0)" ::: "memory"); __builtin_amdgcn_s_barrier(); asm volatile("" ::: "memory");
        if (tid < 256) { const float s = (Pt[tid * 4] + Pt[tid * 4 + 1]) + (Pt[tid * 4 + 2] + Pt[tid * 4 + 3]);
            __hip_atomic_store(X1 + (size_t)u.pn * 8192 + u.pm * BM + tid, s, __ATOMIC_RELAXED, __HIP_MEMORY_SCOPE_AGENT); }
        asm volatile("s_waitcnt vmcnt(0) lgkmcnt(0)" ::: "memory"); __builtin_amdgcn_s_barrier(); asm volatile("" ::: "memory");
        unsigned* cw = cnt + 64 * u.pm;
        if (tid == 0) __hip_atomic_fetch_add(cw, 1u, __ATOMIC_RELAXED, __HIP_MEMORY_SCOPE_AGENT);
        if (tid < 64) { unsigned dead = 0u; const unsigned long long t0 = __builtin_amdgcn_s_memrealtime(); unsigned polls = 0;
            while ((unsigned)__builtin_amdgcn_readfirstlane((int)__hip_atomic_load(cw, __ATOMIC_RELAXED, __HIP_MEMORY_SCOPE_AGENT)) < 16u) {
                if ((++polls & 63u) == 0u && (__builtin_amdgcn_s_memrealtime() - t0 > 4000000ull || __builtin_amdgcn_readfirstlane((int)__hip_atomic_load(tmo, __ATOMIC_RELAXED, __HIP_MEMORY_SCOPE_AGENT)) != 0)) {
                    if (tid == 0) __hip_atomic_store(tmo, 1u, __ATOMIC_RELAXED, __HIP_MEMORY_SCOPE_AGENT); dead = 1u; break; }
                __builtin_amdgcn_s_sleep(2); }
            if (tid == 0) flag[0] = dead; }
        asm volatile("s_waitcnt vmcnt(0) lgkmcnt(0)" ::: "memory"); __builtin_amdgcn_s_barrier(); asm volatile("" ::: "memory");
        if (tid < 256) { float tot = 0.f;
#pragma unroll
            for (int pn = 0; pn < 16; ++pn) tot += __hip_atomic_load(X1 + (size_t)pn * 8192 + u.pm * BM + tid, __ATOMIC_RELAXED, __HIP_MEMORY_SCOPE_AGENT);
            St[tid] = flag[0] ? __builtin_nanf("") : rsqrtf(tot * (1.f / 4096.f) + EPS); }
        asm volatile("s_waitcnt lgkmcnt(0)" ::: "memory"); __builtin_amdgcn_s_barrier(); asm volatile("" ::: "memory");
#pragma unroll
        for (int ai = 0; ai < 2; ++ai)
#pragma unroll
            for (int m = 0; m < 4; ++m) { const int rl = rl0 + ai * HALF + m * 16, row = u.pm * BM + rl; const float rsy = St[rl];
                float s2 = 0.f;
#pragma unroll
                for (int bj = 0; bj < 2; ++bj) { const int col = col0 + bj * HALF;
                    const u32x4 hw = *(const u32x4*)(H + (size_t)row * 4096 + col); const f32x4 g0 = *(const f32x4*)(gpost + col), g1 = *(const f32x4*)(gpost + col + 4);
                    const f32x4 a0 = acc[ai][bj][m][0], a1 = acc[ai][bj][m][1];
                    f32x4 h0, h1;
                    h0[0] = __uint_as_float(hw.x << 16) + a0[0] * rsy * g0[0]; h0[1] = __uint_as_float(hw.x & 0xffff0000u) + a0[1] * rsy * g0[1];
                    h0[2] = __uint_as_float(hw.y << 16) + a0[2] * rsy * g0[2]; h0[3] = __uint_as_float(hw.y & 0xffff0000u) + a0[3] * rsy * g0[3];
                    h1[0] = __uint_as_float(hw.z << 16) + a1[0] * rsy * g1[0]; h1[1] = __uint_as_float(hw.z & 0xffff0000u) + a1[1] * rsy * g1[1];
                    h1[2] = __uint_as_float(hw.w << 16) + a1[2] * rsy * g1[2]; h1[3] = __uint_as_float(hw.w & 0xffff0000u) + a1[3] * rsy * g1[3];
                    if (OUT) { float* op = OUT + (size_t)row * 4096 + col; *(f32x4*)op = h0; *(f32x4*)(op + 4) = h1; }
                    else { u32x4 w; w.x = cvt_pk_bf16(h0[0], h0[1]); w.y = cvt_pk_bf16(h0[2], h0[3]); w.z = cvt_pk_bf16(h1[0], h1[1]); w.w = cvt_pk_bf16(h1[2], h1[3]);
                        *(u32x4*)(H + (size_t)row * 4096 + col) = w;
                        s2 += (h0[0] * h0[0] + h0[1] * h0[1]) + (h0[2] * h0[2] + h0[3] * h0[3]) + (h1[0] * h1[0] + h1[1] * h1[1]) + (h1[2] * h1[2] + h1[3] * h1[3]); } }
                if (!OUT) { s2 += __shfl_xor(s2, 16); s2 += __shfl_xor(s2, 32); if (fq == 0) Pt[rl * 4 + wc] = s2; } }
        if (!OUT) {
            asm volatile("s_waitcnt lgkmcnt(0)" ::: "memory"); __builtin_amdgcn_s_barrier(); asm volatile("" ::: "memory");
            if (tid < 256) X2[(size_t)u.pn * 8192 + u.pm * BM + tid] = (Pt[tid * 4] + Pt[tid * 4 + 1]) + (Pt[tid * 4 + 2] + Pt[tid * 4 + 3]);
            asm volatile("s_waitcnt lgkmcnt(0)" ::: "memory"); __builtin_amdgcn_s_barrier(); asm volatile("" ::: "memory");
        }
    }
};
struct OrderPanel {
    int G, c;
    __device__ __forceinline__ bool next(int i, Unit& u) const {
        const int L = i * G + c; if (L >= 512) return false;
        const int round = L >> 8, idx = L & 255, xcd = idx & 7, k = idx >> 3;
        u.kind = 0; u.pm = 16 * round + 4 * (xcd >> 1) + (k >> 3); u.pn = 8 * (xcd & 1) + (k & 7); return true;
    }
    __device__ __forceinline__ void a_ready(const Unit&) const {}
    __device__ __forceinline__ void done(const Unit&) const {}
};

template <class Epi, class Sched, bool ALIGN_EPI, bool SP2>
__device__ __forceinline__ void gemm_phase(LAS unsigned char* lds, const Gemm g, const Sched& S, const Epi& E, const int wid) {
    const int lane = fresh_lane();
    const int tid = wid * 64 + lane, wr = wid >> 2, wc = wid & 3, fr = lane & 15, fq = lane >> 4;
    const int K = g.K, nt = K / BK;
    unsigned voffA[2], voffB[2];
#pragma unroll
    for (int i = 0; i < 2; ++i) { int R, C; stage_rc(tid * 16 + i * 8192, R, C); const int Rb = Epi::PERM ? ((R & ~31) + perm32(R & 31)) : R;
        voffA[i] = (unsigned)(R * g.lda + C) * 2u; voffB[i] = (unsigned)(Rb * g.ldb + C) * 2u; }
    const size_t kstep = (size_t)(BK * 2);
    const size_t hstepA = (size_t)HALF * g.lda * 2, hstepB = (size_t)HALF * g.ldb * 2;
    const size_t tstepA = 2 * hstepA, tstepB = 2 * hstepB;
    const unsigned ldsw = (unsigned)wid * 1024u;
    const int aoff = lds_byte(wr * 64 + fr, fq * 8), boff = lds_byte(wc * 32 + fr, fq * 8);
#define PG8_SA(b, h) (((b) * 2 + (h)) * HTB)
#define PG8_SB(b, h) ((4 + (b) * 2 + (h)) * HTB)
#define PG8_STAGE(bufoff, gbase, voff) do { _Pragma("unroll") for (int _i = 0; _i < 2; ++_i) \
        __builtin_amdgcn_global_load_lds((const unsigned*)((const char*)(gbase) + (voff)[_i]), (LAS unsigned*)(lds + (bufoff) + ldsw + _i * 8192), 16, 0, 0); } while (0)
#define PG8_LDA(dst, b, h) do { _Pragma("unroll") for (int m = 0; m < 4; ++m) _Pragma("unroll") for (int k = 0; k < 2; ++k) dst[m][k] = *(const LAS bf16x8*)(lds + PG8_SA(b, h) + aoff + m * 2048 + k * 1024); } while (0)
#define PG8_LDB(dst, b, h) do { _Pragma("unroll") for (int n = 0; n < 2; ++n) _Pragma("unroll") for (int k = 0; k < 2; ++k) dst[n][k] = *(const LAS bf16x8*)(lds + PG8_SB(b, h) + boff + n * 2048 + k * 1024); } while (0)
#define PG8_MMA(ai, bj, At, Bt) do { __builtin_amdgcn_s_setprio(1); _Pragma("unroll") for (int m = 0; m < 4; ++m) _Pragma("unroll") for (int n = 0; n < 2; ++n) _Pragma("unroll") for (int k = 0; k < 2; ++k) \
        acc[ai][bj][m][n] = __builtin_amdgcn_mfma_f32_16x16x32_bf16(Bt[n][k], At[m][k], acc[ai][bj][m][n], 0, 0, 0); __builtin_amdgcn_s_setprio(0); } while (0)
#define PG8_WAIT_V(n) asm volatile("s_waitcnt vmcnt(" #n ")" ::: "memory")
#define PG8_WAIT_L(n) asm volatile("s_waitcnt lgkmcnt(" #n ")" ::: "memory")
#define PG8_BAR __builtin_amdgcn_s_barrier()
#define PG8_SCHED __builtin_amdgcn_sched_barrier(0)
    Unit cur, nxt; int ui = 0;
    if (!S.next(0, cur)) return;
    f32x4 acc[2][2][4][2];
#pragma unroll
    for (int a = 0; a < 2; ++a)
#pragma unroll
        for (int b = 0; b < 2; ++b)
#pragma unroll
            for (int m = 0; m < 4; ++m)
#pragma unroll
                for (int n = 0; n < 2; ++n) acc[a][b][m][n] = (f32x4){0.f, 0.f, 0.f, 0.f};
    bf16x8 At[4][2], B0[2][2], B1[2][2];
    const char* cA = (const char*)(cur.kind ? g.A[1] : g.A[0]) + (size_t)cur.pm * tstepA; const char* cB = (const char*)(cur.kind ? g.Bt[1] : g.Bt[0]) + (size_t)cur.pn * tstepB;
    S.a_ready(cur);
    if constexpr (SP2) {
        PG8_STAGE(PG8_SB(0, 0), cB, voffB); PG8_STAGE(PG8_SB(0, 1), cB + hstepB, voffB); PG8_STAGE(PG8_SA(0, 0), cA, voffA); PG8_STAGE(PG8_SA(0, 1), cA + hstepA, voffA);
        if (wr == 1) PG8_BAR;
        PG8_WAIT_V(2); PG8_BAR;
        PG8_STAGE(PG8_SB(1, 0), cB + kstep, voffB); PG8_STAGE(PG8_SA(1, 0), cA + kstep, voffA); PG8_STAGE(PG8_SB(1, 1), cB + hstepB + kstep, voffB);
        PG8_WAIT_V(6); PG8_BAR;
    } else {
        PG8_STAGE(PG8_SB(0, 0), cB, voffB); PG8_STAGE(PG8_SA(0, 0), cA, voffA); PG8_STAGE(PG8_SB(0, 1), cB + hstepB, voffB); PG8_STAGE(PG8_SA(0, 1), cA + hstepA, voffA);
        if (wr == 1) PG8_BAR;
        PG8_WAIT_V(4); PG8_BAR;
        PG8_STAGE(PG8_SB(1, 0), cB + kstep, voffB); PG8_STAGE(PG8_SA(1, 0), cA + kstep, voffA); PG8_STAGE(PG8_SB(1, 1), cB + hstepB + kstep, voffB);
        PG8_WAIT_V(6); PG8_BAR;
    }
    for (;;) {
        const bool has_next = S.next(ui + 1, nxt);
        const char* nA = has_next ? (const char*)(nxt.kind ? g.A[1] : g.A[0]) + (size_t)nxt.pm * tstepA : cA; const char* nB = has_next ? (const char*)(nxt.kind ? g.Bt[1] : g.Bt[0]) + (size_t)nxt.pn * tstepB : cB;
        for (int t = 0; t < nt; t += 2) {
            const bool last = (t == nt - 2);
            const char* a1 = cA + (size_t)(t + 1) * kstep;
            const char* a2 = last ? nA : cA + (size_t)(t + 2) * kstep; const char* b2 = last ? nB : cB + (size_t)(t + 2) * kstep;
            const char* a3 = a2 + kstep; const char* b3 = b2 + kstep;
            if (last && has_next) S.a_ready(nxt);
            if constexpr (SP2) {
            PG8_LDB(B0, 0, 0); PG8_LDB(B1, 0, 1); PG8_SCHED; PG8_LDA(At, 0, 0); PG8_STAGE(PG8_SA(1, 1), a1 + hstepA, voffA);
            PG8_WAIT_V(8); PG8_WAIT_L(0); PG8_BAR; PG8_MMA(0, 0, At, B0); PG8_MMA(0, 1, At, B1); PG8_BAR; PG8_SCHED;
            PG8_LDA(At, 0, 1); PG8_STAGE(PG8_SB(0, 0), b2, voffB); PG8_STAGE(PG8_SB(0, 1), b2 + hstepB, voffB); PG8_STAGE(PG8_SA(0, 0), a2, voffA);
            PG8_WAIT_V(8); PG8_WAIT_L(0); PG8_BAR; PG8_MMA(1, 0, At, B0); PG8_MMA(1, 1, At, B1); PG8_BAR; PG8_SCHED;
            PG8_LDB(B0, 1, 0); PG8_LDB(B1, 1, 1); PG8_SCHED; PG8_LDA(At, 1, 0); PG8_STAGE(PG8_SA(0, 1), a2 + hstepA, voffA);
            PG8_WAIT_V(8); PG8_WAIT_L(0); PG8_BAR; PG8_MMA(0, 0, At, B0); PG8_MMA(0, 1, At, B1); PG8_BAR; PG8_SCHED;
            PG8_LDA(At, 1, 1); PG8_STAGE(PG8_SB(1, 0), b3, voffB); PG8_STAGE(PG8_SB(1, 1), b3 + hstepB, voffB); PG8_STAGE(PG8_SA(1, 0), a3, voffA);
            PG8_WAIT_V(8); PG8_WAIT_L(0); PG8_BAR; PG8_MMA(1, 0, At, B0); PG8_MMA(1, 1, At, B1); PG8_BAR; PG8_SCHED;
            } else {
            PG8_LDB(B0, 0, 0); PG8_SCHED; PG8_LDA(At, 0, 0); PG8_STAGE(PG8_SA(1, 1), a1 + hstepA, voffA);
            PG8_WAIT_L(8); PG8_BAR; PG8_WAIT_L(0); PG8_MMA(0, 0, At, B0); PG8_BAR; PG8_SCHED;
            PG8_LDB(B1, 0, 1); PG8_STAGE(PG8_SB(0, 0), b2, voffB);
            PG8_BAR; PG8_WAIT_L(0); PG8_MMA(0, 1, At, B1); PG8_BAR;
            PG8_LDA(At, 0, 1); PG8_STAGE(PG8_SA(0, 0), a2, voffA);
            PG8_BAR; PG8_WAIT_L(0); PG8_MMA(1, 0, At, B0); PG8_BAR; PG8_SCHED;
            PG8_STAGE(PG8_SB(0, 1), b2 + hstepB, voffB);
            PG8_WAIT_V(6); PG8_BAR; PG8_MMA(1, 1, At, B1); PG8_BAR;
            PG8_LDB(B0, 1, 0); PG8_SCHED; PG8_LDA(At, 1, 0); PG8_STAGE(PG8_SA(0, 1), a2 + hstepA, voffA);
            PG8_WAIT_L(8); PG8_BAR; PG8_WAIT_L(0); PG8_MMA(0, 0, At, B0); PG8_BAR; PG8_SCHED;
            PG8_LDB(B1, 1, 1); PG8_STAGE(PG8_SB(1, 0), b3, voffB);
            PG8_BAR; PG8_WAIT_L(0); PG8_MMA(0, 1, At, B1); PG8_BAR;
            PG8_LDA(At, 1, 1); PG8_STAGE(PG8_SA(1, 0), a3, voffA);
            PG8_BAR; PG8_WAIT_L(0); PG8_MMA(1, 0, At, B0); PG8_BAR; PG8_SCHED;
            PG8_STAGE(PG8_SB(1, 1), b3 + hstepB, voffB);
            PG8_WAIT_V(6); PG8_BAR; PG8_MMA(1, 1, At, B1); PG8_BAR;
            }
        }
        if constexpr (ALIGN_EPI) { if (wr == 0) PG8_BAR; }
        E(acc, cur, wr, wc, fr, fq); S.done(cur);
        if (!has_next) break;
#pragma unroll
        for (int a = 0; a < 2; ++a)
#pragma unroll
            for (int b = 0; b < 2; ++b)
#pragma unroll
                for (int m = 0; m < 4; ++m)
#pragma unroll
                    for (int n = 0; n < 2; ++n) acc[a][b][m][n] = (f32x4){0.f, 0.f, 0.f, 0.f};
        cur = nxt; cA = nA; cB = nB; ++ui;
        if constexpr (ALIGN_EPI) { if (wr == 1) PG8_BAR; }
    }
    PG8_WAIT_V(0);
    if constexpr (!ALIGN_EPI) { if (wr == 0) PG8_BAR; }
    PG8_BAR;
#undef PG8_SA
#undef PG8_SB
#undef PG8_STAGE
#undef PG8_LDA
#undef PG8_LDB
#undef PG8_MMA
#undef PG8_WAIT_V
#undef PG8_WAIT_L
#undef PG8_BAR
#undef PG8_SCHED
}
}
#ifndef PG8_SP2
#define PG8_SP2 true
#endif
#ifndef PG8_ALIGN
#define PG8_ALIGN true
#endif
static_assert(PG8_ALIGN, "EpiConvGlu has a workgroup barrier inside its epilogue: both half-workgroups must run their epilogues together (ALIGN_EPI)");

constexpr size_t WS_GLA = WS_Z;
constexpr size_t GLA_LT = 0, GLA_OI = 64 * MiB, GLA_ST = 96 * MiB, GLA_QT = 128 * MiB, GLA_DEC = 136 * MiB;
__device__ __forceinline__ int crow(int i, int hh) { return (i & 3) + 8 * (i >> 2) + 4 * hh; }
#define MFMA32(a, b, c) __builtin_amdgcn_mfma_f32_32x32x16_bf16((a), (b), (c), 0, 0, 0)
#define WG_BAR() do { asm volatile("s_waitcnt vmcnt(0) lgkmcnt(0)" ::: "memory"); __builtin_amdgcn_s_barrier(); asm volatile("" ::: "memory"); } while (0)

__device__ __forceinline__ f32x16 mma_lds(const LAS bf16_t* A, int pa, const LAS bf16_t* B, int pb, int K, f32x16 acc, int r, int hh) {
    const LAS bf16_t* ap = A + r * pa + 8 * hh; const LAS bf16_t* bp = B + r * pb + 8 * hh;
    for (int k = 0; k < K; k += 16) acc = MFMA32(*(const LAS bf16x8*)(ap + k), *(const LAS bf16x8*)(bp + k), acc);
    return acc;
}

namespace att {
constexpr float LOG2E = 1.4426950408889634f, C1 = 0.08838834764831845f * LOG2E, THRL = 8.f;
constexpr int GSUB_OFF = LDSCTL_OFF + 2048;
constexpr int KP = 528, VP = 144, VBYTES = 256 * VP, KBYTES = 64 * KP, ABUF = VBYTES + KBYTES, XP = 1040;
__device__ __forceinline__ void stage_tile(LAS unsigned char* buf, const char* kt, const char* vt, int wave, int lane) {
#pragma unroll
    for (int i = 0; i < 5; ++i) { const int iv = wave + 8 * i; if (iv < 36) { const unsigned q = iv * 64 + lane, row = q / 9u, cp = q - 9u * row, cc = cp < 8u ? cp : 7u;
        __builtin_amdgcn_global_load_lds((const GAS unsigned*)(vt + (row * (unsigned)(M * 2) + cc * 16u)), (LAS unsigned*)(buf + iv * 1024), 16, 0, 0); } }
#pragma unroll
    for (int i = 0; i < 5; ++i) { const int ik = wave + 8 * i; if (ik < 33) { const unsigned q = ik * 64 + lane, row = q / 33u, cp = q - 33u * row, cc = cp < 32u ? cp : 31u;
        __builtin_amdgcn_global_load_lds((const GAS unsigned*)(kt + (row * (unsigned)(UNW * 2) + cc * 16u)), (LAS unsigned*)(buf + VBYTES + ik * 1024), 16, 0, 0); } }
}
constexpr float TSKIP = 64.f;
__device__ __forceinline__ void unit(LAS unsigned char* lds, const bf16_t* UN, const bf16_t* UT, bf16_t* MIX, const unsigned* KMAX, int b, int h, int qb, float lam, const float* gsub, float post_scale, int wave, int lane, const int mode = 0) {
    const int mp = wave >> 2, wq = wave & 3, r = lane & 31, hh = lane >> 5;
    const int q0 = qb * 128 + wq * 32, qpos = q0 + r, cw = q0 >> 6;
    const float C2 = __uint_as_float((unsigned)(127 - (h + 1)) << 23) * LOG2E;
    const char* kt = (const char*)(UN + (size_t)(b * SEQ) * UNW + UN_KA + h * 256);
    const char* vt = (const char*)(UT + (size_t)(h * 256) * M + (size_t)b * SEQ);
    if (mode != 3) stage_tile(lds, kt + (size_t)(2 * qb + 1) * 64 * UNW * 2, vt + (size_t)(2 * qb + 1) * 128, wave, lane);
    const float km_raw = __uint_as_float(__hip_atomic_load(KMAX + ((b * 8 + h) * 2 + mp) * 64 + lane, __ATOMIC_RELAXED, __HIP_MEMORY_SCOPE_AGENT));
    bf16x8 qf[8];
    { const bf16_t* qp = UN + (size_t)(b * SEQ + qpos) * UNW + UN_QA + h * 256 + mp * 128 + 8 * hh;
#pragma unroll
      for (int kk = 0; kk < 8; ++kk) qf[kk] = *(const bf16x8*)(qp + 16 * kk); }
    unsigned long long mask;
    { float qs = 0.f;
#pragma unroll
      for (int kk = 0; kk < 8; ++kk)
#pragma unroll
          for (int e = 0; e < 8; ++e) { const float x = bf2f((bf16_t)qf[kk][e]); qs += x * x; }
      { auto rr = __builtin_amdgcn_permlane32_swap(__float_as_uint(qs), __float_as_uint(qs), false, false); qs = __uint_as_float(rr[0]) + __uint_as_float(rr[1]); }
#pragma unroll
      for (int o = 1; o < 32; o <<= 1) qs = fmaxf(qs, shfl_xor_l(qs, o, lane));
      const float qn = sqrtf(qs) * 1.001f;
      const float km = km_raw * 1.001f;
      const float kcw = __uint_as_float(__builtin_amdgcn_readlane(__float_as_uint(km), cw));
      const int md = q0 - (64 * lane + 63);
      const bool need = (lane <= cw) && (C1 * qn * (km + kcw) - C2 * (float)(md > 0 ? md : 0) >= -TSKIP);
      mask = __ballot(need); }
    volatile LAS unsigned long long* masks = (volatile LAS unsigned long long*)(lds + LDSCTL_OFF + 512);
    if (lane == 0) masks[wave] = mask;
    f32x16 O[8];
#pragma unroll
    for (int eb = 0; eb < 8; ++eb)
#pragma unroll
        for (int i = 0; i < 16; ++i) O[eb][i] = 0.f;
    float m_ref = -INFINITY, l_acc = 0.f;
    WG_BAR();
    unsigned long long rem = 0ull;
#pragma unroll
    for (int w = 0; w < 8; ++w) { const unsigned long long mw = masks[w]; rem |= ((unsigned long long)__builtin_amdgcn_readfirstlane((unsigned)(mw >> 32)) << 32) | (unsigned long long)__builtin_amdgcn_readfirstlane((unsigned)mw); }
    int j = 63 - __builtin_clzll(rem); rem &= ~(1ull << j);
    const int kbase = VBYTES + r * KP + mp * 256 + hh * 16, vbase = r * VP + hh * 16;
    for (int it = 0;; ++it) {
        WG_BAR();
        LAS unsigned char* buf = lds + (it & 1) * ABUF;
        const int jn = rem ? 63 - __builtin_clzll(rem) : -1;
        if (jn >= 0) { rem &= ~(1ull << jn); if (mode != 3) stage_tile(lds + ((it + 1) & 1) * ABUF, kt + (size_t)jn * 64 * UNW * 2, vt + (size_t)jn * 128, wave, lane); }
        if (((mask >> j) & 1ull) && mode != 1) {
            const LAS unsigned char* kp = buf + kbase; const LAS unsigned char* vp = buf + vbase;
#pragma unroll
            for (int hf = 1; hf >= 0; --hf) {
                f32x16 p0;
#pragma unroll
                for (int i = 0; i < 16; ++i) p0[i] = 0.f;
#define LDK(KK) (*(const LAS bf16x8*)(kp + hf * 32 * KP + (KK) * 32))
                { bf16x8 ka[4] = {LDK(0), LDK(1), LDK(2), LDK(3)}, kb[4] = {LDK(4), LDK(5), LDK(6), LDK(7)};
                  __builtin_amdgcn_sched_barrier(0);
                  __builtin_amdgcn_s_setprio(1);
#pragma unroll
                  for (int kk = 0; kk < 4; ++kk) p0 = MFMA32(ka[kk], qf[kk], p0);
#pragma unroll
                  for (int kk = 0; kk < 4; ++kk) p0 = MFMA32(kb[kk], qf[4 + kk], p0);
                  __builtin_amdgcn_s_setprio(0); }
#undef LDK
                const float base0 = (float)(qpos - 64 * j - 32 * hf - 4 * hh);
                float pmax = -INFINITY;
#pragma unroll
                for (int i = 0; i < 16; ++i) { const float off = (float)((i & 3) + 8 * (i >> 2));
                    p0[i] = fmaf(p0[i], C1, -C2 * fabsf(base0 - off)); pmax = fmaxf(pmax, p0[i]); }
                { auto rr = __builtin_amdgcn_permlane32_swap(__float_as_uint(pmax), __float_as_uint(pmax), false, false); pmax = fmaxf(__uint_as_float(rr[0]), __uint_as_float(rr[1])); }
                if (!__all(pmax - m_ref <= THRL)) {
                    const float mn = fmaxf(m_ref, pmax), alpha = __builtin_amdgcn_exp2f(m_ref - mn); m_ref = mn; l_acc *= alpha;
#pragma unroll
                    for (int eb = 0; eb < 8; ++eb)
#pragma unroll
                        for (int i = 0; i < 16; ++i) O[eb][i] *= alpha;
                }
                float ps = 0.f;
#pragma unroll
                for (int i = 0; i < 16; ++i) { p0[i] = __builtin_amdgcn_exp2f(p0[i] - m_ref); ps += p0[i]; }
                l_acc += ps;
                bf16x8 pf[2];
#define PK4(P, BASE, OUT) do { const unsigned a0 = cvt_pk_bf16(P[BASE + 0], P[BASE + 1]), a1 = cvt_pk_bf16(P[BASE + 2], P[BASE + 3]); \
    const unsigned b0 = cvt_pk_bf16(P[BASE + 4], P[BASE + 5]), b1 = cvt_pk_bf16(P[BASE + 6], P[BASE + 7]); \
    auto r0 = __builtin_amdgcn_permlane32_swap(a0, b0, false, false); auto r1 = __builtin_amdgcn_permlane32_swap(a1, b1, false, false); \
    u32x4 w = {r0[0], r1[0], r0[1], r1[1]}; OUT = *reinterpret_cast<bf16x8*>(&w); } while (0)
                PK4(p0, 0, pf[0]); PK4(p0, 8, pf[1]);
#undef PK4
#define LDV(EB, S2) (*(const LAS bf16x8*)(vp + (EB) * 32 * VP + (4 * hf + 2 * (S2)) * 16))
                { bf16x8 va[4] = {LDV(0, 0), LDV(0, 1), LDV(1, 0), LDV(1, 1)};
                  __builtin_amdgcn_s_setprio(1);
#pragma unroll
                  for (int eb = 0; eb < 8; eb += 2) { bf16x8 vn[4];
                      if (eb < 6) { vn[0] = LDV(eb + 2, 0); vn[1] = LDV(eb + 2, 1); vn[2] = LDV(eb + 3, 0); vn[3] = LDV(eb + 3, 1); }
                      O[eb] = MFMA32(va[0], pf[0], O[eb]); O[eb + 1] = MFMA32(va[2], pf[0], O[eb + 1]); O[eb] = MFMA32(va[1], pf[1], O[eb]); O[eb + 1] = MFMA32(va[3], pf[1], O[eb + 1]);
                      __builtin_amdgcn_sched_barrier(0);
                      if (eb < 6) { va[0] = vn[0]; va[1] = vn[1]; va[2] = vn[2]; va[3] = vn[3]; } }
                  __builtin_amdgcn_s_setprio(0); }
#undef LDV
            }
        }
        if (jn < 0) break;
        j = jn;
    }
    { auto rr = __builtin_amdgcn_permlane32_swap(__float_as_uint(l_acc), __float_as_uint(l_acc), false, false); l_acc = __uint_as_float(rr[0]) + __uint_as_float(rr[1]); }
    WG_BAR();
    LAS unsigned char* xp = lds + (wq * 32 + r) * XP + hh * 16;
    if (mp == 1) {
        const float inv = lam / l_acc;
#pragma unroll
        for (int eb = 0; eb < 8; ++eb)
#pragma unroll
            for (int g4 = 0; g4 < 4; ++g4) { const f32x4 v = {O[eb][4 * g4] * inv, O[eb][4 * g4 + 1] * inv, O[eb][4 * g4 + 2] * inv, O[eb][4 * g4 + 3] * inv};
                *(LAS f32x4*)(xp + (8 * eb + 2 * g4) * 16) = v; }
    }
    WG_BAR();
    if (mp == 0) {
        const float inv = 1.f / l_acc; float ss = 0.f;
#pragma unroll
        for (int eb = 0; eb < 8; ++eb) {
#pragma unroll
            for (int g4 = 0; g4 < 4; ++g4) { const f32x4 x = *(const LAS f32x4*)(xp + (8 * eb + 2 * g4) * 16);
#pragma unroll
                for (int e = 0; e < 4; ++e) { const float v = O[eb][4 * g4 + e] * inv - x[e]; O[eb][4 * g4 + e] = v; ss += v * v; } }
            asm volatile("" ::: "memory"); }
        { auto rr = __builtin_amdgcn_permlane32_swap(__float_as_uint(ss), __float_as_uint(ss), false, false); ss = __uint_as_float(rr[0]) + __uint_as_float(rr[1]); }
        const float rs = rsqrtf(ss * (1.f / 256.f) + EPS) * post_scale;
        bf16_t* op = MIX + (size_t)(b * SEQ + qpos) * D + h * 256 + 4 * hh; const LAS float* gp = (const LAS float*)(lds + GSUB_OFF) + 4 * hh;
#pragma unroll
        for (int eb = 0; eb < 8; ++eb) {
#pragma unroll
            for (int g4 = 0; g4 < 4; ++g4) { const int e0 = 32 * eb + 8 * g4; const f32x4 g = *(const LAS f32x4*)(gp + e0);
                u32x2 w; w.x = cvt_pk_bf16(O[eb][4 * g4] * rs * g[0], O[eb][4 * g4 + 1] * rs * g[1]); w.y = cvt_pk_bf16(O[eb][4 * g4 + 2] * rs * g[2], O[eb][4 * g4 + 3] * rs * g[3]);
                if (mode == 0) *(u32x2*)(op + e0) = w; else asm volatile("" :: "v"(w.x), "v"(w.y)); }
            asm volatile("" ::: "memory"); }
    }
    WG_BAR();
}
}

namespace gla {
constexpr int O_LA = 0, O_ZL = 32768, O_QT = 36864, O_KT = 54272, O_KHT = 71680, O_VT = 90112, O_AM = 0;
constexpr int PQ = 136, PS = 72;
__device__ __forceinline__ void g1_unit(LAS unsigned char* lds, const bf16_t* UN, const bf16_t* UT, const float* ZLR, const float* w2, const float* bgate, unsigned char* gs, int u, int tid, int wave, int lane) {
    const int c = u & 63, h = (u >> 6) & 3, b = u >> 8; const size_t tok0 = (size_t)b * SEQ + c * 64;
    LAS float* LA = (LAS float*)(lds + O_LA); LAS float* ZL = (LAS float*)(lds + O_ZL);
    LAS bf16_t* QT = (LAS bf16_t*)(lds + O_QT); LAS bf16_t* KT = (LAS bf16_t*)(lds + O_KT); LAS bf16_t* KHT = (LAS bf16_t*)(lds + O_KHT); LAS bf16_t* VT = (LAS bf16_t*)(lds + O_VT); LAS bf16_t* AM = (LAS bf16_t*)(lds + O_AM);
    const int d = tid & 127, qd = tid >> 7;
    float w[16]; bf16_t qr[16], kr[16];
#pragma unroll
    for (int rr = 0; rr < 16; ++rr) w[rr] = w2[rr * 512 + h * 128 + d];
    const float bias = bgate[h * 128 + d];
#pragma unroll
    for (int i = 0; i < 16; ++i) { const size_t t = tok0 + qd * 16 + i; qr[i] = UN[t * UNW + UN_QB + h * 128 + d]; kr[i] = UN[t * UNW + UN_KB + h * 128 + d]; }
    if (tid < 256) *(LAS f32x4*)(ZL + tid * 4) = *(const f32x4*)(ZLR + tok0 * 16 + tid * 4);
#pragma unroll
    for (int i = 0; i < 4; ++i) { const int id = tid + 512 * i, row = id >> 3, ch = id & 7;
        *(LAS u32x4*)(VT + row * PS + ch * 8) = *(const u32x4*)(UT + (size_t)(2048 + h * 256 + row) * M + tok0 + ch * 8); }
    WG_BAR();
    float bt[16];
    { float run = 0.f;
#pragma unroll
      for (int i = 0; i < 16; ++i) { const int t = qd * 16 + i; float x = bias;
#pragma unroll
          for (int rr = 0; rr < 16; ++rr) x += ZL[t * 16 + rr] * w[rr];
          const float ls = fminf(x, 0.f) - __logf(1.f + __expf(-fabsf(x)));
          run += ls * (1.f / 16.f); bt[i] = run; }
      WG_BAR();
      ZL[qd * 128 + d] = run; }
    WG_BAR();
    float off = 0.f, btot = 0.f;
#pragma unroll
    for (int q = 0; q < 4; ++q) { const float p = ZL[q * 128 + d]; btot += p; if (q < qd) off += p; }
    bf16_t* QTg = (bf16_t*)(gs + GLA_QT) + (size_t)u * 64 * 128;
#pragma unroll
    for (int i = 0; i < 16; ++i) { const int t = qd * 16 + i; const float bb = bt[i] + off;
        const float qv = bf2f(qr[i]) * 0.08838834764831845f, kv = bf2f(kr[i]);
        const bf16_t qt = f2bf(qv * __expf(bb));
        QT[t * PQ + d] = qt; QTg[t * 128 + d] = qt; KT[t * PQ + d] = f2bf(kv * __expf(-bb)); KHT[d * PS + t] = f2bf(kv * __expf(btot - bb)); }
    if (qd == 0) ((float*)(gs + GLA_DEC))[(size_t)u * 128 + d] = __expf(btot);
    WG_BAR();
    const int r = lane & 31, hh = lane >> 5;
    f32x16 zero;
#pragma unroll
    for (int i = 0; i < 16; ++i) zero[i] = 0.f;
    if (wave < 4) {
        const int mi = wave >> 1, ni = wave & 1;
        const f32x16 a = mma_lds(QT + 32 * mi * PQ, PQ, KT + 32 * ni * PQ, PQ, 128, zero, r, hh);
#pragma unroll
        for (int i = 0; i < 16; ++i) { const int t = 32 * mi + crow(i, hh), s = 32 * ni + r; AM[t * PS + s] = f2bf(s <= t ? a[i] : 0.f); }
    }
    { bf16_t* LT = (bf16_t*)(gs + GLA_LT) + (size_t)u * 256 * 128;
#pragma unroll
      for (int db = 0; db < 4; ++db) { const f32x16 a = mma_lds(VT + 32 * wave * PS, PS, KHT + 32 * db * PS, PS, 64, zero, r, hh);
#pragma unroll
          for (int i = 0; i < 16; ++i) LT[(size_t)(32 * wave + crow(i, hh)) * 128 + 32 * db + r] = f2bf(a[i]); } }
    WG_BAR();
    { float* OI = (float*)(gs + GLA_OI) + (size_t)u * 64 * 256;
#pragma unroll
      for (int tb = 0; tb < 2; ++tb) { const f32x16 a = mma_lds(AM + 32 * tb * PS, PS, VT + 32 * wave * PS, PS, 64, zero, r, hh);
#pragma unroll
          for (int i = 0; i < 16; ++i) OI[(size_t)(32 * tb + crow(i, hh)) * 256 + 32 * wave + r] = a[i]; } }
    WG_BAR();
}
__device__ __forceinline__ void g2_scan(unsigned char* gs, int p) {
    const int bh = p >> 14, rem = p & 16383, e = rem >> 6, d2 = (rem & 63) * 2;
    const bf16_t* LT = (const bf16_t*)(gs + GLA_LT); const float* DEC = (const float*)(gs + GLA_DEC); bf16_t* ST = (bf16_t*)(gs + GLA_ST);
    float s0 = 0.f, s1 = 0.f;
    for (int c0 = 0; c0 < 64; c0 += 16) {
        f32x2 dc[16]; unsigned lv[16];
#pragma unroll
        for (int i = 0; i < 16; ++i) { const size_t u = (size_t)bh * 64 + c0 + i; dc[i] = *(const f32x2*)(DEC + u * 128 + d2); lv[i] = *(const unsigned*)(LT + (u * 256 + e) * 128 + d2); }
#pragma unroll
        for (int i = 0; i < 16; ++i) { const size_t u = (size_t)bh * 64 + c0 + i;
            *(unsigned*)(ST + (u * 256 + e) * 128 + d2) = cvt_pk_bf16(s0, s1);
            s0 = dc[i].x * s0 + __uint_as_float(lv[i] << 16); s1 = dc[i].y * s1 + __uint_as_float(lv[i] & 0xffff0000u); }
    }
}
__device__ __forceinline__ void g3_unit(LAS unsigned char* lds, const bf16_t* UN, unsigned char* gs, const float* ggla, bf16_t* MIX, int u, int tid, int wave, int lane) {
    const int c = u & 63, h = (u >> 6) & 3, b = u >> 8; const size_t tok0 = (size_t)b * SEQ + c * 64;
    LAS bf16_t* QT = (LAS bf16_t*)lds; LAS bf16_t* STs = (LAS bf16_t*)(lds + 17408); LAS float* OT = (LAS float*)lds;
    const bf16_t* QTg = (const bf16_t*)(gs + GLA_QT) + (size_t)u * 64 * 128; const bf16_t* ST = (const bf16_t*)(gs + GLA_ST) + (size_t)u * 256 * 128;
#pragma unroll
    for (int i = 0; i < 2; ++i) { const int id = tid + 512 * i, row = id >> 4, ch = id & 15; *(LAS u32x4*)(QT + row * PQ + ch * 8) = *(const u32x4*)(QTg + row * 128 + ch * 8); }
#pragma unroll
    for (int i = 0; i < 8; ++i) { const int id = tid + 512 * i, row = id >> 4, ch = id & 15; *(LAS u32x4*)(STs + row * PQ + ch * 8) = *(const u32x4*)(ST + row * 128 + ch * 8); }
    const int r = lane & 31, hh = lane >> 5;
    const float* OI = (const float*)(gs + GLA_OI) + (size_t)u * 64 * 256;
    bf16x8 gvv[4]; f32x4 ggv[8];
    { const int t = tid >> 3, part = tid & 7; const bf16_t* gbp = UN + (tok0 + t) * UNW + UN_GB + h * 256 + part * 32; const float* gg = ggla + h * 256 + part * 32;
#pragma unroll
      for (int q = 0; q < 4; ++q) gvv[q] = *(const bf16x8*)(gbp + 8 * q);
#pragma unroll
      for (int q = 0; q < 8; ++q) ggv[q] = *(const f32x4*)(gg + 4 * q); }
    f32x16 acc[2];
#pragma unroll
    for (int tb = 0; tb < 2; ++tb)
#pragma unroll
        for (int i = 0; i < 16; ++i) acc[tb][i] = OI[(size_t)(32 * tb + crow(i, hh)) * 256 + 32 * wave + r];
    WG_BAR();
#pragma unroll
    for (int tb = 0; tb < 2; ++tb) acc[tb] = mma_lds(QT + 32 * tb * PQ, PQ, STs + 32 * wave * PQ, PQ, 128, acc[tb], r, hh);
    WG_BAR();
#pragma unroll
    for (int tb = 0; tb < 2; ++tb)
#pragma unroll
        for (int i = 0; i < 16; ++i) OT[(32 * tb + crow(i, hh)) * 260 + 32 * wave + r] = acc[tb][i];
    WG_BAR();
    { const int t = tid >> 3, part = tid & 7; const LAS float* op = OT + t * 260 + part * 32; float v[32]; float ss = 0.f;
#pragma unroll
      for (int q = 0; q < 8; ++q) { const f32x4 x = *(const LAS f32x4*)(op + 4 * q); v[4 * q] = x[0]; v[4 * q + 1] = x[1]; v[4 * q + 2] = x[2]; v[4 * q + 3] = x[3]; ss += x[0] * x[0] + x[1] * x[1] + x[2] * x[2] + x[3] * x[3]; }
      ss += shfl_xor_l(ss, 1, lane); ss += shfl_xor_l(ss, 2, lane); ss += shfl_xor_l(ss, 4, lane);
      const float rs = rsqrtf(ss * (1.f / 256.f) + EPS);
      bf16_t* mp = MIX + (tok0 + t) * D + 2048 + h * 256 + part * 32;
#pragma unroll
      for (int q = 0; q < 4; ++q) { const bf16x8 gv = gvv[q]; float o[8];
#pragma unroll
          for (int e = 0; e < 8; ++e) { const float g = bf2f((bf16_t)gv[e]); o[e] = v[8 * q + e] * rs * ggv[2 * q + (e >> 2)][e & 3] * (g / (1.f + __expf(-g))); }
          u32x4 w; w.x = cvt_pk_bf16(o[0], o[1]); w.y = cvt_pk_bf16(o[2], o[3]); w.z = cvt_pk_bf16(o[4], o[5]); w.w = cvt_pk_bf16(o[6], o[7]);
          *(u32x4*)(mp + 8 * q) = w; } }
    WG_BAR();
}
}

template <int W> __device__ __forceinline__ void pool_window(LAS bf16_t* DT, const bf16_t* UN, size_t tok0, int g, int tid) {
    constexpr int PD = 264, NR = W - 1 + 8;
    const int cg = tid & 31, seg = tid >> 5, tf = (int)(tok0 & (SEQ - 1)) + 8 * seg;
    const bf16_t* up = UN + (tok0 + 8 * seg) * UNW + UN_UC + g * 256 + 8 * cg;
    bf16x8 x[NR];
#pragma unroll
    for (int k = 0; k < NR; ++k) { const int rel = k - (W - 1); bf16x8 z;
#pragma unroll
        for (int e = 0; e < 8; ++e) z[e] = 0;
        x[k] = (tf + rel >= 0) ? *(const bf16x8*)(up + (ptrdiff_t)rel * UNW) : z; }
    float s[8];
#pragma unroll
    for (int e = 0; e < 8; ++e) s[e] = 0.f;
#pragma unroll
    for (int k = 0; k < W - 1; ++k)
#pragma unroll
        for (int e = 0; e < 8; ++e) s[e] += bf2f((bf16_t)x[k][e]);
#pragma unroll
    for (int i = 0; i < 8; ++i) { const int t = tf + i; const float rc = __builtin_amdgcn_rcpf((float)((t + 1 < W) ? t + 1 : W)); float o[8];
#pragma unroll
        for (int e = 0; e < 8; ++e) { const float ut = bf2f((bf16_t)x[W - 1 + i][e]); s[e] += ut; o[e] = s[e] * rc - ut; s[e] -= bf2f((bf16_t)x[i][e]); }
        u32x4 wv; wv.x = cvt_pk_bf16(o[0], o[1]); wv.y = cvt_pk_bf16(o[2], o[3]); wv.z = cvt_pk_bf16(o[4], o[5]); wv.w = cvt_pk_bf16(o[6], o[7]);
        *(LAS u32x4*)(DT + (8 * seg + i) * PD + 8 * cg) = wv; }
}
__device__ __forceinline__ void pool_unit(LAS unsigned char* lds, const bf16_t* UN, const bf16_t* WP, const float* pscale, bf16_t* MIX, int pu, int tid, int wave, int lane) {
    const int g = pu & 3, rb = pu >> 2; const size_t tok0 = (size_t)rb * 128;
    LAS bf16_t* DT = (LAS bf16_t*)lds; constexpr int PD = 264;
    const bf16_t* bp = WP + (size_t)g * 65536 + (size_t)(32 * wave + (lane & 31)) * 256 + 8 * (lane >> 5);
    bf16x8 bfr[16];
#pragma unroll
    for (int ks = 0; ks < 16; ++ks) bfr[ks] = *(const bf16x8*)(bp + 16 * ks);
    const float sc = pscale[g * 256 + 32 * wave + (lane & 31)];
    if (g == 0) pool_window<2>(DT, UN, tok0, g, tid); else if (g == 1) pool_window<4>(DT, UN, tok0, g, tid); else if (g == 2) pool_window<8>(DT, UN, tok0, g, tid); else pool_window<16>(DT, UN, tok0, g, tid);
    WG_BAR();
    const int r = lane & 31, hh = lane >> 5;
    f32x16 acc[4];
#pragma unroll
    for (int mb = 0; mb < 4; ++mb)
#pragma unroll
        for (int i = 0; i < 16; ++i) acc[mb][i] = 0.f;
#pragma unroll
    for (int ks = 0; ks < 16; ++ks) {
#pragma unroll
        for (int mb = 0; mb < 4; ++mb) acc[mb] = MFMA32(*(const LAS bf16x8*)(DT + (32 * mb + r) * PD + 16 * ks + 8 * hh), bfr[ks], acc[mb]); }
    const int n = 32 * wave + r;
#pragma unroll
    for (int mb = 0; mb < 4; ++mb)
#pragma unroll
        for (int i = 0; i < 16; ++i) MIX[(tok0 + 32 * mb + crow(i, hh)) * D + 3072 + g * 256 + n] = f2bf(acc[mb][i] * sc);
    WG_BAR();
}

#define LDS_WAIT() asm volatile("s_waitcnt lgkmcnt(0)" ::: "memory")
#define VM_WAIT() asm volatile("s_waitcnt vmcnt(0)" ::: "memory")
__device__ __forceinline__ unsigned pk2(float lo, float hi) { return (unsigned)f2bf(lo) | ((unsigned)f2bf(hi) << 16); }

struct CvtItem { const float* W; bf16_t* Wt; const float* gk; int ldw, srccol, nvalid, K, dstrow, k0, hasg; };
__device__ __forceinline__ void cvt_load(const CvtItem& d, f32x4 (&v)[8], f32x4 (&g)[2], int lane) {
    const int n4 = lane & 7, kr = lane >> 3;
    { const float* gp = d.gk + (d.hasg ? d.k0 : (d.k0 & 4095)) + 8 * (lane & 7);
      g[0] = *(const f32x4*)gp; g[1] = *(const f32x4*)(gp + 4); }
    const int c4 = 4 * n4 < d.nvalid ? 4 * n4 : d.nvalid - 4;
    const float* p = d.W + (size_t)(d.k0 + kr) * d.ldw + d.srccol + c4;
#pragma unroll
    for (int i = 0; i < 8; ++i) v[i] = *(const f32x4*)(p + (size_t)(8 * i) * d.ldw);
}
__device__ __forceinline__ void cvt_store(const CvtItem& d, const f32x4 (&v)[8], const f32x4 (&g)[2], LAS float* scr, int lane) {
    { const int n4 = lane & 7, kr = lane >> 3;
#pragma unroll
      for (int i = 0; i < 8; ++i)
#pragma unroll
          for (int e = 0; e < 4; ++e) scr[(kr + 8 * i) * 33 + 4 * n4 + e] = v[i][e]; }
    LDS_WAIT(); asm volatile("" ::: "memory");
    const int c8 = lane & 7; const int k0 = d.k0;
#pragma unroll
    for (int j = 0; j < 4; ++j) { const int n = (lane >> 3) + 8 * j; const LAS float* s = scr + (8 * c8) * 33 + n;
        const float z = n < d.nvalid ? 1.f : 0.f; const f32x4 one4 = {1.f, 1.f, 1.f, 1.f}; const f32x4 ga = (d.hasg ? g[0] : one4) * z, gb = (d.hasg ? g[1] : one4) * z;
        u32x4 o; o.x = cvt_pk_bf16(s[0 * 33] * ga[0], s[1 * 33] * ga[1]); o.y = cvt_pk_bf16(s[2 * 33] * ga[2], s[3 * 33] * ga[3]); o.z = cvt_pk_bf16(s[4 * 33] * gb[0], s[5 * 33] * gb[1]); o.w = cvt_pk_bf16(s[6 * 33] * gb[2], s[7 * 33] * gb[3]);
        *(u32x4*)(d.Wt + (size_t)(d.dstrow + n) * d.K + k0 + 8 * c8) = o; }
    LDS_WAIT(); asm volatile("" ::: "memory");
}
__device__ __forceinline__ int win_src_col(int d) {
    if (d < 2048) return d + (SRC_QA - 0);
    if (d < 4096) return d + (SRC_KA - 2048);
    if (d < 4608) return d + (SRC_QB - 4096);
    if (d < 5120) return d + (SRC_KB - 4608);
    if (d < 6144) return d + (SRC_GB - 5120);
    if (d < 7168) return d + (SRC_UC - 6144);
    if (d < 9216) return d + (SRC_VA - 7168);
    return d + (SRC_VB - 9216);
}
constexpr int I_IN = 64 * 320, I_Z = 64, I_O = 64 * 128, I_UP = 64 * 688, I_DN = 172 * 128, I_P = 128, I_LAYER = I_IN + I_Z + I_O + I_UP + I_DN + I_P;

__device__ __forceinline__ void res_row(const float* X, bf16_t* Hb, const bf16_t* Y, const f32x4 (&gv)[16], float* RS, float* OUT, int row, int lane) {
    f32x4 hv[16];
    if (X) { const f32x4* src = (const f32x4*)(X + (size_t)row * D) + lane;
#pragma unroll
        for (int j = 0; j < 16; ++j) hv[j] = src[64 * j];
    } else { const u32x2* src = (const u32x2*)(Hb + (size_t)row * D) + lane;
#pragma unroll
        for (int j = 0; j < 16; ++j) { const u32x2 w = src[64 * j]; hv[j] = (f32x4){__uint_as_float(w.x << 16), __uint_as_float(w.x & 0xffff0000u), __uint_as_float(w.y << 16), __uint_as_float(w.y & 0xffff0000u)}; } }
    if (Y) {
        const u32x2* yp = (const u32x2*)(Y + (size_t)row * D) + lane;
        f32x4 yv[16]; float s = 0.f;
#pragma unroll
        for (int j = 0; j < 16; ++j) { const u32x2 w = yp[64 * j]; yv[j] = (f32x4){__uint_as_float(w.x << 16), __uint_as_float(w.x & 0xffff0000u), __uint_as_float(w.y << 16), __uint_as_float(w.y & 0xffff0000u)}; s += yv[j].x * yv[j].x + yv[j].y * yv[j].y + yv[j].z * yv[j].z + yv[j].w * yv[j].w; }
        const float rs = rsqrtf(wave_sum_l(s, lane) * (1.f / D) + EPS);
#pragma unroll
        for (int j = 0; j < 16; ++j) hv[j] += yv[j] * rs * gv[j];
    }
    if (OUT) {
        f32x4* hp = (f32x4*)(OUT + (size_t)row * D) + lane;
#pragma unroll
        for (int j = 0; j < 16; ++j) hp[64 * j] = hv[j];
    } else {
        float s = 0.f;
#pragma unroll
        for (int j = 0; j < 16; ++j) s += hv[j].x * hv[j].x + hv[j].y * hv[j].y + hv[j].z * hv[j].z + hv[j].w * hv[j].w;
        const float sst = wave_sum_l(s, lane);
        if (lane == 0) RS[row] = sst;
        u32x2* op = (u32x2*)(Hb + (size_t)row * D) + lane;
#pragma unroll
        for (int j = 0; j < 16; ++j) { u32x2 o; o.x = cvt_pk_bf16(hv[j].x, hv[j].y); o.y = cvt_pk_bf16(hv[j].z, hv[j].w); op[64 * j] = o; }
    }
}

__device__ __forceinline__ void zlr_rows(const bf16_t* HN, const bf16_t* WZ, const float* RS, int nslot, float* ZLR, int rb, LAS unsigned char* lds, int tid, int wave, int lane) {
    const int r = lane & 31, h = lane >> 5;
    f32x16 acc;
#pragma unroll
    for (int e = 0; e < 16; ++e) acc[e] = 0.f;
    const bf16_t* ap = HN + (size_t)(rb * 32 + r) * D + wave * 512 + 8 * h;
    const bf16_t* bp = WZ + (size_t)r * D + wave * 512 + 8 * h;
    const float rst = pg8::row_rstd(RS, nslot, rb * 32 + (tid >> 4));
#pragma unroll 16
    for (int k = 0; k < 512; k += 16) acc = __builtin_amdgcn_mfma_f32_32x32x16_bf16(*(const bf16x8*)(ap + k), *(const bf16x8*)(bp + k), acc, 0, 0, 0);
    LAS float* red = (LAS float*)lds;
    if (r < 16) {
#pragma unroll
        for (int e = 0; e < 16; ++e) red[(wave * 32 + (e & 3) + 8 * (e >> 2) + 4 * h) * 16 + r] = acc[e];
    }
    __syncthreads();
    { const int row = tid >> 4, n = tid & 15; float s = 0.f;
#pragma unroll
      for (int w = 0; w < 8; ++w) s += red[(w * 32 + row) * 16 + n];
      ZLR[(size_t)(rb * 32 + row) * 16 + n] = s * rst; }
    __syncthreads();
}


__device__ __forceinline__ void fix_rows(const float* ZB, const float* wc, const float* bc, bf16_t* F, int it) {
    const int c4 = it % (DFF / 4), rest = it / (DFF / 4), rr = rest & 1, ti = rest >> 1, pm = ti + 1 + ti / 15, c0 = c4 * 4;
    const float* zb = ZB + (size_t)pm * 4 * NUP; const float* zp = zb - (size_t)4 * NUP;
    const float* r0 = zb + (size_t)rr * NUP; const float* r1 = rr ? zb : zp + (size_t)3 * NUP; const float* r2 = rr ? zp + (size_t)3 * NUP : zp + (size_t)2 * NUP;
    const f32x4 g0 = *(const f32x4*)(r0 + c0), g1 = *(const f32x4*)(r1 + c0), g2 = *(const f32x4*)(r2 + c0), v0 = *(const f32x4*)(r0 + DFF + c0), v1 = *(const f32x4*)(r1 + DFF + c0), v2 = *(const f32x4*)(r2 + DFF + c0);
    const f32x4 wg0 = *(const f32x4*)(wc + c0), wg1 = *(const f32x4*)(wc + NUP + c0), wg2 = *(const f32x4*)(wc + 2 * NUP + c0), wv0 = *(const f32x4*)(wc + DFF + c0), wv1 = *(const f32x4*)(wc + NUP + DFF + c0), wv2 = *(const f32x4*)(wc + 2 * NUP + DFF + c0);
    const f32x4 gt = *(const f32x4*)(bc + c0) + wg0 * g2 + wg1 * g1 + wg2 * g0, vl = *(const f32x4*)(bc + DFF + c0) + wv0 * v2 + wv1 * v1 + wv2 * v0;
    u32x2 w; w.x = cvt_pk_bf16(pg8::gelu_tanh_e(gt[0]) * vl[0], pg8::gelu_tanh_e(gt[1]) * vl[1]); w.y = cvt_pk_bf16(pg8::gelu_tanh_e(gt[2]) * vl[2], pg8::gelu_tanh_e(gt[3]) * vl[3]);
    *(u32x2*)(F + (size_t)(pm * 256 + rr) * DFF + c0) = w;
}
__device__ __forceinline__ float gelu_tanh_fast(float x) { const float u = 1.5957691216057308f * (x + 0.044715f * x * x * x); return x / (1.f + __expf(-u)); }
__device__ __forceinline__ void conv_run(const bf16_t* Z, const float* wc, const float* bc, bf16_t* F, int run, int tid) {
    const size_t t0 = (size_t)run * 32; const bool first = ((run * 32) & (SEQ - 1)) == 0;
    for (int oc = tid; oc < DFF / 8; oc += 512) {
        const int c0 = oc * 8;
        float wg[3][8], wv[3][8], bg[8], bv[8];
#pragma unroll
        for (int j = 0; j < 3; ++j)
#pragma unroll
            for (int q = 0; q < 2; ++q) { const f32x4 a = *(const f32x4*)(wc + (size_t)j * NUP + c0 + 4 * q), b = *(const f32x4*)(wc + (size_t)j * NUP + DFF + c0 + 4 * q);
#pragma unroll
                for (int e = 0; e < 4; ++e) { wg[j][4 * q + e] = a[e]; wv[j][4 * q + e] = b[e]; } }
#pragma unroll
        for (int q = 0; q < 2; ++q) { const f32x4 a = *(const f32x4*)(bc + c0 + 4 * q), b = *(const f32x4*)(bc + DFF + c0 + 4 * q);
#pragma unroll
            for (int e = 0; e < 4; ++e) { bg[4 * q + e] = a[e]; bv[4 * q + e] = b[e]; } }
        float g2[8], g1[8], v2[8], v1[8];
        if (first) {
#pragma unroll
            for (int e = 0; e < 8; ++e) { g2[e] = 0.f; g1[e] = 0.f; v2[e] = 0.f; v1[e] = 0.f; }
        } else {
            const bf16x8 a2 = *(const bf16x8*)(Z + (t0 - 2) * NUP + c0), a1 = *(const bf16x8*)(Z + (t0 - 1) * NUP + c0), b2 = *(const bf16x8*)(Z + (t0 - 2) * NUP + DFF + c0), b1 = *(const bf16x8*)(Z + (t0 - 1) * NUP + DFF + c0);
#pragma unroll
            for (int e = 0; e < 8; ++e) { g2[e] = bf2f((bf16_t)a2[e]); g1[e] = bf2f((bf16_t)a1[e]); v2[e] = bf2f((bf16_t)b2[e]); v1[e] = bf2f((bf16_t)b1[e]); }
        }
#pragma unroll 4
        for (int r = 0; r < 32; ++r) {
            const bf16x8 a0 = *(const bf16x8*)(Z + (t0 + r) * NUP + c0), b0 = *(const bf16x8*)(Z + (t0 + r) * NUP + DFF + c0);
            float o[8];
#pragma unroll
            for (int e = 0; e < 8; ++e) { const float g0 = bf2f((bf16_t)a0[e]), v0 = bf2f((bf16_t)b0[e]);
                const float gt = bg[e] + wg[0][e] * g2[e] + wg[1][e] * g1[e] + wg[2][e] * g0, vl = bv[e] + wv[0][e] * v2[e] + wv[1][e] * v1[e] + wv[2][e] * v0;
                o[e] = gelu_tanh_fast(gt) * vl; g2[e] = g1[e]; g1[e] = g0; v2[e] = v1[e]; v1[e] = v0; }
            u32x4 w; w.x = cvt_pk_bf16(o[0], o[1]); w.y = cvt_pk_bf16(o[2], o[3]); w.z = cvt_pk_bf16(o[4], o[5]); w.w = cvt_pk_bf16(o[6], o[7]);
            *(u32x4*)(F + (t0 + r) * DFF + c0) = w;
        }
    }
}

constexpr int NPH = 21;
struct Args { const float* in[21]; float* out; unsigned char* ws; int ph_lo, ph_hi; };

__device__ __forceinline__ const void* lds_ptr(volatile LAS unsigned* A, int i) {
    const unsigned lo = __builtin_amdgcn_readfirstlane(A[2 * i]), hi = __builtin_amdgcn_readfirstlane(A[2 * i + 1]);
    return (const void*)(const GAS void*)(((unsigned long long)hi << 32) | (unsigned long long)lo);
}
constexpr int ARGS_OFF = RING_BYTES + 1024;
#define FRESH_TID() int lane = fresh_lane(); const int tid = wave * 64 + lane
#define P(i) ((const float*)lds_ptr(AP, (i)))
#define WSP() ((unsigned char*)lds_ptr(AP, 22))
#define IN(k) (lo <= (k) && (k) < hi)
#define BOTH(k) (IN(k) && IN((k) + 1))
#define GRID_BAR(k) do { if (BOTH(k)) { XcdBarrier b_; b_.bar = (unsigned*)(WSP() + WS_CTL) + CW_BAR; b_.x = xb_xcc_id(); b_.st = MISC + 8; b_.wave = wave; xcd_barrier(b_); } } while (0)
#define REP(k) _Pragma("unroll") for (int rep_ = 0; rep_ < ((k) == MK_DOUBLE_PHASE ? 2 : 1); ++rep_)
__device__ __forceinline__ CvtItem cvt_decode(int it, unsigned char* ws, volatile LAS unsigned* AP) {
    CvtItem d; d.gk = nullptr; d.nvalid = 32; d.hasg = 1;
    const int l = it >= I_LAYER ? 1 : 0; int r = it - l * I_LAYER;
    unsigned char* wl = ws + WS_W0 + (size_t)l * W_LAYER;
    if (r < I_IN) { const int kb = r / 320, nb = r % 320, d0 = nb * 32; d.W = P(1) + (size_t)l * D * NIN; d.ldw = NIN; d.srccol = win_src_col(d0); d.Wt = (bf16_t*)(wl + OFF_WN); d.K = D; d.dstrow = d0; d.k0 = kb * 64; d.gk = P(17) + (size_t)l * D; if (!d.gk) { d.gk = P(17); d.hasg = 0; } return d; } r -= I_IN;
    if (r < I_Z) { d.W = P(1) + (size_t)l * D * NIN; d.ldw = NIN; d.srccol = SRC_ZLR; d.nvalid = 16; d.Wt = (bf16_t*)(wl + OFF_WZ); d.K = D; d.dstrow = 0; d.k0 = r * 64; d.gk = P(17) + (size_t)l * D; if (!d.gk) { d.gk = P(17); d.hasg = 0; } return d; } r -= I_Z;
    if (r < I_O) { const int kb = r / 128, nb = r % 128; d.W = P(12) + (size_t)l * D * D; d.ldw = D; d.srccol = nb * 32; d.Wt = (bf16_t*)(wl + OFF_WO); d.K = D; d.dstrow = nb * 32; d.k0 = kb * 64; if (!d.gk) { d.gk = P(17); d.hasg = 0; } return d; } r -= I_O;
    if (r < I_UP) { const int kb = r / 688, nb = r % 688, d0 = nb * 32;
        d.W = P(13) + (size_t)l * D * NUP; d.ldw = NUP; d.srccol = ((d0 >> 7) & 1) * DFF + 128 * (d0 >> 8) + (d0 & 127); d.Wt = (bf16_t*)(wl + OFF_WUP); d.K = D; d.dstrow = d0; d.k0 = kb * 64; d.gk = P(19) + (size_t)l * D; if (!d.gk) { d.gk = P(17); d.hasg = 0; } return d; } r -= I_UP;
    if (r < I_DN) { const int kb = r / 128, nb = r % 128; d.W = P(16) + (size_t)l * DFF * D; d.ldw = D; d.srccol = nb * 32; d.Wt = (bf16_t*)(wl + OFF_WDN); d.K = DFF; d.dstrow = nb * 32; d.k0 = kb * 64; if (!d.gk) { d.gk = P(17); d.hasg = 0; } return d; } r -= I_DN;
    { const int g = r >> 5, kb = (r >> 3) & 3, nb = r & 7; d.W = P(10) + ((size_t)l * 4 + g) * 65536; d.ldw = 256; d.srccol = nb * 32; d.Wt = (bf16_t*)(wl + OFF_WP) + (size_t)g * 65536; d.K = 256; d.dstrow = nb * 32; d.k0 = kb * 64; }
    if (!d.gk) { d.gk = P(17); d.hasg = 0; }
    return d;
}
constexpr int I_EARLY = I_IN + I_Z + I_P, I_LATE = I_O + I_UP + I_DN, I_TAIL = 16384;
template <int SLOT> __device__ __forceinline__ int cvt_slot_item(int t) {
    if (SLOT == 0) return t < I_IN + I_Z ? t : t + I_LATE;
    if (SLOT == 1) { if (t < I_LATE) return I_IN + I_Z + t; const int u = t - I_LATE; return I_LAYER + (u < I_IN + I_Z ? u : u + I_LATE); }
    return I_LAYER + I_IN + I_Z + t;
}
template <int SLOT> __device__ __forceinline__ void cvt_stream(int first, int stride, int n, unsigned char* ws, volatile LAS unsigned* AP, LAS float* scr, int lane) {
    if (n <= 0) return;
    CvtItem dA = cvt_decode(cvt_slot_item<SLOT>(first), ws, AP), dB = dA; f32x4 vA[8], gA[2], vB[8], gB[2];
    cvt_load(dA, vA, gA, lane);
    for (int k = 0; k < n; k += 2) {
        const int iB = k + 1 < n ? k + 1 : n - 1;
        dB = cvt_decode(cvt_slot_item<SLOT>(first + iB * stride), ws, AP); cvt_load(dB, vB, gB, lane);
        cvt_store(dA, vA, gA, scr, lane);
        if (k + 1 >= n) break;
        const int iA = k + 2 < n ? k + 2 : n - 1;
        dA = cvt_decode(cvt_slot_item<SLOT>(first + iA * stride), ws, AP); cvt_load(dA, vA, gA, lane);
        cvt_store(dB, vB, gB, scr, lane);
    }
}
template <int l, int LO, int HI> __device__ __forceinline__ void layer_phases(LAS unsigned char* lds, volatile LAS unsigned* MISC, volatile LAS unsigned* AP, const int wave, const int G, const int bx, const int vcu, const int gw, const int NGW) {
    constexpr int lo = LO, hi = HI;

        const int pb = 1 + 10 * l;
        if (IN(pb + 0)) REP(pb + 0) {
            unsigned char* ws = WSP(); unsigned char* wl = ws + WS_W0 + (size_t)l * W_LAYER;
            const bf16_t* HN = (const bf16_t*)(ws + WS_HN);
            { pg8::Gemm g; g.A[0] = HN; g.Bt[0] = (const bf16_t*)(wl + OFF_WN); g.A[1] = (const bf16_t*)(wl + OFF_WT); g.Bt[1] = HN; g.lda = D; g.ldb = D; g.K = D;
              pg8::Order2 S; S.nM0 = M / 256; S.nN0 = UNW / 256; S.nM1 = UTW / 256; S.nN1 = M / 256; S.G = G; S.c = bx;
              pg8::EpiBf16 E; E.O[0] = (bf16_t*)(ws + WS_UN); E.ldc[0] = UNW; E.O[1] = (bf16_t*)(ws + WS_UT); E.ldc[1] = M; E.rs = (const float*)(ws + WS_RS); E.nslot = 1; E.nostore = MK_SHADOW ? rep_ : 0;
              E.kmax = (unsigned*)(ws + WS_CTL) + CW_KMAX + l * 2048; E.nrm = lds + pg8::STAGE_BYTES;
              pg8::gemm_phase<pg8::EpiBf16, pg8::Order2, PG8_ALIGN, PG8_SP2>(lds, g, S, E, wave); }
            FRESH_TID();
            for (int rb = bx; rb < M / 32; rb += G) zlr_rows(HN, (const bf16_t*)(wl + OFF_WZ), (const float*)(ws + WS_RS), 1, (float*)(ws + WS_ZLR), rb, lds, tid, wave, lane);
            GRID_BAR(pb + 0);
        }
        if (IN(pb + 1)) REP(pb + 1) {
            FRESH_TID();
            unsigned char* ws = WSP(); unsigned char* gs = ws + WS_GLA;
            const bf16_t* UN = (const bf16_t*)(ws + WS_UN); const bf16_t* UT = (const bf16_t*)(ws + WS_UT); bf16_t* MIX = (bf16_t*)(ws + WS_MIX);
            { const float* w2 = P(2) + (size_t)l * 16 * 512; const float* bgt = P(3) + (size_t)l * 512; const float* ZLR = (const float*)(ws + WS_ZLR);
              FRESH_TID();
              for (int u = vcu; u < 512; u += G) gla::g1_unit(lds, UN, UT, ZLR, w2, bgt, gs, u, tid, wave, lane); }
            { const bf16_t* WP = (const bf16_t*)(ws + WS_W0 + (size_t)l * W_LAYER + OFF_WP); const float* psc = P(11) + (size_t)l * 1024;
              FRESH_TID();
              for (int pu = vcu; pu < 256; pu += G) pool_unit(lds, UN, WP, psc, MIX, pu, tid, wave, lane); }
            { const float lam_init = 0.8f - 0.6f * expf(-0.3f * (float)l);
              float lam; { const float* q1 = P(4) + l * 128; const float* k1 = P(5) + l * 128; const float* q2 = P(6) + l * 128; const float* k2 = P(7) + l * 128;
                const float s1 = wave_sum_l(q1[lane] * k1[lane] + q1[lane + 64] * k1[lane + 64], lane), s2 = wave_sum_l(q2[lane] * k2[lane] + q2[lane + 64] * k2[lane + 64], lane);
                lam = expf(s1) - expf(s2) + lam_init; }
              lam = __uint_as_float(__builtin_amdgcn_readfirstlane(__float_as_uint(lam)));
              const float* gsub = P(8) + l * 256;
              FRESH_TID();
              unsigned* ctl = (unsigned*)(ws + WS_CTL);
              if (tid < 256) ((LAS float*)(lds + att::GSUB_OFF))[tid] = gsub[tid];
              for (;;) {
                  if (tid == 0) MISC[16] = __hip_atomic_fetch_add(ctl + CW_QUEUE + l * 64 + 32 * rep_, 1u, __ATOMIC_RELAXED, __HIP_MEMORY_SCOPE_AGENT);
                  __syncthreads();
                  const int idx = __builtin_amdgcn_readfirstlane((int)MISC[16]);
                  __syncthreads();
                  constexpr int NSLOT = ((l == 0) ? I_LAYER : I_LATE) - I_TAIL, NCH = (NSLOT + 127) / 128, NQ = 512 + NCH;
                  if (idx >= NQ) break;
                  int a0, a1;
                  if (idx < 256) { a0 = idx; a1 = idx + 1; }
                  else { const int p_ = idx - 256; constexpr int NQ2 = 256 + NCH; a0 = 256 + (int)(((long long)p_ * 256) / NQ2); a1 = 256 + (int)(((long long)(p_ + 1) * 256) / NQ2); }
                  if (a1 > a0) att::unit(lds, UN, UT, MIX, ctl + CW_KMAX + l * 2048, a0 & 1, 7 - ((a0 >> 1) & 7), 31 - (a0 >> 4), lam, nullptr, 1.f - lam_init, wave, lane, MK_SHADOW * rep_);
                  else { if (rep_ == 0) { FRESH_TID(); const int f_ = (idx - a0) * 128 + wave, r_ = (NSLOT - f_ + 7) / 8;     cvt_stream<l == 0 ? 1 : 2>(f_, 8, f_ < NSLOT ? (r_ < 16 ? r_ : 16) : 0, ws, AP, (LAS float*)(lds + wave * 16384), lane); }
                         __syncthreads(); } } }
            GRID_BAR(pb + 1);
        }
        if (IN(pb + 2)) REP(pb + 2) {
            FRESH_TID();
            unsigned char* gs = WSP() + WS_GLA;
            for (int p = vcu * 512 + tid; p < 131072; p += G * 512) gla::g2_scan(gs, p);
            GRID_BAR(pb + 2);
        }
        if (IN(pb + 3)) REP(pb + 3) {
            FRESH_TID();
            unsigned char* ws = WSP(); unsigned char* gs = ws + WS_GLA; const float* gg = P(9) + (size_t)l * 1024;
            for (int u = vcu; u < 512; u += G) gla::g3_unit(lds, (const bf16_t*)(ws + WS_UN), gs, gg, (bf16_t*)(ws + WS_MIX), u, tid, wave, lane);
            GRID_BAR(pb + 3);
        }
        if (IN(pb + 4)) {
            unsigned char* ws = WSP(); unsigned char* wl = ws + WS_W0 + (size_t)l * W_LAYER;
            pg8::Gemm g; g.A[0] = (const bf16_t*)(ws + WS_MIX); g.Bt[0] = (const bf16_t*)(wl + OFF_WO); g.A[1] = g.A[0]; g.Bt[1] = g.Bt[0]; g.lda = D; g.ldb = D; g.K = D;
            pg8::Order2 S; S.nM0 = M / 256; S.nN0 = D / 256; S.nM1 = 0; S.nN1 = 1; S.G = G; S.c = bx;
            pg8::EpiBf16 E; E.O[0] = (bf16_t*)(ws + WS_Y); E.ldc[0] = D; E.O[1] = E.O[0]; E.ldc[1] = D; E.rs = nullptr; E.nslot = 0;
            pg8::gemm_phase<pg8::EpiBf16, pg8::Order2, PG8_ALIGN, PG8_SP2>(lds, g, S, E, wave);
            GRID_BAR(pb + 4);
        }
        if (IN(pb + 5)) {
            FRESH_TID();
            unsigned char* ws = WSP(); const bf16_t* Y = (const bf16_t*)(ws + WS_Y); const float* gp = P(18) + (size_t)l * D; bf16_t* HN = (bf16_t*)(ws + WS_HN); float* RS = (float*)(ws + WS_RS);
            f32x4 gv[16];
#pragma unroll
            for (int j = 0; j < 16; ++j) gv[j] = ((const f32x4*)gp)[lane + 64 * j];
            for (int m = gw; m < M; m += NGW) res_row(nullptr, HN, Y, gv, RS, nullptr, m, lane);
            GRID_BAR(pb + 5);
        }
        if (IN(pb + 6)) REP(pb + 6) {
            unsigned char* ws = WSP(); unsigned char* wl = ws + WS_W0 + (size_t)l * W_LAYER;
            pg8::Gemm g; g.A[0] = (const bf16_t*)(ws + WS_HN); g.Bt[0] = (const bf16_t*)(wl + OFF_WUP); g.A[1] = g.A[0]; g.Bt[1] = g.Bt[0]; g.lda = D; g.ldb = D; g.K = D;
            pg8::Order2 S; S.nM0 = M / 256; S.nN0 = NUP / 256; S.nM1 = 0; S.nN1 = 1; S.G = G; S.c = bx;
            pg8::EpiConvGlu E; E.F = (bf16_t*)(ws + WS_F); E.ZB = (float*)(ws + WS_ZB); E.wcv = P(14) + (size_t)l * 3 * NUP; E.bcv = P(15) + (size_t)l * NUP; E.rs = (const float*)(ws + WS_RS); E.nslot = 1; E.halo = lds + 131072;
            pg8::gemm_phase<pg8::EpiConvGlu, pg8::Order2, PG8_ALIGN, PG8_SP2>(lds, g, S, E, wave);
            if (rep_ == 0) { const int nwg_ = G < 64 ? G : 64;
                if (bx >= G - nwg_) { FRESH_TID(); const int w_ = (bx - (G - nwg_)) * 8 + wave, nw_ = nwg_ * 8;
                    cvt_stream<l == 0 ? 1 : 2>(((l == 0) ? I_LAYER : I_LATE) - I_TAIL + w_, nw_, (I_TAIL - w_ + nw_ - 1) / nw_, ws, AP, (LAS float*)(lds + wave * 16384), lane); } }
            GRID_BAR(pb + 6);
        }
        if (IN(pb + 7)) REP(pb + 7) {
            FRESH_TID();
            unsigned char* ws = WSP(); const float* wc = P(14) + (size_t)l * 3 * NUP; const float* bc = P(15) + (size_t)l * NUP;
            for (int it = vcu * 512 + tid; it < 30 * 2 * (DFF / 4); it += G * 512) fix_rows((const float*)(ws + WS_ZB), wc, bc, (bf16_t*)(ws + WS_F), it);
            GRID_BAR(pb + 7);
        }
        if (IN(pb + 8)) {
            unsigned char* ws = WSP(); unsigned char* wl = ws + WS_W0 + (size_t)l * W_LAYER;
            pg8::Gemm g; g.A[0] = (const bf16_t*)(ws + WS_F); g.Bt[0] = (const bf16_t*)(wl + OFF_WDN); g.A[1] = g.A[0]; g.Bt[1] = g.Bt[0]; g.lda = DFF; g.ldb = DFF; g.K = DFF;
            pg8::Order2 S; S.nM0 = M / 256; S.nN0 = D / 256; S.nM1 = 0; S.nN1 = 1; S.G = G; S.c = bx;
            pg8::EpiBf16 E; E.O[0] = (bf16_t*)(ws + WS_Y); E.ldc[0] = D; E.O[1] = E.O[0]; E.ldc[1] = D; E.rs = nullptr; E.nslot = 0;
            pg8::gemm_phase<pg8::EpiBf16, pg8::Order2, PG8_ALIGN, PG8_SP2>(lds, g, S, E, wave);
            GRID_BAR(pb + 8);
        }
        if (IN(pb + 9)) {
            FRESH_TID();
            unsigned char* ws = WSP(); const bf16_t* Y = (const bf16_t*)(ws + WS_Y); const float* gp = P(20) + (size_t)l * D; bf16_t* HN = (bf16_t*)(ws + WS_HN); float* RS = (float*)(ws + WS_RS);
            float* OUT = l + 1 < DEPTH ? nullptr : (float*)P(21);
            f32x4 gv[16];
#pragma unroll
            for (int j = 0; j < 16; ++j) gv[j] = ((const f32x4*)gp)[lane + 64 * j];
            for (int m = gw; m < M; m += NGW) res_row(nullptr, HN, Y, gv, RS, OUT, m, lane);
            GRID_BAR(pb + 9);
        }
}
template <int LO, int HI> __global__ void __launch_bounds__(512, 2) fwd(Args args) {
    extern __shared__ __attribute__((aligned(16))) unsigned char lds_raw[];
    LAS unsigned char* lds = (LAS unsigned char*)lds_raw;
    volatile LAS unsigned* MISC = (volatile LAS unsigned*)(lds + MISC_OFF);
    volatile LAS unsigned* AP = (volatile LAS unsigned*)(lds + ARGS_OFF);
    const int wave = __builtin_amdgcn_readfirstlane((int)threadIdx.x >> 6);
    const int G = gridDim.x; const int bx = blockIdx.x; const int vcu = (G % 8 == 0) ? (bx % 8) * (G / 8) + bx / 8 : bx;
    constexpr int lo = LO, hi = HI;
    for (int u = threadIdx.x; u < (LDS_BYTES - LDSCTL_OFF) / 4; u += 512) ((LAS unsigned*)(lds + LDSCTL_OFF))[u] = 0u;
    __syncthreads();
    if (threadIdx.x == 0) {
        volatile LAS unsigned long long* A8 = (volatile LAS unsigned long long*)(lds + ARGS_OFF);
#pragma unroll
        for (int i = 0; i < 21; ++i) A8[i] = (unsigned long long)args.in[i];
        A8[21] = (unsigned long long)args.out; A8[22] = (unsigned long long)args.ws;
    }
    __syncthreads();
    if (hi - lo > 1) (void)xcd_barrier_post((unsigned*)(WSP() + WS_CTL) + CW_BAR, MISC + 8);
    const int gw = vcu * 8 + wave, NGW = G * 8;

    if (IN(0)) REP(0) {
        FRESH_TID();
        unsigned char* ws = WSP();
        LAS float* scr = (LAS float*)(lds + wave * 16384);
        cvt_stream<0>(gw, NGW, gw < I_EARLY ? (I_EARLY - gw + NGW - 1) / NGW : 0, ws, AP, scr, lane);
        { const float* x = P(0); bf16_t* HN = (bf16_t*)(ws + WS_HN); float* RS = (float*)(ws + WS_RS);
          f32x4 gv[16];
#pragma unroll
          for (int j = 0; j < 16; ++j) gv[j] = (f32x4){0.f, 0.f, 0.f, 0.f};
          for (int m = gw; m < M; m += NGW) res_row(x, HN, nullptr, gv, RS, nullptr, m, lane); }
        GRID_BAR(0);
    }

    layer_phases<0, LO, HI>(lds, MISC, AP, wave, G, bx, vcu, gw, NGW);
    layer_phases<1, LO, HI>(lds, MISC, AP, wave, G, bx, vcu, gw, NGW);
}

static int g_grid = 0;
template <int LO, int HI> static void launch_range(hipStream_t stream, const Args& a) {
    static bool attr = false;
    if (!attr) { if (hipFuncSetAttribute((const void*)fwd<LO, HI>, hipFuncAttributeMaxDynamicSharedMemorySize, LDS_BYTES) != hipSuccess) fprintf(stderr, "kernel_launch: hipFuncSetAttribute failed\n"); attr = true; }
    hipLaunchKernelGGL((fwd<LO, HI>), dim3(g_grid), dim3(512), LDS_BYTES, stream, a);
    const hipError_t le = hipPeekAtLastError();
    if (le != hipSuccess) fprintf(stderr, "kernel_launch: fwd launch [%d,%d) failed: %s\n", LO, HI, hipGetErrorName(le));
}
template <int P> static void launch_each(hipStream_t stream, const Args& a) { if constexpr (P < NPH) { launch_range<P, P + 1>(stream, a); launch_each<P + 1>(stream, a); } }
extern "C" void kernel_launch(void* const* d_in, const int* in_sizes, int n_in, void* d_out, int out_size, void* d_ws, size_t ws_size, hipStream_t stream) {
    if (n_in != 21 || ws_size < WS_END) { fprintf(stderr, "kernel_launch: unexpected n_in %d or ws %zu < %zu\n", n_in, ws_size, (size_t)WS_END); return; }
    if (g_grid == 0) {
        int dev = 0, cus = 0;
        if (hipGetDevice(&dev) != hipSuccess || hipDeviceGetAttribute(&cus, hipDeviceAttributeMultiprocessorCount, dev) != hipSuccess) { fprintf(stderr, "kernel_launch: device query failed\n"); g_grid = -1; return; }
        int per_cu = 0;
        (void)hipFuncSetAttribute((const void*)fwd<0, NPH>, hipFuncAttributeMaxDynamicSharedMemorySize, LDS_BYTES);
        if (hipOccupancyMaxActiveBlocksPerMultiprocessor(&per_cu, (const void*)fwd<0, NPH>, 512, LDS_BYTES) != hipSuccess || per_cu < 1)
            fprintf(stderr, "kernel_launch: occupancy query reports %d workgroups per CU for 512 threads + %d B LDS; launching one per CU anyway\n", per_cu, LDS_BYTES);
        (void)hipGetLastError();
        g_grid = cus;
    }
    if (g_grid < 0) return;
    (void)hipMemsetAsync((char*)d_ws + WS_CTL, 0, CTL_ZERO_BYTES, stream);
    Args a{};
    for (int i = 0; i < 21; ++i) a.in[i] = (const float*)d_in[i];
    a.out = (float*)d_out; a.ws = (unsigned char*)d_ws;
#if MK_ONE_LAUNCH
    launch_range<0, NPH>(stream, a);
#else
    launch_each<0>(stream, a);
#endif
}
```

```cpp
#include <hip/hip_runtime.h>
#include <stdint.h>
#include <stdio.h>

typedef unsigned short bf16_t;
typedef short bf16x8 __attribute__((ext_vector_type(8)));
typedef float f32x4 __attribute__((ext_vector_type(4)));
typedef float f32x16 __attribute__((ext_vector_type(16)));

constexpr int D = 4096, SEQ = 4096, M = 8192, DEPTH = 2;
constexpr int NIN = 10256, DFF = 11008, NUP = 22016;
constexpr int UNW = 7168, UTW = 3072;
constexpr float EPS = 1e-6f;
constexpr int UN_QA = 0, UN_KA = 2048, UN_QB = 4096, UN_KB = 4608, UN_GB = 5120, UN_UC = 6144;
constexpr int SRC_QA = 0, SRC_KA = 2048, SRC_VA = 4096, SRC_QB = 6144, SRC_KB = 6656, SRC_VB = 7168, SRC_GB = 8192, SRC_ZLR = 9216, SRC_UC = 9232;

constexpr size_t MiB = 1u << 20;
constexpr size_t WS_CTL = 0;
constexpr size_t WS_W0 = 1 * MiB;
constexpr size_t OFF_WN = 0, OFF_WT = 56 * MiB, OFF_WO = 80 * MiB, OFF_WUP = 112 * MiB, OFF_WDN = 284 * MiB, OFF_WP = 370 * MiB, W_LAYER = 371 * MiB;
constexpr size_t WS_HN = WS_W0 + 2 * W_LAYER;
constexpr size_t WS_UN = WS_HN + 64 * MiB;
constexpr size_t WS_UT = WS_UN + 112 * MiB;
constexpr size_t WS_ZLR = WS_UT + 48 * MiB;
constexpr size_t WS_MIX = WS_ZLR + 1 * MiB;
constexpr size_t WS_Y = WS_MIX + 64 * MiB;
constexpr size_t WS_Z = WS_Y + 128 * MiB;
constexpr size_t WS_F = WS_Z + 344 * MiB;
constexpr size_t WS_DP = WS_F + 172 * MiB;
constexpr size_t WS_END = WS_DP + 16 * MiB;

__device__ __forceinline__ bf16_t f2bf(float f) { unsigned u = __float_as_uint(f); u += 0x7fffu + ((u >> 16) & 1u); return (bf16_t)(u >> 16); }
__device__ __forceinline__ float bf2f(bf16_t b) { return __uint_as_float(((unsigned)b) << 16); }
#ifndef MK_ONE_LAUNCH
#define MK_ONE_LAUNCH 1
#endif
#ifndef MK_DOUBLE_PHASE
#define MK_DOUBLE_PHASE (-1)
#endif
#ifndef MK_SHADOW
#define MK_SHADOW 0
#endif

#define LAS __attribute__((address_space(3)))
#define GAS __attribute__((address_space(1)))
typedef unsigned u32x4 __attribute__((ext_vector_type(4)));
typedef unsigned u32x2 __attribute__((ext_vector_type(2)));
typedef float f32x2 __attribute__((ext_vector_type(2)));
typedef GAS unsigned gu32;
#define RLX_AGENT __ATOMIC_RELAXED, __HIP_MEMORY_SCOPE_AGENT
constexpr size_t WS_RS = WS_DP + 12 * MiB;
constexpr size_t WS_ZB = WS_DP;
constexpr size_t OFF_WZ = 370 * MiB + 512 * 1024;
constexpr int RING_BYTES = 141312, LDSCTL_OFF = RING_BYTES, MISC_OFF = LDSCTL_OFF + 320, LDS_BYTES = 147456;
constexpr int CW_BAR = 4096, CW_KMAX = 8192, CW_QUEUE = 12288;
constexpr int CW_CNT = 16384;
constexpr size_t CTL_SS = 128 * 1024;
constexpr size_t CTL_ZERO_BYTES = 128 * 1024;
constexpr size_t WS_X = WS_Z + 160 * MiB;

__device__ __forceinline__ int fresh_lane() { unsigned z = 0u; asm volatile("" : "+s"(z)); return (int)__builtin_amdgcn_mbcnt_hi(~0u, __builtin_amdgcn_mbcnt_lo(~0u, z)); }
__device__ __forceinline__ float shfl_xor_l(float v, int m, int lane) { return __int_as_float(__builtin_amdgcn_ds_bpermute((lane ^ m) << 2, __float_as_int(v))); }
__device__ __forceinline__ float wave_sum_l(float v, int lane) {
#pragma unroll
    for (int o = 1; o < 64; o <<= 1) v += shfl_xor_l(v, o, lane);
    return v;
}
__device__ __forceinline__ unsigned cvt_pk_bf16(float lo, float hi) { unsigned r; asm volatile("v_cvt_pk_bf16_f32 %0, %1, %2" : "=v"(r) : "v"(lo), "v"(hi)); return r; }

#define XB_TMO      128
#define XB_XCNT(j)  (256  + 64 * (j))
#define XB_XSUB(j)  (1280 + 64 * (j))
#define XB_XGEN(j)  (2304 + 64 * (j))
#define XB_TOP      3328
#define XB_TOPGEN   3392
#define XCD_BAR_WORDS 3456
#define XB_SPIN_CAP (1u << 18)
__device__ __forceinline__ unsigned xb_ld(unsigned* p)              { return __hip_atomic_load(p, __ATOMIC_RELAXED, __HIP_MEMORY_SCOPE_AGENT); }
__device__ __forceinline__ unsigned xb_add(unsigned* p, unsigned v) { return __hip_atomic_fetch_add(p, v, __ATOMIC_RELAXED, __HIP_MEMORY_SCOPE_AGENT); }
__device__ __forceinline__ unsigned xb_xcc_id() { return (unsigned)__builtin_amdgcn_s_getreg((3 << 11) | 20) & 0xFu; }
#define XB_SPIN(cond, bar) do { unsigned _sp = 0; while (cond) { __builtin_amdgcn_s_sleep(1); \
    if ((++_sp & 255u) == 0u) { if (xb_ld(&(bar)[XB_TMO])) break; if (_sp > XB_SPIN_CAP) { atomicAdd(&(bar)[XB_TMO], 1u); break; } } } } while (0)
struct XcdBarrier { unsigned* bar; unsigned x; volatile LAS unsigned* st; int wave; };
__device__ __forceinline__ XcdBarrier xcd_barrier_post(unsigned* bar, volatile LAS unsigned* st) {
    XcdBarrier b; b.bar = bar; b.x = xb_xcc_id(); b.st = st;
    if (threadIdx.x == 0) (void)xb_add(&bar[XB_XCNT(b.x)], 1u);
    return b;
}
__device__ __forceinline__ void xcd_barrier_complete(unsigned* bar, unsigned x, unsigned& nloc, unsigned& nx) {
    const unsigned G = gridDim.x * gridDim.y * gridDim.z;
    unsigned sum, cnt, mine, sp = 0u;
    for (;;) {
        sum = 0u; cnt = 0u; mine = 0u;
#pragma unroll
        for (unsigned j = 0; j < 16; ++j) { const unsigned c = xb_ld(&bar[XB_XCNT(j)]); sum += c; cnt += (c > 0u) ? 1u : 0u; mine = (j == x) ? c : mine; }
        if (sum == G) break;
        __builtin_amdgcn_s_sleep(1);
        if ((++sp & 255u) == 0u) { if (xb_ld(&bar[XB_TMO])) break; if (sp > XB_SPIN_CAP) { atomicAdd(&bar[XB_TMO], 1u); break; } }
    }
    nloc = mine > 0u ? mine : 1u; nx = cnt > 0u ? cnt : 1u;
}
__device__ __forceinline__ void xcd_barrier(const XcdBarrier& b) {
    asm volatile("s_waitcnt vmcnt(0)" ::: "memory");
    __syncthreads();
    if (b.wave == 0 && fresh_lane() == 0) {
        unsigned* bar = b.bar;
        __builtin_amdgcn_s_waitcnt(0);
        unsigned nloc = b.st[0], nx = b.st[1];
        if (nloc == 0u) { xcd_barrier_complete(bar, b.x, nloc, nx); b.st[0] = nloc; b.st[1] = nx; }
        const unsigned old = xb_add(&bar[XB_XSUB(b.x)], 1u);
        const unsigned gen = old / nloc;
        if (old + 1u == (gen + 1u) * nloc) {
            __builtin_amdgcn_fence(__ATOMIC_RELEASE, "agent");
            asm volatile("s_waitcnt vmcnt(0)" ::: "memory");
            const unsigned og = xb_add(&bar[XB_TOP], 1u);
            const unsigned tg = og / nx;
            if (og + 1u == (tg + 1u) * nx) xb_add(&bar[XB_TOPGEN], 1u);
            else XB_SPIN(xb_ld(&bar[XB_TOPGEN]) == tg, bar);
            __builtin_amdgcn_fence(__ATOMIC_ACQUIRE, "agent");
            xb_add(&bar[XB_XGEN(b.x)], 1u);
            asm volatile("s_waitcnt vmcnt(0)" ::: "memory");
        } else {
            XB_SPIN(xb_ld(&bar[XB_XGEN(b.x)]) == gen, bar);
            __builtin_amdgcn_fence(__ATOMIC_ACQUIRE, "agent");
            asm volatile("s_waitcnt vmcnt(0)" ::: "memory");
        }
    }
    __syncthreads();
}

namespace pg8 {
constexpr int BM = 256, BK = 64, HALF = 128, HTB = HALF * BK * 2, STAGE_BYTES = 8 * HTB, NXCD = 8, WGM = 8;
__host__ __device__ __forceinline__ int lds_byte(int r, int c) { const int st = (r >> 4) * 2 + (c >> 5), rr = r & 15, cc = c & 31, ob = rr * 64 + cc * 2; return st * 1024 + (ob ^ (((ob >> 9) & 1) << 5)); }
__host__ __device__ __forceinline__ void stage_rc(int b, int& R, int& C) { const int st = b / 1024, sb = b % 1024, swz = sb ^ (((sb >> 9) & 1) << 5); R = (st >> 1) * 16 + swz / 64; C = (st & 1) * 32 + (swz % 64) / 2; }
__host__ __device__ __forceinline__ int perm32(int rho) { const int n = rho >> 4, i = rho & 15; return 8 * (i >> 2) + 4 * n + (i & 3); }

struct Unit { int pm, pn, kind; };
struct Gemm { const bf16_t* A[2]; const bf16_t* Bt[2]; int lda, ldb, K; };

__device__ __forceinline__ void tile_of(int wgid, int nM, int nN, int& pm, int& pn) {
    const int nwg = nM * nN; { const int q = nwg / NXCD, r = nwg % NXCD, xcd = wgid % NXCD, off = wgid / NXCD; wgid = (xcd < r ? xcd * (q + 1) : r * (q + 1) + (xcd - r) * q) + off; }
    const int nig = WGM * nN, gid = wgid / nig, fm = gid * WGM, gsz = (nM - fm) < WGM ? (nM - fm) : WGM;
    pm = fm + ((wgid % nig) % gsz); pn = (wgid % nig) / gsz;
}
struct Order2 {
    int nM0, nN0, nM1, nN1, G, c;
    __device__ __forceinline__ bool next(int i, Unit& u) const {
        const int L = i * G + c, n0 = nM0 * nN0;
        if (L < n0) { u.kind = 0; tile_of(L, nM0, nN0, u.pm, u.pn); return true; }
        if (L < n0 + nM1 * nN1) { u.kind = 1; tile_of(L - n0, nM1, nN1, u.pm, u.pn); return true; }
        return false;
    }
    __device__ __forceinline__ void a_ready(const Unit&) const {}
    __device__ __forceinline__ void done(const Unit&) const {}
};

__device__ __forceinline__ float row_rstd(const float* X, int nslot, int row) { float s = X[row]; for (int k = 1; k < nslot; ++k) s += X[(size_t)k * 8192 + row];
    return rsqrtf(s * (1.f / 4096.f) + EPS); }
struct EpiBf16 {
    static constexpr bool PERM = true;
    int nostore = 0;
    bf16_t* O[2]; int ldc[2]; const float* rs; int nslot;
    unsigned* kmax = nullptr; LAS unsigned char* nrm = nullptr;
    __device__ __forceinline__ void operator()(const f32x4 (&acc)[2][2][4][2], const Unit& u, int wr, int wc, int fr, int fq) const {
        asm volatile("" : "+v"(fr), "+v"(fq));
        const bool kn = kmax != nullptr && u.kind == 0 && u.pn >= UN_KA / 256 && u.pn < UN_KA / 256 + 8;
        LAS float* NT = (LAS float*)nrm;
        const int row0 = u.pm * BM + wr * 64 + fr, col0 = u.pn * BM + wc * 32 + 8 * fq;
        bf16_t* base = u.kind ? O[1] : O[0]; const int ld = u.kind ? ldc[1] : ldc[0];
        f32x4 cs[2][2];
#pragma unroll
        for (int bj = 0; bj < 2; ++bj)
#pragma unroll
            for (int n = 0; n < 2; ++n) { cs[bj][n] = (f32x4){1.f, 1.f, 1.f, 1.f}; if (rs && u.kind) {
#pragma unroll
                for (int e = 0; e < 4; ++e) cs[bj][n][e] = row_rstd(rs, nslot, col0 + bj * HALF + 4 * n + e); } }
        float rsv[2][4];
#pragma unroll
        for (int ai = 0; ai < 2; ++ai)
#pragma unroll
            for (int m = 0; m < 4; ++m) rsv[ai][m] = (rs && !u.kind) ? row_rstd(rs, nslot, row0 + ai * HALF + m * 16) : 1.f;
#pragma unroll
        for (int ai = 0; ai < 2; ++ai)
#pragma unroll
            for (int m = 0; m < 4; ++m) { const int row = row0 + ai * HALF + m * 16; bf16_t* rowp = base + (size_t)row * ld + col0;
                const float rsc = rsv[ai][m];
#pragma unroll
                for (int bj = 0; bj < 2; ++bj) { const f32x4 v0 = acc[ai][bj][m][0] * cs[bj][0] * rsc, v1 = acc[ai][bj][m][1] * cs[bj][1] * rsc;
                    u32x4 w; w.x = cvt_pk_bf16(v0[0], v0[1]); w.y = cvt_pk_bf16(v0[2], v0[3]); w.z = cvt_pk_bf16(v1[0], v1[1]); w.w = cvt_pk_bf16(v1[2], v1[3]);
                    if (nostore) asm volatile("" :: "v"(w.x), "v"(w.y), "v"(w.z), "v"(w.w)); else *(u32x4*)(rowp + bj * HALF) = w;
                    if (kn) { float s = 0.f;
#pragma unroll
                        for (int e = 0; e < 4; ++e) { const unsigned q = e == 0 ? w.x : e == 1 ? w.y : e == 2 ? w.z : w.w; const float a = __uint_as_float(q << 16), b = __uint_as_float(q & 0xffff0000u); s += a * a + b * b; }
                        const int ln = fq * 16 + fr; s += shfl_xor_l(s, 16, ln); s += shfl_xor_l(s, 32, ln);
                        if (fq == 0) NT[((ai * HALF + wr * 64 + m * 16 + fr) * 4 + wc) * 2 + bj] = s; } } }
        if (kn) {
            asm volatile("s_waitcnt lgkmcnt(0)" ::: "memory"); __builtin_amdgcn_s_barrier(); asm volatile("" ::: "memory");
            const int wv = wr * 4 + wc, ln = fq * 16 + fr, t = wv * 64 + ln, rl = t >> 1, mp = t & 1;
            float nv = sqrtf((NT[(rl * 4 + 0) * 2 + mp] + NT[(rl * 4 + 1) * 2 + mp]) + (NT[(rl * 4 + 2) * 2 + mp] + NT[(rl * 4 + 3) * 2 + mp]));
#pragma unroll
            for (int o = 2; o < 64; o <<= 1) nv = fmaxf(nv, shfl_xor_l(nv, o, ln));
            if (ln < 2) __hip_atomic_fetch_max(kmax + (((u.pm >> 4) * 8 + (u.pn - UN_KA / 256)) * 2 + mp) * 64 + (u.pm & 15) * 4 + (wv >> 1), __float_as_uint(nv), __ATOMIC_RELAXED, __HIP_MEMORY_SCOPE_AGENT);
        }
    }
};
struct EpiF32 {
    static constexpr bool PERM = false;
    float* C; int ldc;
    __device__ __forceinline__ void operator()(const f32x4 (&acc)[2][2][4][2], const Unit& u, int wr, int wc, int fr, int fq) const {
        const int row0 = u.pm * BM + wr * 64 + fr, col0 = u.pn * BM + wc * 32 + 4 * fq;
#pragma unroll
        for (int ai = 0; ai < 2; ++ai)
#pragma unroll
            for (int m = 0; m < 4; ++m) { float* rowp = C + (size_t)(row0 + ai * HALF + m * 16) * ldc + col0;
#pragma unroll
                for (int bj = 0; bj < 2; ++bj)
#pragma unroll
                    for (int n = 0; n < 2; ++n) *(f32x4*)(rowp + bj * HALF + n * 16) = acc[ai][bj][m][n]; }
    }
};


__device__ __forceinline__ float dpp_ror1(float x) { return __int_as_float(__builtin_amdgcn_update_dpp(0, __float_as_int(x), 0x121, 0xf, 0xf, false)); }
__device__ __forceinline__ float dpp_ror2(float x) { return __int_as_float(__builtin_amdgcn_update_dpp(0, __float_as_int(x), 0x122, 0xf, 0xf, false)); }
__device__ __forceinline__ float gelu_tanh_e(float x) { const float u = x * __builtin_fmaf(x * x, -0.10294324f, -2.3022082f); return x * __builtin_amdgcn_rcpf(1.f + __builtin_amdgcn_exp2f(u)); }
__device__ __forceinline__ void conv_taps_dpp(float& gt, float& vl, float s1g, float s2g, float w1g, float w0g, float s1v, float s2v, float w1v, float w0v) {
    asm("s_nop 1\n\tv_fmac_f32_dpp %0, %2, %4 row_ror:1 row_mask:0xf bank_mask:0xf\n\tv_fmac_f32_dpp %1, %6, %8 row_ror:1 row_mask:0xf bank_mask:0xf\n\t"
        "v_fmac_f32_dpp %0, %3, %5 row_ror:2 row_mask:0xf bank_mask:0xf\n\tv_fmac_f32_dpp %1, %7, %9 row_ror:2 row_mask:0xf bank_mask:0xf"
        : "+v"(gt), "+v"(vl) : "v"(s1g), "v"(s2g), "v"(w1g), "v"(w0g), "v"(s1v), "v"(s2v), "v"(w1v), "v"(w0v));
}
struct EpiConvGlu {
    static constexpr bool PERM = true;
    bf16_t* F; float* ZB; const float* wcv; const float* bcv; const float* rs; int nslot; LAS unsigned char* halo;
    __device__ __forceinline__ void operator()(const f32x4 (&acc)[2][2][4][2], const Unit& u, int wr, int wc, int fr, int fq) const {
        asm volatile("" : "+v"(fr), "+v"(fq));
        const int colt = wc * 32 + 8 * fq, ch = u.pn * 128 + colt;
        LAS float* HL = (LAS float*)halo;
        float rsr[2][4];
#pragma unroll
        for (int ai = 0; ai < 2; ++ai)
#pragma unroll
            for (int m = 0; m < 4; ++m) rsr[ai][m] = row_rstd(rs, nslot, u.pm * BM + ai * HALF + wr * 64 + m * 16 + fr);
        if (fr >= 14) {
#pragma unroll
            for (int ai = 0; ai < 2; ++ai) { const int blk = 2 * ai + wr;
#pragma unroll
                for (int bj = 0; bj < 2; ++bj)
#pragma unroll
                    for (int n = 0; n < 2; ++n) { const f32x4 v = acc[ai][bj][3][n] * rsr[ai][3];
                        if (blk < 3) *(LAS f32x4*)(HL + ((blk + 1) * 2 + (fr - 14)) * 256 + bj * 128 + colt + 4 * n) = v;
                        else *(f32x4*)(ZB + ((size_t)u.pm * 4 + 2 + (fr - 14)) * NUP + bj * DFF + ch + 4 * n) = v; } }
        }
        if (wr == 0 && fr < 2) {
#pragma unroll
            for (int bj = 0; bj < 2; ++bj)
#pragma unroll
                for (int n = 0; n < 2; ++n) *(f32x4*)(ZB + ((size_t)u.pm * 4 + fr) * NUP + bj * DFF + ch + 4 * n) = acc[0][bj][0][n] * rsr[0][0];
        }
        asm volatile("s_waitcnt lgkmcnt(0)" ::: "memory"); __builtin_amdgcn_s_barrier(); asm volatile("" ::: "memory");
#pragma unroll
        for (int n = 0; n < 2; ++n) {
            float wg[3][4], wv[3][4], bg[4], bv[4];
#pragma unroll
            for (int j = 0; j < 3; ++j) { const f32x4 a = *(const f32x4*)(wcv + (size_t)j * NUP + ch + 4 * n), b = *(const f32x4*)(wcv + (size_t)j * NUP + DFF + ch + 4 * n);
#pragma unroll
                for (int e = 0; e < 4; ++e) { wg[j][e] = a[e]; wv[j][e] = b[e]; } }
            { const f32x4 a = *(const f32x4*)(bcv + ch + 4 * n), b = *(const f32x4*)(bcv + DFF + ch + 4 * n);
#pragma unroll
              for (int e = 0; e < 4; ++e) { bg[e] = a[e]; bv[e] = b[e]; } }
#pragma unroll
            for (int ai = 0; ai < 2; ++ai) { const int blk = 2 * ai + wr;
                f32x4 pg = (f32x4){0.f, 0.f, 0.f, 0.f}, pv = (f32x4){0.f, 0.f, 0.f, 0.f};
                if (blk > 0 && fr >= 14) { pg = *(const LAS f32x4*)(HL + (blk * 2 + (fr - 14)) * 256 + colt + 4 * n); pv = *(const LAS f32x4*)(HL + (blk * 2 + (fr - 14)) * 256 + 128 + colt + 4 * n); }
#pragma unroll
                for (int m = 0; m < 4; ++m) { float o[4];
                    const f32x4 gs = acc[ai][0][m][n] * rsr[ai][m], vs = acc[ai][1][m][n] * rsr[ai][m];
#pragma unroll
                    for (int j = 0; j < 4; ++j) {
                        const float g0 = gs[j], v0 = vs[j];
                        float gt = __builtin_fmaf(wg[2][j], g0, bg[j]), vl = __builtin_fmaf(wv[2][j], v0, bv[j]);
                        conv_taps_dpp(gt, vl, fr == 15 ? pg[j] : g0, fr >= 14 ? pg[j] : g0, wg[1][j], wg[0][j], fr == 15 ? pv[j] : v0, fr >= 14 ? pv[j] : v0, wv[1][j], wv[0][j]);
                        o[j] = gelu_tanh_e(gt) * vl; }
                    u32x2 w; w.x = cvt_pk_bf16(o[0], o[1]); w.y = cvt_pk_bf16(o[2], o[3]);
                    *(u32x2*)(F + (size_t)(u.pm * BM + ai * HALF + wr * 64 + m * 16 + fr) * DFF + ch + 4 * n) = w;
                    pg = gs; pv = vs; }
            }
        }
    }
};

struct EpiRes {
    static constexpr bool PERM = true;
    bf16_t* H; const float* gpost; float* X1; float* X2; unsigned* cnt; unsigned* tmo; float* OUT; LAS unsigned char* tab;
    __device__ __forceinline__ void operator()(const f32x4 (&acc)[2][2][4][2], const Unit& u, int wr, int wc, int fr, int fq) const {
        asm volatile("" : "+v"(fr), "+v"(fq));
        int tid = threadIdx.x; asm volatile("" : "+v"(tid));
        LAS float* Pt = (LAS float*)tab; LAS float* St = Pt + 1024; volatile LAS unsigned* flag = (volatile LAS unsigned*)(St + 256);
        const int rl0 = wr * 64 + fr, col0 = u.pn * BM + wc * 32 + 8 * fq;
#pragma unroll
        for (int ai = 0; ai < 2; ++ai)
#pragma unroll
            for (int m = 0; m < 4; ++m) { float s = 0.f;
#pragma unroll
                for (int bj = 0; bj < 2; ++bj)
#pragma unroll
                    for (int n = 0; n < 2; ++n) { const f32x4 v = acc[ai][bj][m][n]; s += (v[0] * v[0] + v[1] * v[1]) + (v[2] * v[2] + v[3] * v[3]); }
                s += __shfl_xor(s, 16); s += __shfl_xor(s, 32);
                if (fq == 0) Pt[(rl0 + ai * HALF + m * 16) * 4 + wc] = s; }
        asm volatile("s_waitcnt lgkmcnt(0)" ::: "memory"); __builtin_amdgcn_s_barrier(); asm volatile("" ::: "memory");
        if (tid < 256) { const float s = (Pt[tid * 4] + Pt[tid * 4 + 1]) + (Pt[tid * 4 + 2] + Pt[tid * 4 + 3]);
            __hip_atomic_store(X1 + (size_t)u.pn * 8192 + u.pm * BM + tid, s, __ATOMIC_RELAXED, __HIP_MEMORY_SCOPE_AGENT); }
        asm volatile("s_waitcnt vmcnt(0) lgkmcnt(0)" ::: "memory"); __builtin_amdgcn_s_barrier(); asm volatile("" ::: "memory");
        unsigned* cw = cnt + 64 * u.pm;
        if (tid == 0) __hip_atomic_fetch_add(cw, 1u, __ATOMIC_RELAXED, __HIP_MEMORY_SCOPE_AGENT);
        if (tid < 64) { unsigned dead = 0u; const unsigned long long t0 = __builtin_amdgcn_s_memrealtime(); unsigned polls = 0;
            while ((unsigned)__builtin_amdgcn_readfirstlane((int)__hip_atomic_load(cw, __ATOMIC_RELAXED, __HIP_MEMORY_SCOPE_AGENT)) < 16u) {
                if ((++polls & 63u) == 0u && (__builtin_amdgcn_s_memrealtime() - t0 > 4000000ull || __builtin_amdgcn_readfirstlane((int)__hip_atomic_load(tmo, __ATOMIC_RELAXED, __HIP_MEMORY_SCOPE_AGENT)) != 0)) {
                    if (tid == 0) __hip_atomic_store(tmo, 1u, __ATOMIC_RELAXED, __HIP_MEMORY_SCOPE_AGENT); dead = 1u; break; }
                __builtin_amdgcn_s_sleep(2); }
            if (tid == 0) flag[0] = dead; }
        asm volatile("s_waitcnt vmcnt(0) lgkmcnt(0)" ::: "memory"); __builtin_amdgcn_s_barrier(); asm volatile("" ::: "memory");
        if (tid < 256) { float tot = 0.f;
#pragma unroll
            for (int pn = 0; pn < 16; ++pn) tot += __hip_atomic_load(X1 + (size_t)pn * 8192 + u.pm * BM + tid, __ATOMIC_RELAXED, __HIP_MEMORY_SCOPE_AGENT);
            St[tid] = flag[0] ? __builtin_nanf("") : rsqrtf(tot * (1.f / 4096.f) + EPS); }
        asm volatile("s_waitcnt lgkmcnt(0)" ::: "memory"); __builtin_amdgcn_s_barrier(); asm volatile("" ::: "memory");
#pragma unroll
        for (int ai = 0; ai < 2; ++ai)
#pragma unroll
            for (int m = 0; m < 4; ++m) { const int rl = rl0 + ai * HALF + m * 16, row = u.pm * BM + rl; const float rsy = St[rl];
                float s2 = 0.f;
#pragma unroll
                for (int bj = 0; bj < 2; ++bj) { const int col = col0 + bj * HALF;
                    const u32x4 hw = *(const u32x4*)(H + (size_t)row * 4096 + col); const f32x4 g0 = *(const f32x4*)(gpost + col), g1 = *(const f32x4*)(gpost + col + 4);
                    const f32x4 a0 = acc[ai][bj][m][0], a1 = acc[ai][bj][m][1];
                    f32x4 h0, h1;
                    h0[0] = __uint_as_float(hw.x << 16) + a0[0] * rsy * g0[0]; h0[1] = __uint_as_float(hw.x & 0xffff0000u) + a0[1] * rsy * g0[1];
                    h0[2] = __uint_as_float(hw.y << 16) + a0[2] * rsy * g0[2]; h0[3] = __uint_as_float(hw.y & 0xffff0000u) + a0[3] * rsy * g0[3];
                    h1[0] = __uint_as_float(hw.z << 16) + a1[0] * rsy * g1[0]; h1[1] = __uint_as_float(hw.z & 0xffff0000u) + a1[1] * rsy * g1[1];
                    h1[2] = __uint_as_float(hw.w << 16) + a1[2] * rsy * g1[2]; h1[3] = __uint_as_float(hw.w & 0xffff0000u) + a1[3] * rsy * g1[3];
                    if (OUT) { float* op = OUT + (size_t)row * 4096 + col; *(f32x4*)op = h0; *(f32x4*)(op + 4) = h1; }
                    else { u32x4 w; w.x = cvt_pk_bf16(h0[0], h0[1]); w.y = cvt_pk_bf16(h0[2], h0[3]); w.z = cvt_pk_bf16(h1[0], h1[1]); w.w = cvt_pk_bf16(h1[2], h1[3]);
                        *(u32x4*)(H + (size_t)row * 4096 + col) = w;
                        s2 += (h0[0] * h0[0] + h0[1] * h0[1]) + (h0[2] * h0[2] + h0[3] * h0[3]) + (h1[0] * h1[0] + h1[1] * h1[1]) + (h1[2] * h1[2] + h1[3] * h1[3]); } }
                if (!OUT) { s2 += __shfl_xor(s2, 16); s2 += __shfl_xor(s2, 32); if (fq == 0) Pt[rl * 4 + wc] = s2; } }
        if (!OUT) {
            asm volatile("s_waitcnt lgkmcnt(0)" ::: "memory"); __builtin_amdgcn_s_barrier(); asm volatile("" ::: "memory");
            if (tid < 256) X2[(size_t)u.pn * 8192 + u.pm * BM + tid] = (Pt[tid * 4] + Pt[tid * 4 + 1]) + (Pt[tid * 4 + 2] + Pt[tid * 4 + 3]);
            asm volatile("s_waitcnt lgkmcnt(0)" ::: "memory"); __builtin_amdgcn_s_barrier(); asm volatile("" ::: "memory");
        }
    }
};
struct OrderPanel {
    int G, c;
    __device__ __forceinline__ bool next(int i, Unit& u) const {
        const int L = i * G + c; if (L >= 512) return false;
        const int round = L >> 8, idx = L & 255, xcd = idx & 7, k = idx >> 3;
        u.kind = 0; u.pm = 16 * round + 4 * (xcd >> 1) + (k >> 3); u.pn = 8 * (xcd & 1) + (k & 7); return true;
    }
    __device__ __forceinline__ void a_ready(const Unit&) const {}
    __device__ __forceinline__ void done(const Unit&) const {}
};

template <class Epi, class Sched, bool ALIGN_EPI, bool SP2>
__device__ __forceinline__ void gemm_phase(LAS unsigned char* lds, const Gemm g, const Sched& S, const Epi& E, const int wid) {
    const int lane = fresh_lane();
    const int tid = wid * 64 + lane, wr = wid >> 2, wc = wid & 3, fr = lane & 15, fq = lane >> 4;
    const int K = g.K, nt = K / BK;
    unsigned voffA[2], voffB[2];
#pragma unroll
    for (int i = 0; i < 2; ++i) { int R, C; stage_rc(tid * 16 + i * 8192, R, C); const int Rb = Epi::PERM ? ((R & ~31) + perm32(R & 31)) : R;
        voffA[i] = (unsigned)(R * g.lda + C) * 2u; voffB[i] = (unsigned)(Rb * g.ldb + C) * 2u; }
    const size_t kstep = (size_t)(BK * 2);
    const size_t hstepA = (size_t)HALF * g.lda * 2, hstepB = (size_t)HALF * g.ldb * 2;
    const size_t tstepA = 2 * hstepA, tstepB = 2 * hstepB;
    const unsigned ldsw = (unsigned)wid * 1024u;
    const int aoff = lds_byte(wr * 64 + fr, fq * 8), boff = lds_byte(wc * 32 + fr, fq * 8);
#define PG8_SA(b, h) (((b) * 2 + (h)) * HTB)
#define PG8_SB(b, h) ((4 + (b) * 2 + (h)) * HTB)
#define PG8_STAGE(bufoff, gbase, voff) do { _Pragma("unroll") for (int _i = 0; _i < 2; ++_i) \
        __builtin_amdgcn_global_load_lds((const unsigned*)((const char*)(gbase) + (voff)[_i]), (LAS unsigned*)(lds + (bufoff) + ldsw + _i * 8192), 16, 0, 0); } while (0)
#define PG8_LDA(dst, b, h) do { _Pragma("unroll") for (int m = 0; m < 4; ++m) _Pragma("unroll") for (int k = 0; k < 2; ++k) dst[m][k] = *(const LAS bf16x8*)(lds + PG8_SA(b, h) + aoff + m * 2048 + k * 1024); } while (0)
#define PG8_LDB(dst, b, h) do { _Pragma("unroll") for (int n = 0; n < 2; ++n) _Pragma("unroll") for (int k = 0; k < 2; ++k) dst[n][k] = *(const LAS bf16x8*)(lds + PG8_SB(b, h) + boff + n * 2048 + k * 1024); } while (0)
#define PG8_MMA(ai, bj, At, Bt) do { __builtin_amdgcn_s_setprio(1); _Pragma("unroll") for (int m = 0; m < 4; ++m) _Pragma("unroll") for (int n = 0; n < 2; ++n) _Pragma("unroll") for (int k = 0; k < 2; ++k) \
        acc[ai][bj][m][n] = __builtin_amdgcn_mfma_f32_16x16x32_bf16(Bt[n][k], At[m][k], acc[ai][bj][m][n], 0, 0, 0); __builtin_amdgcn_s_setprio(0); } while (0)
#define PG8_WAIT_V(n) asm volatile("s_waitcnt vmcnt(" #n ")" ::: "memory")
#define PG8_WAIT_L(n) asm volatile("s_waitcnt lgkmcnt(" #n ")" ::: "memory")
#define PG8_BAR __builtin_amdgcn_s_barrier()
#define PG8_SCHED __builtin_amdgcn_sched_barrier(0)
    Unit cur, nxt; int ui = 0;
    if (!S.next(0, cur)) return;
    f32x4 acc[2][2][4][2];
#pragma unroll
    for (int a = 0; a < 2; ++a)
#pragma unroll
        for (int b = 0; b < 2; ++b)
#pragma unroll
            for (int m = 0; m < 4; ++m)
#pragma unroll
                for (int n = 0; n < 2; ++n) acc[a][b][m][n] = (f32x4){0.f, 0.f, 0.f, 0.f};
    bf16x8 At[4][2], B0[2][2], B1[2][2];
    const char* cA = (const char*)(cur.kind ? g.A[1] : g.A[0]) + (size_t)cur.pm * tstepA; const char* cB = (const char*)(cur.kind ? g.Bt[1] : g.Bt[0]) + (size_t)cur.pn * tstepB;
    S.a_ready(cur);
    if constexpr (SP2) {
        PG8_STAGE(PG8_SB(0, 0), cB, voffB); PG8_STAGE(PG8_SB(0, 1), cB + hstepB, voffB); PG8_STAGE(PG8_SA(0, 0), cA, voffA); PG8_STAGE(PG8_SA(0, 1), cA + hstepA, voffA);
        if (wr == 1) PG8_BAR;
        PG8_WAIT_V(2); PG8_BAR;
        PG8_STAGE(PG8_SB(1, 0), cB + kstep, voffB); PG8_STAGE(PG8_SA(1, 0), cA + kstep, voffA); PG8_STAGE(PG8_SB(1, 1), cB + hstepB + kstep, voffB);
        PG8_WAIT_V(6); PG8_BAR;
    } else {
        PG8_STAGE(PG8_SB(0, 0), cB, voffB); PG8_STAGE(PG8_SA(0, 0), cA, voffA); PG8_STAGE(PG8_SB(0, 1), cB + hstepB, voffB); PG8_STAGE(PG8_SA(0, 1), cA + hstepA, voffA);
        if (wr == 1) PG8_BAR;
        PG8_WAIT_V(4); PG8_BAR;
        PG8_STAGE(PG8_SB(1, 0), cB + kstep, voffB); PG8_STAGE(PG8_SA(1, 0), cA + kstep, voffA); PG8_STAGE(PG8_SB(1, 1), cB + hstepB + kstep, voffB);
        PG8_WAIT_V(6); PG8_BAR;
    }
    for (;;) {
        const bool has_next = S.next(ui + 1, nxt);
        const char* nA = has_next ? (const char*)(nxt.kind ? g.A[1] : g.A[0]) + (size_t)nxt.pm * tstepA : cA; const char* nB = has_next ? (const char*)(nxt.kind ? g.Bt[1] : g.Bt[0]) + (size_t)nxt.pn * tstepB : cB;
        for (int t = 0; t < nt; t += 2) {
            const bool last = (t == nt - 2);
            const char* a1 = cA + (size_t)(t + 1) * kstep;
            const char* a2 = last ? nA : cA + (size_t)(t + 2) * kstep; const char* b2 = last ? nB : cB + (size_t)(t + 2) * kstep;
            const char* a3 = a2 + kstep; const char* b3 = b2 + kstep;
            if (last && has_next) S.a_ready(nxt);
            if constexpr (SP2) {
            PG8_LDB(B0, 0, 0); PG8_LDB(B1, 0, 1); PG8_SCHED; PG8_LDA(At, 0, 0); PG8_STAGE(PG8_SA(1, 1), a1 + hstepA, voffA);
            PG8_WAIT_V(8); PG8_WAIT_L(0); PG8_BAR; PG8_MMA(0, 0, At, B0); PG8_MMA(0, 1, At, B1); PG8_BAR; PG8_SCHED;
            PG8_LDA(At, 0, 1); PG8_STAGE(PG8_SB(0, 0), b2, voffB); PG8_STAGE(PG8_SB(0, 1), b2 + hstepB, voffB); PG8_STAGE(PG8_SA(0, 0), a2, voffA);
            PG8_WAIT_V(8); PG8_WAIT_L(0); PG8_BAR; PG8_MMA(1, 0, At, B0); PG8_MMA(1, 1, At, B1); PG8_BAR; PG8_SCHED;
            PG8_LDB(B0, 1, 0); PG8_LDB(B1, 1, 1); PG8_SCHED; PG8_LDA(At, 1, 0); PG8_STAGE(PG8_SA(0, 1), a2 + hstepA, voffA);
            PG8_WAIT_V(8); PG8_WAIT_L(0); PG8_BAR; PG8_MMA(0, 0, At, B0); PG8_MMA(0, 1, At, B1); PG8_BAR; PG8_SCHED;
            PG8_LDA(At, 1, 1); PG8_STAGE(PG8_SB(1, 0), b3, voffB); PG8_STAGE(PG8_SB(1, 1), b3 + hstepB, voffB); PG8_STAGE(PG8_SA(1, 0), a3, voffA);
            PG8_WAIT_V(8); PG8_WAIT_L(0); PG8_BAR; PG8_MMA(1, 0, At, B0); PG8_MMA(1, 1, At, B1); PG8_BAR; PG8_SCHED;
            } else {
            PG8_LDB(B0, 0, 0); PG8_SCHED; PG8_LDA(At, 0, 0); PG8_STAGE(PG8_SA(1, 1), a1 + hstepA, voffA);
            PG8_WAIT_L(8); PG8_BAR; PG8_WAIT_L(0); PG8_MMA(0, 0, At, B0); PG8_BAR; PG8_SCHED;
            PG8_LDB(B1, 0, 1); PG8_STAGE(PG8_SB(0, 0), b2, voffB);
            PG8_BAR; PG8_WAIT_L(0); PG8_MMA(0, 1, At, B1); PG8_BAR;
            PG8_LDA(At, 0, 1); PG8_STAGE(PG8_SA(0, 0), a2, voffA);
            PG8_BAR; PG8_WAIT_L(0); PG8_MMA(1, 0, At, B0); PG8_BAR; PG8_SCHED;
            PG8_STAGE(PG8_SB(0, 1), b2 + hstepB, voffB);
            PG8_WAIT_V(6); PG8_BAR; PG8_MMA(1, 1, At, B1); PG8_BAR;
            PG8_LDB(B0, 1, 0); PG8_SCHED; PG8_LDA(At, 1, 0); PG8_STAGE(PG8_SA(0, 1), a2 + hstepA, voffA);
            PG8_WAIT_L(8); PG8_BAR; PG8_WAIT_L(0); PG8_MMA(0, 0, At, B0); PG8_BAR; PG8_SCHED;
            PG8_LDB(B1, 1, 1); PG8_STAGE(PG8_SB(1, 0), b3, voffB);
            PG8_BAR; PG8_WAIT_L(0); PG8_MMA(0, 1, At, B1); PG8_BAR;
            PG8_LDA(At, 1, 1); PG8_STAGE(PG8_SA(1, 0), a3, voffA);
            PG8_BAR; PG8_WAIT_L(0); PG8_MMA(1, 0, At, B0); PG8_BAR; PG8_SCHED;
            PG8_STAGE(PG8_SB(1, 1), b3 + hstepB, voffB);
            PG8_WAIT_V(6); PG8_BAR; PG8_MMA(1, 1, At, B1); PG8_BAR;
            }
        }
        if constexpr (ALIGN_EPI) { if (wr == 0) PG8_BAR; }
        E(acc, cur, wr, wc, fr, fq); S.done(cur);
        if (!has_next) break;
#pragma unroll
        for (int a = 0; a < 2; ++a)
#pragma unroll
            for (int b = 0; b < 2; ++b)
#pragma unroll
                for (int m = 0; m < 4; ++m)
#pragma unroll
                    for (int n = 0; n < 2; ++n) acc[a][b][m][n] = (f32x4){0.f, 0.f, 0.f, 0.f};
        cur = nxt; cA = nA; cB = nB; ++ui;
        if constexpr (ALIGN_EPI) { if (wr == 1) PG8_BAR; }
    }
    PG8_WAIT_V(0);
    if constexpr (!ALIGN_EPI) { if (wr == 0) PG8_BAR; }
    PG8_BAR;
#undef PG8_SA
#undef PG8_SB
#undef PG8_STAGE
#undef PG8_LDA
#undef PG8_LDB
#undef PG8_MMA
#undef PG8_WAIT_V
#undef PG8_WAIT_L
#undef PG8_BAR
#undef PG8_SCHED
}
}
#ifndef PG8_SP2
#define PG8_SP2 true
#endif
#ifndef PG8_ALIGN
#define PG8_ALIGN true
#endif
static_assert(PG8_ALIGN, "EpiConvGlu has a workgroup barrier inside its epilogue: both half-workgroups must run their epilogues together (ALIGN_EPI)");

constexpr size_t WS_GLA = WS_Z;
constexpr size_t GLA_LT = 0, GLA_OI = 64 * MiB, GLA_ST = 96 * MiB, GLA_QT = 128 * MiB, GLA_DEC = 136 * MiB;
__device__ __forceinline__ int crow(int i, int hh) { return (i & 3) + 8 * (i >> 2) + 4 * hh; }
#define MFMA32(a, b, c) __builtin_amdgcn_mfma_f32_32x32x16_bf16((a), (b), (c), 0, 0, 0)
#define WG_BAR() do { asm volatile("s_waitcnt vmcnt(0) lgkmcnt(0)" ::: "memory"); __builtin_amdgcn_s_barrier(); asm volatile("" ::: "memory"); } while (0)

__device__ __forceinline__ f32x16 mma_lds(const LAS bf16_t* A, int pa, const LAS bf16_t* B, int pb, int K, f32x16 acc, int r, int hh) {
    const LAS bf16_t* ap = A + r * pa + 8 * hh; const LAS bf16_t* bp = B + r * pb + 8 * hh;
    for (int k = 0; k < K; k += 16) acc = MFMA32(*(const LAS bf16x8*)(ap + k), *(const LAS bf16x8*)(bp + k), acc);
    return acc;
}

namespace att {
constexpr float LOG2E = 1.4426950408889634f, C1 = 0.08838834764831845f * LOG2E, THRL = 8.f;
constexpr int GSUB_OFF = LDSCTL_OFF + 2048;
constexpr int KP = 528, VP = 144, VBYTES = 256 * VP, KBYTES = 64 * KP, ABUF = VBYTES + KBYTES, XP = 1040;
__device__ __forceinline__ void stage_tile(LAS unsigned char* buf, const char* kt, const char* vt, int wave, int lane) {
#pragma unroll
    for (int i = 0; i < 5; ++i) { const int iv = wave + 8 * i; if (iv < 36) { const unsigned q = iv * 64 + lane, row = q / 9u, cp = q - 9u * row, cc = cp < 8u ? cp : 7u;
        __builtin_amdgcn_global_load_lds((const GAS unsigned*)(vt + (row * (unsigned)(M * 2) + cc * 16u)), (LAS unsigned*)(buf + iv * 1024), 16, 0, 0); } }
#pragma unroll
    for (int i = 0; i < 5; ++i) { const int ik = wave + 8 * i; if (ik < 33) { const unsigned q = ik * 64 + lane, row = q / 33u, cp = q - 33u * row, cc = cp < 32u ? cp : 31u;
        __builtin_amdgcn_global_load_lds((const GAS unsigned*)(kt + (row * (unsigned)(UNW * 2) + cc * 16u)), (LAS unsigned*)(buf + VBYTES + ik * 1024), 16, 0, 0); } }
}
constexpr float TSKIP = 64.f;
__device__ __forceinline__ void unit(LAS unsigned char* lds, const bf16_t* UN, const bf16_t* UT, bf16_t* MIX, const unsigned* KMAX, int b, int h, int qb, float lam, const float* gsub, float post_scale, int wave, int lane, const int mode = 0) {
    const int mp = wave >> 2, wq = wave & 3, r = lane & 31, hh = lane >> 5;
    const int q0 = qb * 128 + wq * 32, qpos = q0 + r, cw = q0 >> 6;
    const float C2 = __uint_as_float((unsigned)(127 - (h + 1)) << 23) * LOG2E;
    const char* kt = (const char*)(UN + (size_t)(b * SEQ) * UNW + UN_KA + h * 256);
    const char* vt = (const char*)(UT + (size_t)(h * 256) * M + (size_t)b * SEQ);
    if (mode != 3) stage_tile(lds, kt + (size_t)(2 * qb + 1) * 64 * UNW * 2, vt + (size_t)(2 * qb + 1) * 128, wave, lane);
    const float km_raw = __uint_as_float(__hip_atomic_load(KMAX + ((b * 8 + h) * 2 + mp) * 64 + lane, __ATOMIC_RELAXED, __HIP_MEMORY_SCOPE_AGENT));
    bf16x8 qf[8];
    { const bf16_t* qp = UN + (size_t)(b * SEQ + qpos) * UNW + UN_QA + h * 256 + mp * 128 + 8 * hh;
#pragma unroll
      for (int kk = 0; kk < 8; ++kk) qf[kk] = *(const bf16x8*)(qp + 16 * kk); }
    unsigned long long mask;
    { float qs = 0.f;
#pragma unroll
      for (int kk = 0; kk < 8; ++kk)
#pragma unroll
          for (int e = 0; e < 8; ++e) { const float x = bf2f((bf16_t)qf[kk][e]); qs += x * x; }
      { auto rr = __builtin_amdgcn_permlane32_swap(__float_as_uint(qs), __float_as_uint(qs), false, false); qs = __uint_as_float(rr[0]) + __uint_as_float(rr[1]); }
#pragma unroll
      for (int o = 1; o < 32; o <<= 1) qs = fmaxf(qs, shfl_xor_l(qs, o, lane));
      const float qn = sqrtf(qs) * 1.001f;
      const float km = km_raw * 1.001f;
      const float kcw = __uint_as_float(__builtin_amdgcn_readlane(__float_as_uint(km), cw));
      const int md = q0 - (64 * lane + 63);
      const bool need = (lane <= cw) && (C1 * qn * (km + kcw) - C2 * (float)(md > 0 ? md : 0) >= -TSKIP);
      mask = __ballot(need); }
    volatile LAS unsigned long long* masks = (volatile LAS unsigned long long*)(lds + LDSCTL_OFF + 512);
    if (lane == 0) masks[wave] = mask;
    f32x16 O[8];
#pragma unroll
    for (int eb = 0; eb < 8; ++eb)
#pragma unroll
        for (int i = 0; i < 16; ++i) O[eb][i] = 0.f;
    float m_ref = -INFINITY, l_acc = 0.f;
    WG_BAR();
    unsigned long long rem = 0ull;
#pragma unroll
    for (int w = 0; w < 8; ++w) { const unsigned long long mw = masks[w]; rem |= ((unsigned long long)__builtin_amdgcn_readfirstlane((unsigned)(mw >> 32)) << 32) | (unsigned long long)__builtin_amdgcn_readfirstlane((unsigned)mw); }
    int j = 63 - __builtin_clzll(rem); rem &= ~(1ull << j);
    const int kbase = VBYTES + r * KP + mp * 256 + hh * 16, vbase = r * VP + hh * 16;
    for (int it = 0;; ++it) {
        WG_BAR();
        LAS unsigned char* buf = lds + (it & 1) * ABUF;
        const int jn = rem ? 63 - __builtin_clzll(rem) : -1;
        if (jn >= 0) { rem &= ~(1ull << jn); if (mode != 3) stage_tile(lds + ((it + 1) & 1) * ABUF, kt + (size_t)jn * 64 * UNW * 2, vt + (size_t)jn * 128, wave, lane); }
        if (((mask >> j) & 1ull) && mode != 1) {
            const LAS unsigned char* kp = buf + kbase; const LAS unsigned char* vp = buf + vbase;
#pragma unroll
            for (int hf = 1; hf >= 0; --hf) {
                f32x16 p0;
#pragma unroll
                for (int i = 0; i < 16; ++i) p0[i] = 0.f;
#define LDK(KK) (*(const LAS bf16x8*)(kp + hf * 32 * KP + (KK) * 32))
                { bf16x8 ka[4] = {LDK(0), LDK(1), LDK(2), LDK(3)}, kb[4] = {LDK(4), LDK(5), LDK(6), LDK(7)};
                  __builtin_amdgcn_sched_barrier(0);
                  __builtin_amdgcn_s_setprio(1);
#pragma unroll
                  for (int kk = 0; kk < 4; ++kk) p0 = MFMA32(ka[kk], qf[kk], p0);
#pragma unroll
                  for (int kk = 0; kk < 4; ++kk) p0 = MFMA32(kb[kk], qf[4 + kk], p0);
                  __builtin_amdgcn_s_setprio(0); }
#undef LDK
                const float base0 = (float)(qpos - 64 * j - 32 * hf - 4 * hh);
                float pmax = -INFINITY;
#pragma unroll
                for (int i = 0; i < 16; ++i) { const float off = (float)((i & 3) + 8 * (i >> 2));
                    p0[i] = fmaf(p0[i], C1, -C2 * fabsf(base0 - off)); pmax = fmaxf(pmax, p0[i]); }
                { auto rr = __builtin_amdgcn_permlane32_swap(__float_as_uint(pmax), __float_as_uint(pmax), false, false); pmax = fmaxf(__uint_as_float(rr[0]), __uint_as_float(rr[1])); }
                if (!__all(pmax - m_ref <= THRL)) {
                    const float mn = fmaxf(m_ref, pmax), alpha = __builtin_amdgcn_exp2f(m_ref - mn); m_ref = mn; l_acc *= alpha;
#pragma unroll
                    for (int eb = 0; eb < 8; ++eb)
#pragma unroll
                        for (int i = 0; i < 16; ++i) O[eb][i] *= alpha;
                }
                float ps = 0.f;
#pragma unroll
                for (int i = 0; i < 16; ++i) { p0[i] = __builtin_amdgcn_exp2f(p0[i] - m_ref); ps += p0[i]; }
                l_acc += ps;
                bf16x8 pf[2];
#define PK4(P, BASE, OUT) do { const unsigned a0 = cvt_pk_bf16(P[BASE + 0], P[BASE + 1]), a1 = cvt_pk_bf16(P[BASE + 2], P[BASE + 3]); \
    const unsigned b0 = cvt_pk_bf16(P[BASE + 4], P[BASE + 5]), b1 = cvt_pk_bf16(P[BASE + 6], P[BASE + 7]); \
    auto r0 = __builtin_amdgcn_permlane32_swap(a0, b0, false, false); auto r1 = __builtin_amdgcn_permlane32_swap(a1, b1, false, false); \
    u32x4 w = {r0[0], r1[0], r0[1], r1[1]}; OUT = *reinterpret_cast<bf16x8*>(&w); } while (0)
                PK4(p0, 0, pf[0]); PK4(p0, 8, pf[1]);
#undef PK4
#define LDV(EB, S2) (*(const LAS bf16x8*)(vp + (EB) * 32 * VP + (4 * hf + 2 * (S2)) * 16))
                { bf16x8 va[4] = {LDV(0, 0), LDV(0, 1), LDV(1, 0), LDV(1, 1)};
                  __builtin_amdgcn_s_setprio(1);
#pragma unroll
                  for (int eb = 0; eb < 8; eb += 2) { bf16x8 vn[4];
                      if (eb < 6) { vn[0] = LDV(eb + 2, 0); vn[1] = LDV(eb + 2, 1); vn[2] = LDV(eb + 3, 0); vn[3] = LDV(eb + 3, 1); }
                      O[eb] = MFMA32(va[0], pf[0], O[eb]); O[eb + 1] = MFMA32(va[2], pf[0], O[eb + 1]); O[eb] = MFMA32(va[1], pf[1], O[eb]); O[eb + 1] = MFMA32(va[3], pf[1], O[eb + 1]);
                      __builtin_amdgcn_sched_barrier(0);
                      if (eb < 6) { va[0] = vn[0]; va[1] = vn[1]; va[2] = vn[2]; va[3] = vn[3]; } }
                  __builtin_amdgcn_s_setprio(0); }
#undef LDV
            }
        }
        if (jn < 0) break;
        j = jn;
    }
    { auto rr = __builtin_amdgcn_permlane32_swap(__float_as_uint(l_acc), __float_as_uint(l_acc), false, false); l_acc = __uint_as_float(rr[0]) + __uint_as_float(rr[1]); }
    WG_BAR();
    LAS unsigned char* xp = lds + (wq * 32 + r) * XP + hh * 16;
    if (mp == 1) {
        const float inv = lam / l_acc;
#pragma unroll
        for (int eb = 0; eb < 8; ++eb)
#pragma unroll
            for (int g4 = 0; g4 < 4; ++g4) { const f32x4 v = {O[eb][4 * g4] * inv, O[eb][4 * g4 + 1] * inv, O[eb][4 * g4 + 2] * inv, O[eb][4 * g4 + 3] * inv};
                *(LAS f32x4*)(xp + (8 * eb + 2 * g4) * 16) = v; }
    }
    WG_BAR();
    if (mp == 0) {
        const float inv = 1.f / l_acc; float ss = 0.f;
#pragma unroll
        for (int eb = 0; eb < 8; ++eb) {
#pragma unroll
            for (int g4 = 0; g4 < 4; ++g4) { const f32x4 x = *(const LAS f32x4*)(xp + (8 * eb + 2 * g4) * 16);
#pragma unroll
                for (int e = 0; e < 4; ++e) { const float v = O[eb][4 * g4 + e] * inv - x[e]; O[eb][4 * g4 + e] = v; ss += v * v; } }
            asm volatile("" ::: "memory"); }
        { auto rr = __builtin_amdgcn_permlane32_swap(__float_as_uint(ss), __float_as_uint(ss), false, false); ss = __uint_as_float(rr[0]) + __uint_as_float(rr[1]); }
        const float rs = rsqrtf(ss * (1.f / 256.f) + EPS) * post_scale;
        bf16_t* op = MIX + (size_t)(b * SEQ + qpos) * D + h * 256 + 4 * hh; const LAS float* gp = (const LAS float*)(lds + GSUB_OFF) + 4 * hh;
#pragma unroll
        for (int eb = 0; eb < 8; ++eb) {
#pragma unroll
            for (int g4 = 0; g4 < 4; ++g4) { const int e0 = 32 * eb + 8 * g4; const f32x4 g = *(const LAS f32x4*)(gp + e0);
                u32x2 w; w.x = cvt_pk_bf16(O[eb][4 * g4] * rs * g[0], O[eb][4 * g4 + 1] * rs * g[1]); w.y = cvt_pk_bf16(O[eb][4 * g4 + 2] * rs * g[2], O[eb][4 * g4 + 3] * rs * g[3]);
                if (mode == 0) *(u32x2*)(op + e0) = w; else asm volatile("" :: "v"(w.x), "v"(w.y)); }
            asm volatile("" ::: "memory"); }
    }
    WG_BAR();
}
}

namespace gla {
constexpr int O_LA = 0, O_ZL = 32768, O_QT = 36864, O_KT = 54272, O_KHT = 71680, O_VT = 90112, O_AM = 0;
constexpr int PQ = 136, PS = 72;
__device__ __forceinline__ void g1_unit(LAS unsigned char* lds, const bf16_t* UN, const bf16_t* UT, const float* ZLR, const float* w2, const float* bgate, unsigned char* gs, int u, int tid, int wave, int lane) {
    const int c = u & 63, h = (u >> 6) & 3, b = u >> 8; const size_t tok0 = (size_t)b * SEQ + c * 64;
    LAS float* LA = (LAS float*)(lds + O_LA); LAS float* ZL = (LAS float*)(lds + O_ZL);
    LAS bf16_t* QT = (LAS bf16_t*)(lds + O_QT); LAS bf16_t* KT = (LAS bf16_t*)(lds + O_KT); LAS bf16_t* KHT = (LAS bf16_t*)(lds + O_KHT); LAS bf16_t* VT = (LAS bf16_t*)(lds + O_VT); LAS bf16_t* AM = (LAS bf16_t*)(lds + O_AM);
    const int d = tid & 127, qd = tid >> 7;
    float w[16]; bf16_t qr[16], kr[16];
#pragma unroll
    for (int rr = 0; rr < 16; ++rr) w[rr] = w2[rr * 512 + h * 128 + d];
    const float bias = bgate[h * 128 + d];
#pragma unroll
    for (int i = 0; i < 16; ++i) { const size_t t = tok0 + qd * 16 + i; qr[i] = UN[t * UNW + UN_QB + h * 128 + d]; kr[i] = UN[t * UNW + UN_KB + h * 128 + d]; }
    if (tid < 256) *(LAS f32x4*)(ZL + tid * 4) = *(const f32x4*)(ZLR + tok0 * 16 + tid * 4);
#pragma unroll
    for (int i = 0; i < 4; ++i) { const int id = tid + 512 * i, row = id >> 3, ch = id & 7;
        *(LAS u32x4*)(VT + row * PS + ch * 8) = *(const u32x4*)(UT + (size_t)(2048 + h * 256 + row) * M + tok0 + ch * 8); }
    WG_BAR();
    float bt[16];
    { float run = 0.f;
#pragma unroll
      for (int i = 0; i < 16; ++i) { const int t = qd * 16 + i; float x = bias;
#pragma unroll
          for (int rr = 0; rr < 16; ++rr) x += ZL[t * 16 + rr] * w[rr];
          const float ls = fminf(x, 0.f) - __logf(1.f + __expf(-fabsf(x)));
          run += ls * (1.f / 16.f); bt[i] = run; }
      WG_BAR();
      ZL[qd * 128 + d] = run; }
    WG_BAR();
    float off = 0.f, btot = 0.f;
#pragma unroll
    for (int q = 0; q < 4; ++q) { const float p = ZL[q * 128 + d]; btot += p; if (q < qd) off += p; }
    bf16_t* QTg = (bf16_t*)(gs + GLA_QT) + (size_t)u * 64 * 128;
#pragma unroll
    for (int i = 0; i < 16; ++i) { const int t = qd * 16 + i; const float bb = bt[i] + off;
        const float qv = bf2f(qr[i]) * 0.08838834764831845f, kv = bf2f(kr[i]);
        const bf16_t qt = f2bf(qv * __expf(bb));
        QT[t * PQ + d] = qt; QTg[t * 128 + d] = qt; KT[t * PQ + d] = f2bf(kv * __expf(-bb)); KHT[d * PS + t] = f2bf(kv * __expf(btot - bb)); }
    if (qd == 0) ((float*)(gs + GLA_DEC))[(size_t)u * 128 + d] = __expf(btot);
    WG_BAR();
    const int r = lane & 31, hh = lane >> 5;
    f32x16 zero;
#pragma unroll
    for (int i = 0; i < 16; ++i) zero[i] = 0.f;
    if (wave < 4) {
        const int mi = wave >> 1, ni = wave & 1;
        const f32x16 a = mma_lds(QT + 32 * mi * PQ, PQ, KT + 32 * ni * PQ, PQ, 128, zero, r, hh);
#pragma unroll
        for (int i = 0; i < 16; ++i) { const int t = 32 * mi + crow(i, hh), s = 32 * ni + r; AM[t * PS + s] = f2bf(s <= t ? a[i] : 0.f); }
    }
    { bf16_t* LT = (bf16_t*)(gs + GLA_LT) + (size_t)u * 256 * 128;
#pragma unroll
      for (int db = 0; db < 4; ++db) { const f32x16 a = mma_lds(VT + 32 * wave * PS, PS, KHT + 32 * db * PS, PS, 64, zero, r, hh);
#pragma unroll
          for (int i = 0; i < 16; ++i) LT[(size_t)(32 * wave + crow(i, hh)) * 128 + 32 * db + r] = f2bf(a[i]); } }
    WG_BAR();
    { bf16_t* OI = (bf16_t*)(gs + GLA_OI) + (size_t)u * 64 * 256;
#pragma unroll
      for (int tb = 0; tb < 2; ++tb) { const f32x16 a = mma_lds(AM + 32 * tb * PS, PS, VT + 32 * wave * PS, PS, 64, zero, r, hh);
#pragma unroll
          for (int i = 0; i < 16; ++i) OI[(size_t)(32 * tb + crow(i, hh)) * 256 + 32 * wave + r] = f2bf(a[i]); } }
    WG_BAR();
}
__device__ __forceinline__ void g2_scan(unsigned char* gs, int p) {
    const int bh = p >> 14, rem = p & 16383, e = rem >> 6, d2 = (rem & 63) * 2;
    const bf16_t* LT = (const bf16_t*)(gs + GLA_LT); const float* DEC = (const float*)(gs + GLA_DEC); bf16_t* ST = (bf16_t*)(gs + GLA_ST);
    float s0 = 0.f, s1 = 0.f;
    for (int c0 = 0; c0 < 64; c0 += 16) {
        f32x2 dc[16]; unsigned lv[16];
#pragma unroll
        for (int i = 0; i < 16; ++i) { const size_t u = (size_t)bh * 64 + c0 + i; dc[i] = *(const f32x2*)(DEC + u * 128 + d2); lv[i] = *(const unsigned*)(LT + (u * 256 + e) * 128 + d2); }
#pragma unroll
        for (int i = 0; i < 16; ++i) { const size_t u = (size_t)bh * 64 + c0 + i;
            *(unsigned*)(ST + (u * 256 + e) * 128 + d2) = cvt_pk_bf16(s0, s1);
            s0 = dc[i].x * s0 + __uint_as_float(lv[i] << 16); s1 = dc[i].y * s1 + __uint_as_float(lv[i] & 0xffff0000u); }
    }
}
__device__ __forceinline__ void g3_unit(LAS unsigned char* lds, const bf16_t* UN, unsigned char* gs, const float* ggla, bf16_t* MIX, int u, int tid, int wave, int lane) {
    const int c = u & 63, h = (u >> 6) & 3, b = u >> 8; const size_t tok0 = (size_t)b * SEQ + c * 64;
    LAS bf16_t* QT = (LAS bf16_t*)lds; LAS bf16_t* STs = (LAS bf16_t*)(lds + 17408); LAS float* OT = (LAS float*)lds;
    const bf16_t* QTg = (const bf16_t*)(gs + GLA_QT) + (size_t)u * 64 * 128; const bf16_t* ST = (const bf16_t*)(gs + GLA_ST) + (size_t)u * 256 * 128;
#pragma unroll
    for (int i = 0; i < 2; ++i) { const int id = tid + 512 * i, row = id >> 4, ch = id & 15; *(LAS u32x4*)(QT + row * PQ + ch * 8) = *(const u32x4*)(QTg + row * 128 + ch * 8); }
#pragma unroll
    for (int i = 0; i < 8; ++i) { const int id = tid + 512 * i, row = id >> 4, ch = id & 15; *(LAS u32x4*)(STs + row * PQ + ch * 8) = *(const u32x4*)(ST + row * 128 + ch * 8); }
    const int r = lane & 31, hh = lane >> 5;
    const bf16_t* OI = (const bf16_t*)(gs + GLA_OI) + (size_t)u * 64 * 256;
    bf16x8 gvv[4]; f32x4 ggv[8];
    { const int t = tid >> 3, part = tid & 7; const bf16_t* gbp = UN + (tok0 + t) * UNW + UN_GB + h * 256 + part * 32; const float* gg = ggla + h * 256 + part * 32;
#pragma unroll
      for (int q = 0; q < 4; ++q) gvv[q] = *(const bf16x8*)(gbp + 8 * q);
#pragma unroll
      for (int q = 0; q < 8; ++q) ggv[q] = *(const f32x4*)(gg + 4 * q); }
    f32x16 acc[2];
#pragma unroll
    for (int tb = 0; tb < 2; ++tb)
#pragma unroll
        for (int i = 0; i < 16; ++i) acc[tb][i] = bf2f(OI[(size_t)(32 * tb + crow(i, hh)) * 256 + 32 * wave + r]);
    WG_BAR();
#pragma unroll
    for (int tb = 0; tb < 2; ++tb) acc[tb] = mma_lds(QT + 32 * tb * PQ, PQ, STs + 32 * wave * PQ, PQ, 128, acc[tb], r, hh);
    WG_BAR();
#pragma unroll
    for (int tb = 0; tb < 2; ++tb)
#pragma unroll
        for (int i = 0; i < 16; ++i) OT[(32 * tb + crow(i, hh)) * 260 + 32 * wave + r] = acc[tb][i];
    WG_BAR();
    { const int t = tid >> 3, part = tid & 7; const LAS float* op = OT + t * 260 + part * 32; float v[32]; float ss = 0.f;
#pragma unroll
      for (int q = 0; q < 8; ++q) { const f32x4 x = *(const LAS f32x4*)(op + 4 * q); v[4 * q] = x[0]; v[4 * q + 1] = x[1]; v[4 * q + 2] = x[2]; v[4 * q + 3] = x[3]; ss += x[0] * x[0] + x[1] * x[1] + x[2] * x[2] + x[3] * x[3]; }
      ss += shfl_xor_l(ss, 1, lane); ss += shfl_xor_l(ss, 2, lane); ss += shfl_xor_l(ss, 4, lane);
      const float rs = rsqrtf(ss * (1.f / 256.f) + EPS);
      bf16_t* mp = MIX + (tok0 + t) * D + 2048 + h * 256 + part * 32;
#pragma unroll
      for (int q = 0; q < 4; ++q) { const bf16x8 gv = gvv[q]; float o[8];
#pragma unroll
          for (int e = 0; e < 8; ++e) { const float g = bf2f((bf16_t)gv[e]); o[e] = v[8 * q + e] * rs * ggv[2 * q + (e >> 2)][e & 3] * (g / (1.f + __expf(-g))); }
          u32x4 w; w.x = cvt_pk_bf16(o[0], o[1]); w.y = cvt_pk_bf16(o[2], o[3]); w.z = cvt_pk_bf16(o[4], o[5]); w.w = cvt_pk_bf16(o[6], o[7]);
          *(u32x4*)(mp + 8 * q) = w; } }
    WG_BAR();
}
}

template <int W> __device__ __forceinline__ void pool_window(LAS bf16_t* DT, const bf16_t* UN, size_t tok0, int g, int tid) {
    constexpr int PD = 264, NR = W - 1 + 8;
    const int cg = tid & 31, seg = tid >> 5, tf = (int)(tok0 & (SEQ - 1)) + 8 * seg;
    const bf16_t* up = UN + (tok0 + 8 * seg) * UNW + UN_UC + g * 256 + 8 * cg;
    bf16x8 x[NR];
#pragma unroll
    for (int k = 0; k < NR; ++k) { const int rel = k - (W - 1); bf16x8 z;
#pragma unroll
        for (int e = 0; e < 8; ++e) z[e] = 0;
        x[k] = (tf + rel >= 0) ? *(const bf16x8*)(up + (ptrdiff_t)rel * UNW) : z; }
    float s[8];
#pragma unroll
    for (int e = 0; e < 8; ++e) s[e] = 0.f;
#pragma unroll
    for (int k = 0; k < W - 1; ++k)
#pragma unroll
        for (int e = 0; e < 8; ++e) s[e] += bf2f((bf16_t)x[k][e]);
#pragma unroll
    for (int i = 0; i < 8; ++i) { const int t = tf + i; const float rc = __builtin_amdgcn_rcpf((float)((t + 1 < W) ? t + 1 : W)); float o[8];
#pragma unroll
        for (int e = 0; e < 8; ++e) { const float ut = bf2f((bf16_t)x[W - 1 + i][e]); s[e] += ut; o[e] = s[e] * rc - ut; s[e] -= bf2f((bf16_t)x[i][e]); }
        u32x4 wv; wv.x = cvt_pk_bf16(o[0], o[1]); wv.y = cvt_pk_bf16(o[2], o[3]); wv.z = cvt_pk_bf16(o[4], o[5]); wv.w = cvt_pk_bf16(o[6], o[7]);
        *(LAS u32x4*)(DT + (8 * seg + i) * PD + 8 * cg) = wv; }
}
__device__ __forceinline__ void pool_unit(LAS unsigned char* lds, const bf16_t* UN, const bf16_t* WP, const float* pscale, bf16_t* MIX, int pu, int tid, int wave, int lane) {
    const int g = pu & 3, rb = pu >> 2; const size_t tok0 = (size_t)rb * 128;
    LAS bf16_t* DT = (LAS bf16_t*)lds; constexpr int PD = 264;
    const bf16_t* bp = WP + (size_t)g * 65536 + (size_t)(32 * wave + (lane & 31)) * 256 + 8 * (lane >> 5);
    bf16x8 bfr[16];
#pragma unroll
    for (int ks = 0; ks < 16; ++ks) bfr[ks] = *(const bf16x8*)(bp + 16 * ks);
    const float sc = pscale[g * 256 + 32 * wave + (lane & 31)];
    if (g == 0) pool_window<2>(DT, UN, tok0, g, tid); else if (g == 1) pool_window<4>(DT, UN, tok0, g, tid); else if (g == 2) pool_window<8>(DT, UN, tok0, g, tid); else pool_window<16>(DT, UN, tok0, g, tid);
    WG_BAR();
    const int r = lane & 31, hh = lane >> 5;
    f32x16 acc[4];
#pragma unroll
    for (int mb = 0; mb < 4; ++mb)
#pragma unroll
        for (int i = 0; i < 16; ++i) acc[mb][i] = 0.f;
#pragma unroll
    for (int ks = 0; ks < 16; ++ks) {
#pragma unroll
        for (int mb = 0; mb < 4; ++mb) acc[mb] = MFMA32(*(const LAS bf16x8*)(DT + (32 * mb + r) * PD + 16 * ks + 8 * hh), bfr[ks], acc[mb]); }
    const int n = 32 * wave + r;
#pragma unroll
    for (int mb = 0; mb < 4; ++mb)
#pragma unroll
        for (int i = 0; i < 16; ++i) MIX[(tok0 + 32 * mb + crow(i, hh)) * D + 3072 + g * 256 + n] = f2bf(acc[mb][i] * sc);
    WG_BAR();
}

#define LDS_WAIT() asm volatile("s_waitcnt lgkmcnt(0)" ::: "memory")
#define VM_WAIT() asm volatile("s_waitcnt vmcnt(0)" ::: "memory")
__device__ __forceinline__ unsigned pk2(float lo, float hi) { return (unsigned)f2bf(lo) | ((unsigned)f2bf(hi) << 16); }

struct CvtItem { const float* W; bf16_t* Wt; const float* gk; int ldw, srccol, nvalid, K, dstrow, k0, hasg; };
__device__ __forceinline__ void cvt_load(const CvtItem& d, f32x4 (&v)[8], f32x4 (&g)[2], int lane) {
    const int n4 = lane & 7, kr = lane >> 3;
    { const float* gp = d.gk + (d.hasg ? d.k0 : (d.k0 & 4095)) + 8 * (lane & 7);
      g[0] = *(const f32x4*)gp; g[1] = *(const f32x4*)(gp + 4); }
    const int c4 = 4 * n4 < d.nvalid ? 4 * n4 : d.nvalid - 4;
    const float* p = d.W + (size_t)(d.k0 + kr) * d.ldw + d.srccol + c4;
#pragma unroll
    for (int i = 0; i < 8; ++i) v[i] = *(const f32x4*)(p + (size_t)(8 * i) * d.ldw);
}
__device__ __forceinline__ void cvt_store(const CvtItem& d, const f32x4 (&v)[8], const f32x4 (&g)[2], LAS float* scr, int lane) {
    { const int n4 = lane & 7, kr = lane >> 3;
#pragma unroll
      for (int i = 0; i < 8; ++i)
#pragma unroll
          for (int e = 0; e < 4; ++e) scr[(kr + 8 * i) * 33 + 4 * n4 + e] = v[i][e]; }
    LDS_WAIT(); asm volatile("" ::: "memory");
    const int c8 = lane & 7; const int k0 = d.k0;
#pragma unroll
    for (int j = 0; j < 4; ++j) { const int n = (lane >> 3) + 8 * j; const LAS float* s = scr + (8 * c8) * 33 + n;
        const float z = n < d.nvalid ? 1.f : 0.f; const f32x4 one4 = {1.f, 1.f, 1.f, 1.f}; const f32x4 ga = (d.hasg ? g[0] : one4) * z, gb = (d.hasg ? g[1] : one4) * z;
        u32x4 o; o.x = cvt_pk_bf16(s[0 * 33] * ga[0], s[1 * 33] * ga[1]); o.y = cvt_pk_bf16(s[2 * 33] * ga[2], s[3 * 33] * ga[3]); o.z = cvt_pk_bf16(s[4 * 33] * gb[0], s[5 * 33] * gb[1]); o.w = cvt_pk_bf16(s[6 * 33] * gb[2], s[7 * 33] * gb[3]);
        *(u32x4*)(d.Wt + (size_t)(d.dstrow + n) * d.K + k0 + 8 * c8) = o; }
    LDS_WAIT(); asm volatile("" ::: "memory");
}
__device__ __forceinline__ int win_src_col(int d) {
    if (d < 2048) return d + (SRC_QA - 0);
    if (d < 4096) return d + (SRC_KA - 2048);
    if (d < 4608) return d + (SRC_QB - 4096);
    if (d < 5120) return d + (SRC_KB - 4608);
    if (d < 6144) return d + (SRC_GB - 5120);
    if (d < 7168) return d + (SRC_UC - 6144);
    if (d < 9216) return d + (SRC_VA - 7168);
    return d + (SRC_VB - 9216);
}
constexpr int I_IN = 64 * 320, I_Z = 64, I_O = 64 * 128, I_UP = 64 * 688, I_DN = 172 * 128, I_P = 128, I_LAYER = I_IN + I_Z + I_O + I_UP + I_DN + I_P;

__device__ __forceinline__ void res_row(const float* X, bf16_t* Hb, const bf16_t* Y, const f32x4 (&gv)[16], float* RS, float* OUT, int row, int lane) {
    f32x4 hv[16];
    if (X) { const f32x4* src = (const f32x4*)(X + (size_t)row * D) + lane;
#pragma unroll
        for (int j = 0; j < 16; ++j) hv[j] = src[64 * j];
    } else { const u32x2* src = (const u32x2*)(Hb + (size_t)row * D) + lane;
#pragma unroll
        for (int j = 0; j < 16; ++j) { const u32x2 w = src[64 * j]; hv[j] = (f32x4){__uint_as_float(w.x << 16), __uint_as_float(w.x & 0xffff0000u), __uint_as_float(w.y << 16), __uint_as_float(w.y & 0xffff0000u)}; } }
    if (Y) {
        const u32x2* yp = (const u32x2*)(Y + (size_t)row * D) + lane;
        f32x4 yv[16]; float s = 0.f;
#pragma unroll
        for (int j = 0; j < 16; ++j) { const u32x2 w = yp[64 * j]; yv[j] = (f32x4){__uint_as_float(w.x << 16), __uint_as_float(w.x & 0xffff0000u), __uint_as_float(w.y << 16), __uint_as_float(w.y & 0xffff0000u)}; s += yv[j].x * yv[j].x + yv[j].y * yv[j].y + yv[j].z * yv[j].z + yv[j].w * yv[j].w; }
        const float rs = rsqrtf(wave_sum_l(s, lane) * (1.f / D) + EPS);
#pragma unroll
        for (int j = 0; j < 16; ++j) hv[j] += yv[j] * rs * gv[j];
    }
    if (OUT) {
        f32x4* hp = (f32x4*)(OUT + (size_t)row * D) + lane;
#pragma unroll
        for (int j = 0; j < 16; ++j) hp[64 * j] = hv[j];
    } else {
        float s = 0.f;
#pragma unroll
        for (int j = 0; j < 16; ++j) s += hv[j].x * hv[j].x + hv[j].y * hv[j].y + hv[j].z * hv[j].z + hv[j].w * hv[j].w;
        const float sst = wave_sum_l(s, lane);
        if (lane == 0) RS[row] = sst;
        u32x2* op = (u32x2*)(Hb + (size_t)row * D) + lane;
#pragma unroll
        for (int j = 0; j < 16; ++j) { u32x2 o; o.x = cvt_pk_bf16(hv[j].x, hv[j].y); o.y = cvt_pk_bf16(hv[j].z, hv[j].w); op[64 * j] = o; }
    }
}

__device__ __forceinline__ void zlr_rows(const bf16_t* HN, const bf16_t* WZ, const float* RS, int nslot, float* ZLR, int rb, LAS unsigned char* lds, int tid, int wave, int lane) {
    const int r = lane & 31, h = lane >> 5;
    f32x16 acc;
#pragma unroll
    for (int e = 0; e < 16; ++e) acc[e] = 0.f;
    const bf16_t* ap = HN + (size_t)(rb * 32 + r) * D + wave * 512 + 8 * h;
    const bf16_t* bp = WZ + (size_t)r * D + wave * 512 + 8 * h;
    const float rst = pg8::row_rstd(RS, nslot, rb * 32 + (tid >> 4));
#pragma unroll 16
    for (int k = 0; k < 512; k += 16) acc = __builtin_amdgcn_mfma_f32_32x32x16_bf16(*(const bf16x8*)(ap + k), *(const bf16x8*)(bp + k), acc, 0, 0, 0);
    LAS float* red = (LAS float*)lds;
    if (r < 16) {
#pragma unroll
        for (int e = 0; e < 16; ++e) red[(wave * 32 + (e & 3) + 8 * (e >> 2) + 4 * h) * 16 + r] = acc[e];
    }
    __syncthreads();
    { const int row = tid >> 4, n = tid & 15; float s = 0.f;
#pragma unroll
      for (int w = 0; w < 8; ++w) s += red[(w * 32 + row) * 16 + n];
      ZLR[(size_t)(rb * 32 + row) * 16 + n] = s * rst; }
    __syncthreads();
}


__device__ __forceinline__ void fix_rows(const float* ZB, const float* wc, const float* bc, bf16_t* F, int it) {
    const int c4 = it % (DFF / 4), rest = it / (DFF / 4), rr = rest & 1, ti = rest >> 1, pm = ti + 1 + ti / 15, c0 = c4 * 4;
    const float* zb = ZB + (size_t)pm * 4 * NUP; const float* zp = zb - (size_t)4 * NUP;
    const float* r0 = zb + (size_t)rr * NUP; const float* r1 = rr ? zb : zp + (size_t)3 * NUP; const float* r2 = rr ? zp + (size_t)3 * NUP : zp + (size_t)2 * NUP;
    const f32x4 g0 = *(const f32x4*)(r0 + c0), g1 = *(const f32x4*)(r1 + c0), g2 = *(const f32x4*)(r2 + c0), v0 = *(const f32x4*)(r0 + DFF + c0), v1 = *(const f32x4*)(r1 + DFF + c0), v2 = *(const f32x4*)(r2 + DFF + c0);
    const f32x4 wg0 = *(const f32x4*)(wc + c0), wg1 = *(const f32x4*)(wc + NUP + c0), wg2 = *(const f32x4*)(wc + 2 * NUP + c0), wv0 = *(const f32x4*)(wc + DFF + c0), wv1 = *(const f32x4*)(wc + NUP + DFF + c0), wv2 = *(const f32x4*)(wc + 2 * NUP + DFF + c0);
    const f32x4 gt = *(const f32x4*)(bc + c0) + wg0 * g2 + wg1 * g1 + wg2 * g0, vl = *(const f32x4*)(bc + DFF + c0) + wv0 * v2 + wv1 * v1 + wv2 * v0;
    u32x2 w; w.x = cvt_pk_bf16(pg8::gelu_tanh_e(gt[0]) * vl[0], pg8::gelu_tanh_e(gt[1]) * vl[1]); w.y = cvt_pk_bf16(pg8::gelu_tanh_e(gt[2]) * vl[2], pg8::gelu_tanh_e(gt[3]) * vl[3]);
    *(u32x2*)(F + (size_t)(pm * 256 + rr) * DFF + c0) = w;
}
__device__ __forceinline__ float gelu_tanh_fast(float x) { const float u = 1.5957691216057308f * (x + 0.044715f * x * x * x); return x / (1.f + __expf(-u)); }
__device__ __forceinline__ void conv_run(const bf16_t* Z, const float* wc, const float* bc, bf16_t* F, int run, int tid) {
    const size_t t0 = (size_t)run * 32; const bool first = ((run * 32) & (SEQ - 1)) == 0;
    for (int oc = tid; oc < DFF / 8; oc += 512) {
        const int c0 = oc * 8;
        float wg[3][8], wv[3][8], bg[8], bv[8];
#pragma unroll
        for (int j = 0; j < 3; ++j)
#pragma unroll
            for (int q = 0; q < 2; ++q) { const f32x4 a = *(const f32x4*)(wc + (size_t)j * NUP + c0 + 4 * q), b = *(const f32x4*)(wc + (size_t)j * NUP + DFF + c0 + 4 * q);
#pragma unroll
                for (int e = 0; e < 4; ++e) { wg[j][4 * q + e] = a[e]; wv[j][4 * q + e] = b[e]; } }
#pragma unroll
        for (int q = 0; q < 2; ++q) { const f32x4 a = *(const f32x4*)(bc + c0 + 4 * q), b = *(const f32x4*)(bc + DFF + c0 + 4 * q);
#pragma unroll
            for (int e = 0; e < 4; ++e) { bg[4 * q + e] = a[e]; bv[4 * q + e] = b[e]; } }
        float g2[8], g1[8], v2[8], v1[8];
        if (first) {
#pragma unroll
            for (int e = 0; e < 8; ++e) { g2[e] = 0.f; g1[e] = 0.f; v2[e] = 0.f; v1[e] = 0.f; }
        } else {
            const bf16x8 a2 = *(const bf16x8*)(Z + (t0 - 2) * NUP + c0), a1 = *(const bf16x8*)(Z + (t0 - 1) * NUP + c0), b2 = *(const bf16x8*)(Z + (t0 - 2) * NUP + DFF + c0), b1 = *(const bf16x8*)(Z + (t0 - 1) * NUP + DFF + c0);
#pragma unroll
            for (int e = 0; e < 8; ++e) { g2[e] = bf2f((bf16_t)a2[e]); g1[e] = bf2f((bf16_t)a1[e]); v2[e] = bf2f((bf16_t)b2[e]); v1[e] = bf2f((bf16_t)b1[e]); }
        }
#pragma unroll 4
        for (int r = 0; r < 32; ++r) {
            const bf16x8 a0 = *(const bf16x8*)(Z + (t0 + r) * NUP + c0), b0 = *(const bf16x8*)(Z + (t0 + r) * NUP + DFF + c0);
            float o[8];
#pragma unroll
            for (int e = 0; e < 8; ++e) { const float g0 = bf2f((bf16_t)a0[e]), v0 = bf2f((bf16_t)b0[e]);
                const float gt = bg[e] + wg[0][e] * g2[e] + wg[1][e] * g1[e] + wg[2][e] * g0, vl = bv[e] + wv[0][e] * v2[e] + wv[1][e] * v1[e] + wv[2][e] * v0;
                o[e] = gelu_tanh_fast(gt) * vl; g2[e] = g1[e]; g1[e] = g0; v2[e] = v1[e]; v1[e] = v0; }
            u32x4 w; w.x = cvt_pk_bf16(o[0], o[1]); w.y = cvt_pk_bf16(o[2], o[3]); w.z = cvt_pk_bf16(o[4], o[5]); w.w = cvt_pk_bf16(o[6], o[7]);
            *(u32x4*)(F + (t0 + r) * DFF + c0) = w;
        }
    }
}

constexpr int NPH = 21;
struct Args { const float* in[21]; float* out; unsigned char* ws; int ph_lo, ph_hi; };

__device__ __forceinline__ const void* lds_ptr(volatile LAS unsigned* A, int i) {
    const unsigned lo = __builtin_amdgcn_readfirstlane(A[2 * i]), hi = __builtin_amdgcn_readfirstlane(A[2 * i + 1]);
    return (const void*)(const GAS void*)(((unsigned long long)hi << 32) | (unsigned long long)lo);
}
constexpr int ARGS_OFF = RING_BYTES + 1024;
#define FRESH_TID() int lane = fresh_lane(); const int tid = wave * 64 + lane
#define P(i) ((const float*)lds_ptr(AP, (i)))
#define WSP() ((unsigned char*)lds_ptr(AP, 22))
#define IN(k) (lo <= (k) && (k) < hi)
#define BOTH(k) (IN(k) && IN((k) + 1))
#define GRID_BAR(k) do { if (BOTH(k)) { XcdBarrier b_; b_.bar = (unsigned*)(WSP() + WS_CTL) + CW_BAR; b_.x = xb_xcc_id(); b_.st = MISC + 8; b_.wave = wave; xcd_barrier(b_); } } while (0)
#define REP(k) _Pragma("unroll") for (int rep_ = 0; rep_ < ((k) == MK_DOUBLE_PHASE ? 2 : 1); ++rep_)
__device__ __forceinline__ CvtItem cvt_decode(int it, unsigned char* ws, volatile LAS unsigned* AP) {
    CvtItem d; d.gk = nullptr; d.nvalid = 32; d.hasg = 1;
    const int l = it >= I_LAYER ? 1 : 0; int r = it - l * I_LAYER;
    unsigned char* wl = ws + WS_W0 + (size_t)l * W_LAYER;
    if (r < I_IN) { const int kb = r / 320, nb = r % 320, d0 = nb * 32; d.W = P(1) + (size_t)l * D * NIN; d.ldw = NIN; d.srccol = win_src_col(d0); d.Wt = (bf16_t*)(wl + OFF_WN); d.K = D; d.dstrow = d0; d.k0 = kb * 64; d.gk = P(17) + (size_t)l * D; if (!d.gk) { d.gk = P(17); d.hasg = 0; } return d; } r -= I_IN;
    if (r < I_Z) { d.W = P(1) + (size_t)l * D * NIN; d.ldw = NIN; d.srccol = SRC_ZLR; d.nvalid = 16; d.Wt = (bf16_t*)(wl + OFF_WZ); d.K = D; d.dstrow = 0; d.k0 = r * 64; d.gk = P(17) + (size_t)l * D; if (!d.gk) { d.gk = P(17); d.hasg = 0; } return d; } r -= I_Z;
    if (r < I_O) { const int kb = r / 128, nb = r % 128; d.W = P(12) + (size_t)l * D * D; d.ldw = D; d.srccol = nb * 32; d.Wt = (bf16_t*)(wl + OFF_WO); d.K = D; d.dstrow = nb * 32; d.k0 = kb * 64; if (!d.gk) { d.gk = P(17); d.hasg = 0; } return d; } r -= I_O;
    if (r < I_UP) { const int kb = r / 688, nb = r % 688, d0 = nb * 32;
        d.W = P(13) + (size_t)l * D * NUP; d.ldw = NUP; d.srccol = ((d0 >> 7) & 1) * DFF + 128 * (d0 >> 8) + (d0 & 127); d.Wt = (bf16_t*)(wl + OFF_WUP); d.K = D; d.dstrow = d0; d.k0 = kb * 64; d.gk = P(19) + (size_t)l * D; if (!d.gk) { d.gk = P(17); d.hasg = 0; } return d; } r -= I_UP;
    if (r < I_DN) { const int kb = r / 128, nb = r % 128; d.W = P(16) + (size_t)l * DFF * D; d.ldw = D; d.srccol = nb * 32; d.Wt = (bf16_t*)(wl + OFF_WDN); d.K = DFF; d.dstrow = nb * 32; d.k0 = kb * 64; if (!d.gk) { d.gk = P(17); d.hasg = 0; } return d; } r -= I_DN;
    { const int g = r >> 5, kb = (r >> 3) & 3, nb = r & 7; d.W = P(10) + ((size_t)l * 4 + g) * 65536; d.ldw = 256; d.srccol = nb * 32; d.Wt = (bf16_t*)(wl + OFF_WP) + (size_t)g * 65536; d.K = 256; d.dstrow = nb * 32; d.k0 = kb * 64; }
    if (!d.gk) { d.gk = P(17); d.hasg = 0; }
    return d;
}
constexpr int I_EARLY = I_IN + I_Z + I_P, I_LATE = I_O + I_UP + I_DN, I_TAIL = 16384;
template <int SLOT> __device__ __forceinline__ int cvt_slot_item(int t) {
    if (SLOT == 0) return t < I_IN + I_Z ? t : t + I_LATE;
    if (SLOT == 1) { if (t < I_LATE) return I_IN + I_Z + t; const int u = t - I_LATE; return I_LAYER + (u < I_IN + I_Z ? u : u + I_LATE); }
    return I_LAYER + I_IN + I_Z + t;
}
template <int SLOT> __device__ __forceinline__ void cvt_stream(int first, int stride, int n, unsigned char* ws, volatile LAS unsigned* AP, LAS float* scr, int lane) {
    if (n <= 0) return;
    CvtItem dA = cvt_decode(cvt_slot_item<SLOT>(first), ws, AP), dB = dA; f32x4 vA[8], gA[2], vB[8], gB[2];
    cvt_load(dA, vA, gA, lane);
    for (int k = 0; k < n; k += 2) {
        const int iB = k + 1 < n ? k + 1 : n - 1;
        dB = cvt_decode(cvt_slot_item<SLOT>(first + iB * stride), ws, AP); cvt_load(dB, vB, gB, lane);
        cvt_store(dA, vA, gA, scr, lane);
        if (k + 1 >= n) break;
        const int iA = k + 2 < n ? k + 2 : n - 1;
        dA = cvt_decode(cvt_slot_item<SLOT>(first + iA * stride), ws, AP); cvt_load(dA, vA, gA, lane);
        cvt_store(dB, vB, gB, scr, lane);
    }
}
template <int l, int LO, int HI> __device__ __forceinline__ void layer_phases(LAS unsigned char* lds, volatile LAS unsigned* MISC, volatile LAS unsigned* AP, const int wave, const int G, const int bx, const int vcu, const int gw, const int NGW) {
    constexpr int lo = LO, hi = HI;

        const int pb = 1 + 10 * l;
        if (IN(pb + 0)) REP(pb + 0) {
            unsigned char* ws = WSP(); unsigned char* wl = ws + WS_W0 + (size_t)l * W_LAYER;
            const bf16_t* HN = (const bf16_t*)(ws + WS_HN);
            { pg8::Gemm g; g.A[0] = HN; g.Bt[0] = (const bf16_t*)(wl + OFF_WN); g.A[1] = (const bf16_t*)(wl + OFF_WT); g.Bt[1] = HN; g.lda = D; g.ldb = D; g.K = D;
              pg8::Order2 S; S.nM0 = M / 256; S.nN0 = UNW / 256; S.nM1 = UTW / 256; S.nN1 = M / 256; S.G = G; S.c = bx;
              pg8::EpiBf16 E; E.O[0] = (bf16_t*)(ws + WS_UN); E.ldc[0] = UNW; E.O[1] = (bf16_t*)(ws + WS_UT); E.ldc[1] = M; E.rs = (const float*)(ws + WS_RS); E.nslot = 1; E.nostore = MK_SHADOW ? rep_ : 0;
              E.kmax = (unsigned*)(ws + WS_CTL) + CW_KMAX + l * 2048; E.nrm = lds + pg8::STAGE_BYTES;
              pg8::gemm_phase<pg8::EpiBf16, pg8::Order2, PG8_ALIGN, PG8_SP2>(lds, g, S, E, wave); }
            FRESH_TID();
            for (int rb = bx; rb < M / 32; rb += G) zlr_rows(HN, (const bf16_t*)(wl + OFF_WZ), (const float*)(ws + WS_RS), 1, (float*)(ws + WS_ZLR), rb, lds, tid, wave, lane);
            GRID_BAR(pb + 0);
        }
        if (IN(pb + 1)) REP(pb + 1) {
            FRESH_TID();
            unsigned char* ws = WSP(); unsigned char* gs = ws + WS_GLA;
            const bf16_t* UN = (const bf16_t*)(ws + WS_UN); const bf16_t* UT = (const bf16_t*)(ws + WS_UT); bf16_t* MIX = (bf16_t*)(ws + WS_MIX);
            { const float* w2 = P(2) + (size_t)l * 16 * 512; const float* bgt = P(3) + (size_t)l * 512; const float* ZLR = (const float*)(ws + WS_ZLR);
              FRESH_TID();
              for (int u = vcu; u < 512; u += G) gla::g1_unit(lds, UN, UT, ZLR, w2, bgt, gs, u, tid, wave, lane); }
            { const bf16_t* WP = (const bf16_t*)(ws + WS_W0 + (size_t)l * W_LAYER + OFF_WP); const float* psc = P(11) + (size_t)l * 1024;
              FRESH_TID();
              for (int pu = vcu; pu < 256; pu += G) pool_unit(lds, UN, WP, psc, MIX, pu, tid, wave, lane); }
            { const float lam_init = 0.8f - 0.6f * expf(-0.3f * (float)l);
              float lam; { const float* q1 = P(4) + l * 128; const float* k1 = P(5) + l * 128; const float* q2 = P(6) + l * 128; const float* k2 = P(7) + l * 128;
                const float s1 = wave_sum_l(q1[lane] * k1[lane] + q1[lane + 64] * k1[lane + 64], lane), s2 = wave_sum_l(q2[lane] * k2[lane] + q2[lane + 64] * k2[lane + 64], lane);
                lam = expf(s1) - expf(s2) + lam_init; }
              lam = __uint_as_float(__builtin_amdgcn_readfirstlane(__float_as_uint(lam)));
              const float* gsub = P(8) + l * 256;
              FRESH_TID();
              unsigned* ctl = (unsigned*)(ws + WS_CTL);
              if (tid < 256) ((LAS float*)(lds + att::GSUB_OFF))[tid] = gsub[tid];
              for (;;) {
                  if (tid == 0) MISC[16] = __hip_atomic_fetch_add(ctl + CW_QUEUE + l * 64 + 32 * rep_, 1u, __ATOMIC_RELAXED, __HIP_MEMORY_SCOPE_AGENT);
                  __syncthreads();
                  const int idx = __builtin_amdgcn_readfirstlane((int)MISC[16]);
                  __syncthreads();
                  constexpr int NSLOT = ((l == 0) ? I_LAYER : I_LATE) - I_TAIL, NCH = (NSLOT + 127) / 128, NQ = 512 + NCH;
                  if (idx >= NQ) break;
                  int a0, a1;
                  if (idx < 256) { a0 = idx; a1 = idx + 1; }
                  else { const int p_ = idx - 256; constexpr int NQ2 = 256 + NCH; a0 = 256 + (int)(((long long)p_ * 256) / NQ2); a1 = 256 + (int)(((long long)(p_ + 1) * 256) / NQ2); }
                  if (a1 > a0) att::unit(lds, UN, UT, MIX, ctl + CW_KMAX + l * 2048, a0 & 1, 7 - ((a0 >> 1) & 7), 31 - (a0 >> 4), lam, nullptr, 1.f - lam_init, wave, lane, MK_SHADOW * rep_);
                  else { if (rep_ == 0) { FRESH_TID(); const int f_ = (idx - a0) * 128 + wave, r_ = (NSLOT - f_ + 7) / 8;     cvt_stream<l == 0 ? 1 : 2>(f_, 8, f_ < NSLOT ? (r_ < 16 ? r_ : 16) : 0, ws, AP, (LAS float*)(lds + wave * 16384), lane); }
                         __syncthreads(); } } }
            GRID_BAR(pb + 1);
        }
        if (IN(pb + 2)) REP(pb + 2) {
            FRESH_TID();
            unsigned char* gs = WSP() + WS_GLA;
            for (int p = vcu * 512 + tid; p < 131072; p += G * 512) gla::g2_scan(gs, p);
            GRID_BAR(pb + 2);
        }
        if (IN(pb + 3)) REP(pb + 3) {
            FRESH_TID();
            unsigned char* ws = WSP(); unsigned char* gs = ws + WS_GLA; const float* gg = P(9) + (size_t)l * 1024;
            for (int u = vcu; u < 512; u += G) gla::g3_unit(lds, (const bf16_t*)(ws + WS_UN), gs, gg, (bf16_t*)(ws + WS_MIX), u, tid, wave, lane);
            GRID_BAR(pb + 3);
        }
        if (IN(pb + 4)) {
            unsigned char* ws = WSP(); unsigned char* wl = ws + WS_W0 + (size_t)l * W_LAYER;
            pg8::Gemm g; g.A[0] = (const bf16_t*)(ws + WS_MIX); g.Bt[0] = (const bf16_t*)(wl + OFF_WO); g.A[1] = g.A[0]; g.Bt[1] = g.Bt[0]; g.lda = D; g.ldb = D; g.K = D;
            pg8::Order2 S; S.nM0 = M / 256; S.nN0 = D / 256; S.nM1 = 0; S.nN1 = 1; S.G = G; S.c = bx;
            pg8::EpiBf16 E; E.O[0] = (bf16_t*)(ws + WS_Y); E.ldc[0] = D; E.O[1] = E.O[0]; E.ldc[1] = D; E.rs = nullptr; E.nslot = 0;
            pg8::gemm_phase<pg8::EpiBf16, pg8::Order2, PG8_ALIGN, PG8_SP2>(lds, g, S, E, wave);
            GRID_BAR(pb + 4);
        }
        if (IN(pb + 5)) {
            FRESH_TID();
            unsigned char* ws = WSP(); const bf16_t* Y = (const bf16_t*)(ws + WS_Y); const float* gp = P(18) + (size_t)l * D; bf16_t* HN = (bf16_t*)(ws + WS_HN); float* RS = (float*)(ws + WS_RS);
            f32x4 gv[16];
#pragma unroll
            for (int j = 0; j < 16; ++j) gv[j] = ((const f32x4*)gp)[lane + 64 * j];
            for (int m = gw; m < M; m += NGW) res_row(nullptr, HN, Y, gv, RS, nullptr, m, lane);
            GRID_BAR(pb + 5);
        }
        if (IN(pb + 6)) REP(pb + 6) {
            unsigned char* ws = WSP(); unsigned char* wl = ws + WS_W0 + (size_t)l * W_LAYER;
            pg8::Gemm g; g.A[0] = (const bf16_t*)(ws + WS_HN); g.Bt[0] = (const bf16_t*)(wl + OFF_WUP); g.A[1] = g.A[0]; g.Bt[1] = g.Bt[0]; g.lda = D; g.ldb = D; g.K = D;
            pg8::Order2 S; S.nM0 = M / 256; S.nN0 = NUP / 256; S.nM1 = 0; S.nN1 = 1; S.G = G; S.c = bx;
            pg8::EpiConvGlu E; E.F = (bf16_t*)(ws + WS_F); E.ZB = (float*)(ws + WS_ZB); E.wcv = P(14) + (size_t)l * 3 * NUP; E.bcv = P(15) + (size_t)l * NUP; E.rs = (const float*)(ws + WS_RS); E.nslot = 1; E.halo = lds + 131072;
            pg8::gemm_phase<pg8::EpiConvGlu, pg8::Order2, PG8_ALIGN, PG8_SP2>(lds, g, S, E, wave);
            if (rep_ == 0) { const int nwg_ = G < 64 ? G : 64;
                if (bx >= G - nwg_) { FRESH_TID(); const int w_ = (bx - (G - nwg_)) * 8 + wave, nw_ = nwg_ * 8;
                    cvt_stream<l == 0 ? 1 : 2>(((l == 0) ? I_LAYER : I_LATE) - I_TAIL + w_, nw_, (I_TAIL - w_ + nw_ - 1) / nw_, ws, AP, (LAS float*)(lds + wave * 16384), lane); } }
            GRID_BAR(pb + 6);
        }
        if (IN(pb + 7)) REP(pb + 7) {
            FRESH_TID();
            unsigned char* ws = WSP(); const float* wc = P(14) + (size_t)l * 3 * NUP; const float* bc = P(15) + (size_t)l * NUP;
            for (int it = vcu * 512 + tid; it < 30 * 2 * (DFF / 4); it += G * 512) fix_rows((const float*)(ws + WS_ZB), wc, bc, (bf16_t*)(ws + WS_F), it);
            GRID_BAR(pb + 7);
        }
        if (IN(pb + 8)) {
            unsigned char* ws = WSP(); unsigned char* wl = ws + WS_W0 + (size_t)l * W_LAYER;
            pg8::Gemm g; g.A[0] = (const bf16_t*)(ws + WS_F); g.Bt[0] = (const bf16_t*)(wl + OFF_WDN); g.A[1] = g.A[0]; g.Bt[1] = g.Bt[0]; g.lda = DFF; g.ldb = DFF; g.K = DFF;
            pg8::Order2 S; S.nM0 = M / 256; S.nN0 = D / 256; S.nM1 = 0; S.nN1 = 1; S.G = G; S.c = bx;
            pg8::EpiBf16 E; E.O[0] = (bf16_t*)(ws + WS_Y); E.ldc[0] = D; E.O[1] = E.O[0]; E.ldc[1] = D; E.rs = nullptr; E.nslot = 0;
            pg8::gemm_phase<pg8::EpiBf16, pg8::Order2, PG8_ALIGN, PG8_SP2>(lds, g, S, E, wave);
            GRID_BAR(pb + 8);
        }
        if (IN(pb + 9)) {
            FRESH_TID();
            unsigned char* ws = WSP(); const bf16_t* Y = (const bf16_t*)(ws + WS_Y); const float* gp = P(20) + (size_t)l * D; bf16_t* HN = (bf16_t*)(ws + WS_HN); float* RS = (float*)(ws + WS_RS);
            float* OUT = l + 1 < DEPTH ? nullptr : (float*)P(21);
            f32x4 gv[16];
#pragma unroll
            for (int j = 0; j < 16; ++j) gv[j] = ((const f32x4*)gp)[lane + 64 * j];
            for (int m = gw; m < M; m += NGW) res_row(nullptr, HN, Y, gv, RS, OUT, m, lane);
            GRID_BAR(pb + 9);
        }
}
template <int LO, int HI> __global__ void __launch_bounds__(512, 2) fwd(Args args) {
    extern __shared__ __attribute__((aligned(16))) unsigned char lds_raw[];
    LAS unsigned char* lds = (LAS unsigned char*)lds_raw;
    volatile LAS unsigned* MISC = (volatile LAS unsigned*)(lds + MISC_OFF);
    volatile LAS unsigned* AP = (volatile LAS unsigned*)(lds + ARGS_OFF);
    const int wave = __builtin_amdgcn_readfirstlane((int)threadIdx.x >> 6);
    const int G = gridDim.x; const int bx = blockIdx.x; const int vcu = (G % 8 == 0) ? (bx % 8) * (G / 8) + bx / 8 : bx;
    constexpr int lo = LO, hi = HI;
    for (int u = threadIdx.x; u < (LDS_BYTES - LDSCTL_OFF) / 4; u += 512) ((LAS unsigned*)(lds + LDSCTL_OFF))[u] = 0u;
    __syncthreads();
    if (threadIdx.x == 0) {
        volatile LAS unsigned long long* A8 = (volatile LAS unsigned long long*)(lds + ARGS_OFF);
#pragma unroll
        for (int i = 0; i < 21; ++i) A8[i] = (unsigned long long)args.in[i];
        A8[21] = (unsigned long long)args.out; A8[22] = (unsigned long long)args.ws;
    }
    __syncthreads();
    if (hi - lo > 1) (void)xcd_barrier_post((unsigned*)(WSP() + WS_CTL) + CW_BAR, MISC + 8);
    const int gw = vcu * 8 + wave, NGW = G * 8;

    if (IN(0)) REP(0) {
        FRESH_TID();
        unsigned char* ws = WSP();
        LAS float* scr = (LAS float*)(lds + wave * 16384);
        cvt_stream<0>(gw, NGW, gw < I_EARLY ? (I_EARLY - gw + NGW - 1) / NGW : 0, ws, AP, scr, lane);
        { const float* x = P(0); bf16_t* HN = (bf16_t*)(ws + WS_HN); float* RS = (float*)(ws + WS_RS);
          f32x4 gv[16];
#pragma unroll
          for (int j = 0; j < 16; ++j) gv[j] = (f32x4){0.f, 0.f, 0.f, 0.f};
          for (int m = gw; m < M; m += NGW) res_row(x, HN, nullptr, gv, RS, nullptr, m, lane); }
        GRID_BAR(0);
    }

    layer_phases<0, LO, HI>(lds, MISC, AP, wave, G, bx, vcu, gw, NGW);
    layer_phases<1, LO, HI>(lds, MISC, AP, wave, G, bx, vcu, gw, NGW);
}

static int g_grid = 0;
template <int LO, int HI> static void launch_range(hipStream_t stream, const Args& a) {
    static bool attr = false;
    if (!attr) { if (hipFuncSetAttribute((const void*)fwd<LO, HI>, hipFuncAttributeMaxDynamicSharedMemorySize, LDS_BYTES) != hipSuccess) fprintf(stderr, "kernel_launch: hipFuncSetAttribute failed\n"); attr = true; }
    hipLaunchKernelGGL((fwd<LO, HI>), dim3(g_grid), dim3(512), LDS_BYTES, stream, a);
    const hipError_t le = hipPeekAtLastError();
    if (le != hipSuccess) fprintf(stderr, "kernel_launch: fwd launch [%d,%d) failed: %s\n", LO, HI, hipGetErrorName(le));
}
template <int P> static void launch_each(hipStream_t stream, const Args& a) { if constexpr (P < NPH) { launch_range<P, P + 1>(stream, a); launch_each<P + 1>(stream, a); } }
extern "C" void kernel_launch(void* const* d_in, const int* in_sizes, int n_in, void* d_out, int out_size, void* d_ws, size_t ws_size, hipStream_t stream) {
    if (n_in != 21 || ws_size < WS_END) { fprintf(stderr, "kernel_launch: unexpected n_in %d or ws %zu < %zu\n", n_in, ws_size, (size_t)WS_END); return; }
    if (g_grid == 0) {
        int dev = 0, cus = 0;
        if (hipGetDevice(&dev) != hipSuccess || hipDeviceGetAttribute(&cus, hipDeviceAttributeMultiprocessorCount, dev) != hipSuccess) { fprintf(stderr, "kernel_launch: device query failed\n"); g_grid = -1; return; }
        int per_cu = 0;
        (void)hipFuncSetAttribute((const void*)fwd<0, NPH>, hipFuncAttributeMaxDynamicSharedMemorySize, LDS_BYTES);
        if (hipOccupancyMaxActiveBlocksPerMultiprocessor(&per_cu, (const void*)fwd<0, NPH>, 512, LDS_BYTES) != hipSuccess || per_cu < 1)
            fprintf(stderr, "kernel_launch: occupancy query reports %d workgroups per CU for 512 threads + %d B LDS; launching one per CU anyway\n", per_cu, LDS_BYTES);
        (void)hipGetLastError();
        g_grid = cus;
    }
    if (g_grid < 0) return;
    (void)hipMemsetAsync((char*)d_ws + WS_CTL, 0, CTL_ZERO_BYTES, stream);
    Args a{};
    for (int i = 0; i < 21; ++i) a.in[i] = (const float*)d_in[i];
    a.out = (float*)d_out; a.ws = (unsigned char*)d_ws;
#if MK_ONE_LAUNCH
    launch_range<0, NPH>(stream, a);
#else
    launch_each<0>(stream, a);
#endif
}
```
